# Optimizing an MI355X kernel written in HIP

```python
import jax
import jax.numpy as jnp
from jax import lax
import numpy as np

D_MODEL = 2048
BATCH = 1
SEQ = 16384
DEPTH = 1

D_MIX = D_MODEL
RWKV_WIDTH = D_MIX // 2
RWKV_HEAD_DIM = 64
RWKV_HEADS = RWKV_WIDTH // RWKV_HEAD_DIM
LORA_RANK = 64
MOBA_WIDTH = D_MIX - RWKV_WIDTH
MOBA_HEAD_DIM = 128
MOBA_HEADS = MOBA_WIDTH // MOBA_HEAD_DIM
ROT_DIM = MOBA_HEAD_DIM // 4
ROPE_THETA = 500000.0
MOBA_BLOCK = 256
MOBA_TOPK = 3
Q_CHUNK = 64
RMS_EPS = 1e-6
LNX_EPS = 64e-5
NEG_INF = -1e30
IN_SPLITS = (RWKV_WIDTH, RWKV_WIDTH, RWKV_WIDTH, LORA_RANK, LORA_RANK, RWKV_WIDTH,
             MOBA_WIDTH, MOBA_WIDTH, MOBA_WIDTH, MOBA_WIDTH)
D_IN = sum(IN_SPLITS)

kernel_name = "hymba_rwkv7_moba_layer"


def rms_norm(x, w):
    xf = x.astype(jnp.float32)
    y = xf * lax.rsqrt(jnp.mean(xf * xf, axis=-1, keepdims=True) + RMS_EPS)
    return (y * w.astype(jnp.float32)).astype(x.dtype)


def token_shift(z, mu):
    z_prev = jnp.pad(z, ((0, 0), (1, 0), (0, 0)))[:, :-1]
    return z + mu * (z_prev - z)


def wkv7_scan(r, w, k, v, a, b):
    B, T, H, N = r.shape

    def step(S, inp):
        r_t, w_t, k_t, v_t, a_t, b_t = inp
        sa = jnp.einsum("bhij,bhj->bhi", S, a_t)
        S = (S * w_t[:, :, None, :] + sa[..., None] * b_t[:, :, None, :]
             + v_t[..., None] * k_t[:, :, None, :])
        y = jnp.einsum("bhij,bhj->bhi", S, r_t)
        return S, y

    seq = tuple(jnp.moveaxis(t, 1, 0) for t in (r, w, k, v, a, b))
    S0 = jnp.zeros((B, H, N, N), jnp.float32)
    _, ys = lax.scan(step, S0, seq)
    return jnp.moveaxis(ys, 0, 1)


def rwkv7_branch(r, k, v, wd, ad, mu_rkv, mu_lora, w_decay_up, w_decay_bias,
                 w_iclr_up, w_iclr_bias, k_k, k_a, r_k, lnx_w, lnx_b):
    B, T, _ = r.shape
    H, N = RWKV_HEADS, RWKV_HEAD_DIM
    r = token_shift(r, mu_rkv[0])
    k = token_shift(k, mu_rkv[1])
    v = token_shift(v, mu_rkv[2])
    wd = token_shift(wd, mu_lora[0])
    ad = token_shift(ad, mu_lora[1])
    w_log = -jax.nn.softplus(-(w_decay_bias + jnp.tanh(wd) @ w_decay_up)) - 0.5
    a = jax.nn.sigmoid(w_iclr_bias + ad @ w_iclr_up)
    kk = (k * k_k).reshape(B, T, H, N).astype(jnp.float32)
    kk = kk / jnp.maximum(jnp.sqrt(jnp.sum(kk * kk, axis=-1, keepdims=True)), 1e-12)
    k = k * (1.0 + (a - 1.0) * k_a)

    def heads(t):
        return t.reshape(B, T, H, N).astype(jnp.float32)

    rh, kh, vh, ah = heads(r), heads(k), heads(v), heads(a)
    decay = jnp.exp(-jnp.exp(heads(w_log)))
    y = wkv7_scan(rh, decay, kh, vh, -kk, kk * ah)
    mean = jnp.mean(y, axis=-1, keepdims=True)
    var = jnp.mean(jnp.square(y - mean), axis=-1, keepdims=True)
    y = ((y - mean) * lax.rsqrt(var + LNX_EPS)).reshape(B, T, H * N) * lnx_w + lnx_b
    bonus = jnp.sum(rh * kh * r_k, axis=-1, keepdims=True) * vh
    return (y + bonus.reshape(B, T, H * N)).astype(r.dtype)


def partial_rope(x, pos):
    half = ROT_DIM // 2
    inv_freq = ROPE_THETA ** (-jnp.arange(half, dtype=jnp.float32) / half)
    ang = pos[:, None] * inv_freq[None, :]
    cos = jnp.cos(ang)[None, :, None, :]
    sin = jnp.sin(ang)[None, :, None, :]
    xf = x.astype(jnp.float32)
    x1 = xf[..., :half]
    x2 = xf[..., half:ROT_DIM]
    out = jnp.concatenate([x1 * cos - x2 * sin, x2 * cos + x1 * sin, xf[..., ROT_DIM:]], axis=-1)
    return out.astype(x.dtype)


def moba_attention(q, k, v):
    B, T, H, Dh = q.shape
    nb = -(-T // MOBA_BLOCK)
    pad = nb * MOBA_BLOCK - T
    topk = min(MOBA_TOPK, nb)

    def to_blocks(t):
        t = jnp.pad(t, ((0, 0), (0, pad), (0, 0), (0, 0)))
        return t.reshape(B, nb, MOBA_BLOCK, H, Dh).transpose(0, 3, 1, 2, 4)

    kb, vb = to_blocks(k), to_blocks(v)
    k_mean = jnp.mean(kb.astype(jnp.float32), axis=3)
    b_idx = jnp.arange(B)[:, None, None, None]
    h_idx = jnp.arange(H)[None, None, :, None]
    scale = Dh ** -0.5

    def attend_chunk(ci):
        start = ci * Q_CHUNK
        qc = lax.dynamic_slice_in_dim(q, start, Q_CHUNK, axis=1).astype(jnp.float32)
        cur = start // MOBA_BLOCK
        q_pos = start + jnp.arange(Q_CHUNK)
        gate = jnp.einsum("bqhd,bhnd->bqhn", qc, k_mean)
        gate = jnp.where(jnp.arange(nb) < cur, gate, NEG_INF)
        _, sel = lax.top_k(gate, topk)
        valid = jnp.arange(topk) < cur
        k_sel = kb[b_idx, h_idx, sel].astype(jnp.float32)
        v_sel = vb[b_idx, h_idx, sel].astype(jnp.float32)
        s_sel = jnp.einsum("bqhd,bqhksd->bqhks", qc, k_sel) * scale
        s_sel = jnp.where(valid[:, None], s_sel, NEG_INF)
        k_own = lax.dynamic_index_in_dim(kb, cur, axis=2, keepdims=False).astype(jnp.float32)
        v_own = lax.dynamic_index_in_dim(vb, cur, axis=2, keepdims=False).astype(jnp.float32)
        s_own = jnp.einsum("bqhd,bhsd->bqhs", qc, k_own) * scale
        k_pos = cur * MOBA_BLOCK + jnp.arange(MOBA_BLOCK)
        causal = (k_pos[None, :] <= q_pos[:, None])[:, None, :]
        s_own = jnp.where(causal, s_own, NEG_INF)
        scores = jnp.concatenate([s_sel.reshape(B, Q_CHUNK, H, topk * MOBA_BLOCK), s_own], axis=-1)
        p = jax.nn.softmax(scores, axis=-1)
        p_sel = p[..., :topk * MOBA_BLOCK].reshape(B, Q_CHUNK, H, topk, MOBA_BLOCK)
        p_own = p[..., topk * MOBA_BLOCK:]
        out = (jnp.einsum("bqhks,bqhksd->bqhd", p_sel, v_sel)
               + jnp.einsum("bqhs,bhsd->bqhd", p_own, v_own))
        return out.astype(q.dtype)

    outs = lax.map(attend_chunk, jnp.arange(T // Q_CHUNK))
    return jnp.moveaxis(outs, 0, 1).reshape(B, T, H, Dh)


def setup_inputs(seed: int = 0) -> dict:
    key = jax.random.key(seed)
    ks = jax.random.split(key, 16)
    f32 = jnp.float32
    x = jax.random.normal(ks[0], (BATCH, SEQ, D_MODEL), f32)
    norm_w = 1.0 + 0.02 * jax.random.normal(ks[1], (DEPTH, D_MODEL), f32)
    w_in = jax.random.normal(ks[2], (DEPTH, D_MODEL, D_IN), f32) * D_MODEL ** -0.5
    mu_rkv = jax.random.uniform(ks[3], (DEPTH, 3, RWKV_WIDTH), f32)
    mu_lora = jax.random.uniform(ks[4], (DEPTH, 2, LORA_RANK), f32)
    w_decay_up = jax.random.normal(ks[5], (DEPTH, LORA_RANK, RWKV_WIDTH), f32) * (0.1 * LORA_RANK ** -0.5)
    w_decay_bias = jax.random.uniform(ks[6], (DEPTH, RWKV_WIDTH), f32, minval=-6.5, maxval=-1.5)
    w_iclr_up = jax.random.normal(ks[7], (DEPTH, LORA_RANK, RWKV_WIDTH), f32) * (0.1 * LORA_RANK ** -0.5)
    w_iclr_bias = 0.1 * jax.random.normal(ks[8], (DEPTH, RWKV_WIDTH), f32)
    k_k = 0.85 + 0.02 * jax.random.normal(ks[9], (DEPTH, RWKV_WIDTH), f32)
    k_a = 1.0 + 0.02 * jax.random.normal(ks[10], (DEPTH, RWKV_WIDTH), f32)
    r_k = 0.1 * jax.random.normal(ks[11], (DEPTH, RWKV_HEADS, RWKV_HEAD_DIM), f32)
    lnx_w = 1.0 + 0.02 * jax.random.normal(ks[12], (DEPTH, RWKV_WIDTH), f32)
    lnx_b = 0.02 * jax.random.normal(ks[13], (DEPTH, RWKV_WIDTH), f32)
    w_out = jax.random.normal(ks[14], (DEPTH, D_MIX, D_MODEL), f32) * D_MIX ** -0.5
    final_norm_w = 1.0 + 0.02 * jax.random.normal(ks[15], (D_MODEL,), f32)
    return {"x": x, "norm_w": norm_w, "w_in": w_in, "mu_rkv": mu_rkv, "mu_lora": mu_lora,
            "w_decay_up": w_decay_up, "w_decay_bias": w_decay_bias, "w_iclr_up": w_iclr_up,
            "w_iclr_bias": w_iclr_bias, "k_k": k_k, "k_a": k_a, "r_k": r_k, "lnx_w": lnx_w,
            "lnx_b": lnx_b, "w_out": w_out, "final_norm_w": final_norm_w}


def reference(x, norm_w, w_in, mu_rkv, mu_lora, w_decay_up, w_decay_bias, w_iclr_up,
              w_iclr_bias, k_k, k_a, r_k, lnx_w, lnx_b, w_out, final_norm_w):
    B, T, _ = x.shape
    pos = jnp.arange(T, dtype=jnp.float32)
    offsets = [int(o) for o in np.cumsum(IN_SPLITS)[:-1]]
    h = x
    for layer in range(DEPTH):
        u = rms_norm(h, norm_w[layer])
        proj = u @ w_in[layer]
        r, k_r, v_r, wd, ad, g_r, q_m, k_m, v_m, g_m = jnp.split(proj, offsets, axis=-1)
        y_r = rwkv7_branch(r, k_r, v_r, wd, ad, mu_rkv[layer], mu_lora[layer],
                           w_decay_up[layer], w_decay_bias[layer], w_iclr_up[layer],
                           w_iclr_bias[layer], k_k[layer], k_a[layer], r_k[layer],
                           lnx_w[layer], lnx_b[layer])
        q_m = partial_rope(q_m.reshape(B, T, MOBA_HEADS, MOBA_HEAD_DIM), pos)
        k_m = partial_rope(k_m.reshape(B, T, MOBA_HEADS, MOBA_HEAD_DIM), pos)
        v_m = v_m.reshape(B, T, MOBA_HEADS, MOBA_HEAD_DIM)
        y_m = moba_attention(q_m, k_m, v_m).reshape(B, T, MOBA_WIDTH)
        mixed = jnp.concatenate([y_r * jax.nn.silu(g_r), y_m * jax.nn.silu(g_m)], axis=-1)
        h = h + mixed @ w_out[layer]
    return rms_norm(h, final_norm_w)
```

```cpp
#include <hip/hip_runtime.h>
#include <cstdio>
#include <cstdint>
namespace pg8 {
#define PG8_LAS __attribute__((address_space(3)))
typedef unsigned short bf16_t;
typedef short bf16x8 __attribute__((ext_vector_type(8)));
typedef float f32x4 __attribute__((ext_vector_type(4)));
typedef unsigned u32x4 __attribute__((ext_vector_type(4)));
constexpr int BM = 256, BK = 64, HALF = 128, HTB = HALF * BK * 2  , STAGE_BYTES = 8 * HTB, NXCD = 8, WGM = 8;

__host__ __device__ __forceinline__ int lds_byte(int r, int c) { const int st = (r >> 4) * 2 + (c >> 5), rr = r & 15, cc = c & 31, ob = rr * 64 + cc * 2; return st * 1024 + (ob ^ (((ob >> 9) & 1) << 5)); }
__host__ __device__ __forceinline__ void stage_rc(int b, int& R, int& C) { const int st = b / 1024, sb = b % 1024, swz = sb ^ (((sb >> 9) & 1) << 5); R = (st >> 1) * 16 + swz / 64; C = (st & 1) * 32 + (swz % 64) / 2; }
__host__ __device__ __forceinline__ int perm32(int rho) { const int n = rho >> 4, i = rho & 15; return 8 * (i >> 2) + 4 * n + (i & 3); }

struct Unit { int pm, pn; };
struct Gemm { const bf16_t* A; const bf16_t* Bt; int M, N, K; };

struct StaticOrder {
    int nM, nN, nwg, G, c;
    __host__ __device__ void init(int M, int N, int G_, int c_) { nM = M / BM; nN = N / BM; nwg = nM * nN; G = G_; c = c_; }
    __host__ __device__ bool next(int i, Unit& u) const {
        const long L = (long)i * G + c; if (L >= nwg) return false;
        int wgid = (int)L; { const int q = nwg / NXCD, r = nwg % NXCD, xcd = wgid % NXCD, off = wgid / NXCD; wgid = (xcd < r ? xcd * (q + 1) : r * (q + 1) + (xcd - r) * q) + off; }
        const int nig = WGM * nN, gid = wgid / nig, fm = gid * WGM, gsz = (nM - fm) < WGM ? (nM - fm) : WGM;
        u.pm = fm + ((wgid % nig) % gsz); u.pn = (wgid % nig) / gsz; return true;
    }
    __device__ __forceinline__ void a_ready(const Unit&) const {}
    __device__ __forceinline__ void done(const Unit&) const {}
};

__device__ __forceinline__ unsigned cvt_pk_bf16(float lo, float hi) { unsigned r; asm volatile("v_cvt_pk_bf16_f32 %0, %1, %2" : "=v"(r) : "v"(lo), "v"(hi)); return r; }

struct EpiProj {
    static constexpr bool PERM = true, AFTER_DRAIN = false;
    bf16_t* base; bf16_t* wdad; const float* ropec; const float* ropes; size_t gstride;
    __device__ __forceinline__ void operator()(const f32x4 (&acc)[2][2][4][2], const Unit& u, int wr, int wc, int fr, int fq) const {
        const int row0 = u.pm * BM + wr * 64 + fr;
        if (u.pn < 32) {
            const int group = u.pn >> 2; bf16_t* bg = base + (size_t)group * gstride;
            const int col0 = (u.pn & 3) * BM + wc * 32 + 8 * fq;
            const bool rope = (group == 5 || group == 6) && wc == 0;
#pragma unroll
            for (int ai = 0; ai < 2; ++ai)
#pragma unroll
                for (int m = 0; m < 4; ++m) { const int row = row0 + ai * HALF + m * 16; bf16_t* rowp = bg + (size_t)row * 1024 + col0;
                    f32x4 cs = (f32x4){1.f, 1.f, 1.f, 1.f}, sn = (f32x4){0.f, 0.f, 0.f, 0.f};
                    if (rope) { cs = *(const f32x4*)(ropec + (size_t)row * 16 + 4 * fq); sn = *(const f32x4*)(ropes + (size_t)row * 16 + 4 * fq); }
#pragma unroll
                    for (int bj = 0; bj < 2; ++bj) { f32x4 v0 = acc[ai][bj][m][0], v1 = acc[ai][bj][m][1];
                        if (rope) { const f32x4 a = v0 * cs - v1 * sn, b = v1 * cs + v0 * sn; v0 = a; v1 = b; }
                        u32x4 w; w.x = cvt_pk_bf16(v0[0], v0[1]); w.y = cvt_pk_bf16(v0[2], v0[3]); w.z = cvt_pk_bf16(v1[0], v1[1]); w.w = cvt_pk_bf16(v1[2], v1[3]);
                        *(u32x4*)(rowp + bj * HALF) = w; } }
        } else {
            const int col0 = wc * 32 + 8 * fq;
#pragma unroll
            for (int ai = 0; ai < 2; ++ai)
#pragma unroll
                for (int m = 0; m < 4; ++m) { const int row = row0 + ai * HALF + m * 16; bf16_t* rowp = wdad + (size_t)row * 128 + col0;
                    const f32x4 v0 = acc[ai][0][m][0], v1 = acc[ai][0][m][1];
                    u32x4 w; w.x = cvt_pk_bf16(v0[0], v0[1]); w.y = cvt_pk_bf16(v0[2], v0[3]); w.z = cvt_pk_bf16(v1[0], v1[1]); w.w = cvt_pk_bf16(v1[2], v1[3]);
                    *(u32x4*)rowp = w; }
        }
    }
};

struct EpiOut {
    static constexpr bool PERM = false, AFTER_DRAIN = false;
    const float* x; float* out; float* rowss; int ldc;
    __device__ __forceinline__ void operator()(const f32x4 (&acc)[2][2][4][2], const Unit& u, int wr, int wc, int fr, int fq) const {
        const int row0 = u.pm * BM + wr * 64 + fr, col0 = u.pn * BM + wc * 32 + 4 * fq;
#pragma unroll
        for (int ai = 0; ai < 2; ++ai)
#pragma unroll
            for (int m = 0; m < 4; ++m) { const int row = row0 + ai * HALF + m * 16; const size_t off = (size_t)row * ldc + col0; float ss = 0.f;
#pragma unroll
                for (int bj = 0; bj < 2; ++bj)
#pragma unroll
                    for (int n = 0; n < 2; ++n) { const f32x4 xv = *(const f32x4*)(x + off + bj * HALF + n * 16); const f32x4 h = xv + acc[ai][bj][m][n];
                        *(f32x4*)(out + off + bj * HALF + n * 16) = h; ss += (h[0] * h[0] + h[1] * h[1]) + (h[2] * h[2] + h[3] * h[3]); }
                ss += __shfl_xor(ss, 16); ss += __shfl_xor(ss, 32);
                if (fq == 0) rowss[(size_t)row * 32 + u.pn * 4 + wc] = ss; }
    }
};
template <class Epi, class Sched, bool ALIGN_EPI = false, bool SP2 = false>
__device__ __forceinline__ void gemm_phase(PG8_LAS unsigned char* lds, const Gemm g, const Sched& S, const Epi& E) {
    int tid_ = threadIdx.x; asm volatile("" : "+v"(tid_));
    const int tid = tid_, wid = __builtin_amdgcn_readfirstlane(tid >> 6), lane = tid & 63, wr = wid >> 2, wc = wid & 3, fr = lane & 15, fq = lane >> 4;
    const int K = g.K, nt = K / BK;
    unsigned voffA[2], voffB[2];
#pragma unroll
    for (int i = 0; i < 2; ++i) { int R, C; stage_rc(tid * 16 + i * 8192, R, C); const int Rb = Epi::PERM ? ((R & ~31) + perm32(R & 31)) : R;
        voffA[i] = (unsigned)(R * K + C) * 2u; voffB[i] = (unsigned)(Rb * K + C) * 2u; }
    const size_t kstep = (size_t)(BK * 2);
    const size_t hstep = (size_t)HALF * K * 2;
    const size_t tstep = 2 * hstep;
    const unsigned ldsw = (unsigned)wid * 1024u;
    const int aoff = lds_byte(wr * 64 + fr, fq * 8), boff = lds_byte(wc * 32 + fr, fq * 8);
#define PG8_SA(b, h) (((b) * 2 + (h)) * HTB)
#define PG8_SB(b, h) ((4 + (b) * 2 + (h)) * HTB)
#define PG8_STAGE(bufoff, gbase, voff) do { _Pragma("unroll") for (int _i = 0; _i < 2; ++_i) \
        __builtin_amdgcn_global_load_lds((const unsigned*)((const char*)(gbase) + (voff)[_i]), (PG8_LAS unsigned*)(lds + (bufoff) + ldsw + _i * 8192), 16, 0, 0); } while (0)
#define PG8_LDA(dst, b, h) do { _Pragma("unroll") for (int m = 0; m < 4; ++m) _Pragma("unroll") for (int k = 0; k < 2; ++k) dst[m][k] = *(const PG8_LAS bf16x8*)(lds + PG8_SA(b, h) + aoff + m * 2048 + k * 1024); } while (0)
#define PG8_LDB(dst, b, h) do { _Pragma("unroll") for (int n = 0; n < 2; ++n) _Pragma("unroll") for (int k = 0; k < 2; ++k) dst[n][k] = *(const PG8_LAS bf16x8*)(lds + PG8_SB(b, h) + boff + n * 2048 + k * 1024); } while (0)
#define PG8_MMA(ai, bj, At, Bt) do { __builtin_amdgcn_s_setprio(1); _Pragma("unroll") for (int m = 0; m < 4; ++m) _Pragma("unroll") for (int n = 0; n < 2; ++n) _Pragma("unroll") for (int k = 0; k < 2; ++k) \
        acc[ai][bj][m][n] = __builtin_amdgcn_mfma_f32_16x16x32_bf16(Bt[n][k], At[m][k], acc[ai][bj][m][n], 0, 0, 0); __builtin_amdgcn_s_setprio(0); } while (0)
#define PG8_WAIT_V(n) asm volatile("s_waitcnt vmcnt(" #n ")" ::: "memory")
#define PG8_WAIT_L(n) asm volatile("s_waitcnt lgkmcnt(" #n ")" ::: "memory")
#define PG8_BAR __builtin_amdgcn_s_barrier()
#define PG8_SCHED __builtin_amdgcn_sched_barrier(0)
    Unit cur, nxt; int ui = 0;
    if (!S.next(0, cur)) return;
    f32x4 acc[2][2][4][2];
#pragma unroll
    for (int a = 0; a < 2; ++a)
#pragma unroll
        for (int b = 0; b < 2; ++b)
#pragma unroll
            for (int m = 0; m < 4; ++m)
#pragma unroll
                for (int n = 0; n < 2; ++n) acc[a][b][m][n] = (f32x4){0.f, 0.f, 0.f, 0.f};
    bf16x8 At[4][2], B0[2][2], B1[2][2];
    const char* cA = (const char*)g.A + (size_t)cur.pm * tstep; const char* cB = (const char*)g.Bt + (size_t)cur.pn * tstep;
    S.a_ready(cur);
    if constexpr (SP2) {
        PG8_STAGE(PG8_SB(0, 0), cB, voffB); PG8_STAGE(PG8_SB(0, 1), cB + hstep, voffB); PG8_STAGE(PG8_SA(0, 0), cA, voffA); PG8_STAGE(PG8_SA(0, 1), cA + hstep, voffA);
        if (wr == 1) PG8_BAR;
        PG8_WAIT_V(2); PG8_BAR;
        PG8_STAGE(PG8_SB(1, 0), cB + kstep, voffB); PG8_STAGE(PG8_SA(1, 0), cA + kstep, voffA); PG8_STAGE(PG8_SB(1, 1), cB + hstep + kstep, voffB);
        PG8_WAIT_V(6); PG8_BAR;
    } else {
        PG8_STAGE(PG8_SB(0, 0), cB, voffB); PG8_STAGE(PG8_SA(0, 0), cA, voffA); PG8_STAGE(PG8_SB(0, 1), cB + hstep, voffB); PG8_STAGE(PG8_SA(0, 1), cA + hstep, voffA);
        if (wr == 1) PG8_BAR;
        PG8_WAIT_V(4); PG8_BAR;
        PG8_STAGE(PG8_SB(1, 0), cB + kstep, voffB); PG8_STAGE(PG8_SA(1, 0), cA + kstep, voffA); PG8_STAGE(PG8_SB(1, 1), cB + hstep + kstep, voffB);
        PG8_WAIT_V(6); PG8_BAR;
    }
    for (;;) {
        const bool has_next = S.next(ui + 1, nxt);
        const char* nA = has_next ? (const char*)g.A + (size_t)nxt.pm * tstep : cA; const char* nB = has_next ? (const char*)g.Bt + (size_t)nxt.pn * tstep : cB;
        for (int t = 0; t < nt; t += 2) {
            const bool last = (t == nt - 2);
            const char* a1 = cA + (size_t)(t + 1) * kstep;
            const char* a2 = last ? nA : cA + (size_t)(t + 2) * kstep; const char* b2 = last ? nB : cB + (size_t)(t + 2) * kstep;
            const char* a3 = a2 + kstep; const char* b3 = b2 + kstep;
            if (last && has_next) S.a_ready(nxt);
            if constexpr (SP2) {
            PG8_LDB(B0, 0, 0); PG8_LDB(B1, 0, 1); PG8_SCHED; PG8_LDA(At, 0, 0); PG8_STAGE(PG8_SA(1, 1), a1 + hstep, voffA);
            PG8_WAIT_V(8); PG8_WAIT_L(0); PG8_BAR; PG8_MMA(0, 0, At, B0); PG8_MMA(0, 1, At, B1); PG8_BAR; PG8_SCHED;
            PG8_LDA(At, 0, 1); PG8_STAGE(PG8_SB(0, 0), b2, voffB); PG8_STAGE(PG8_SB(0, 1), b2 + hstep, voffB); PG8_STAGE(PG8_SA(0, 0), a2, voffA);
            PG8_WAIT_V(8); PG8_WAIT_L(0); PG8_BAR; PG8_MMA(1, 0, At, B0); PG8_MMA(1, 1, At, B1); PG8_BAR; PG8_SCHED;
            PG8_LDB(B0, 1, 0); PG8_LDB(B1, 1, 1); PG8_SCHED; PG8_LDA(At, 1, 0); PG8_STAGE(PG8_SA(0, 1), a2 + hstep, voffA);
            PG8_WAIT_V(8); PG8_WAIT_L(0); PG8_BAR; PG8_MMA(0, 0, At, B0); PG8_MMA(0, 1, At, B1); PG8_BAR; PG8_SCHED;
            PG8_LDA(At, 1, 1); PG8_STAGE(PG8_SB(1, 0), b3, voffB); PG8_STAGE(PG8_SB(1, 1), b3 + hstep, voffB); PG8_STAGE(PG8_SA(1, 0), a3, voffA);
            PG8_WAIT_V(8); PG8_WAIT_L(0); PG8_BAR; PG8_MMA(1, 0, At, B0); PG8_MMA(1, 1, At, B1); PG8_BAR; PG8_SCHED;
            } else {
            PG8_LDB(B0, 0, 0); PG8_SCHED; PG8_LDA(At, 0, 0); PG8_STAGE(PG8_SA(1, 1), a1 + hstep, voffA);
            PG8_WAIT_L(8); PG8_BAR; PG8_WAIT_L(0); PG8_MMA(0, 0, At, B0); PG8_BAR; PG8_SCHED;
            PG8_LDB(B1, 0, 1); PG8_STAGE(PG8_SB(0, 0), b2, voffB);
            PG8_BAR; PG8_WAIT_L(0); PG8_MMA(0, 1, At, B1); PG8_BAR;
            PG8_LDA(At, 0, 1); PG8_STAGE(PG8_SA(0, 0), a2, voffA);
            PG8_BAR; PG8_WAIT_L(0); PG8_MMA(1, 0, At, B0); PG8_BAR; PG8_SCHED;
            PG8_STAGE(PG8_SB(0, 1), b2 + hstep, voffB);
            PG8_WAIT_V(6); PG8_BAR; PG8_MMA(1, 1, At, B1); PG8_BAR;
            PG8_LDB(B0, 1, 0); PG8_SCHED; PG8_LDA(At, 1, 0); PG8_STAGE(PG8_SA(0, 1), a2 + hstep, voffA);
            PG8_WAIT_L(8); PG8_BAR; PG8_WAIT_L(0); PG8_MMA(0, 0, At, B0); PG8_BAR; PG8_SCHED;
            PG8_LDB(B1, 1, 1); PG8_STAGE(PG8_SB(1, 0), b3, voffB);
            PG8_BAR; PG8_WAIT_L(0); PG8_MMA(0, 1, At, B1); PG8_BAR;
            PG8_LDA(At, 1, 1); PG8_STAGE(PG8_SA(1, 0), a3, voffA);
            PG8_BAR; PG8_WAIT_L(0); PG8_MMA(1, 0, At, B0); PG8_BAR; PG8_SCHED;
            PG8_STAGE(PG8_SB(1, 1), b3 + hstep, voffB);
            PG8_WAIT_V(6); PG8_BAR; PG8_MMA(1, 1, At, B1); PG8_BAR;
            }
        }
        if constexpr (ALIGN_EPI) { if (wr == 0) PG8_BAR; }
        if constexpr (!Epi::AFTER_DRAIN) { E(acc, cur, wr, wc, fr, fq); S.done(cur); }
        if (!has_next) break;
#pragma unroll
        for (int a = 0; a < 2; ++a)
#pragma unroll
            for (int b = 0; b < 2; ++b)
#pragma unroll
                for (int m = 0; m < 4; ++m)
#pragma unroll
                    for (int n = 0; n < 2; ++n) acc[a][b][m][n] = (f32x4){0.f, 0.f, 0.f, 0.f};
        cur = nxt; cA = nA; cB = nB; ++ui;
        if constexpr (ALIGN_EPI) { if (wr == 1) PG8_BAR; }
    }
    PG8_WAIT_V(0);
    if constexpr (!ALIGN_EPI) { if (wr == 0) PG8_BAR; }
    PG8_BAR;
    if constexpr (Epi::AFTER_DRAIN) { E.fused(acc, cur, wr, wc, fr, fq, lds, wid, lane); S.done(cur); }
#undef PG8_SA
#undef PG8_SB
#undef PG8_STAGE
#undef PG8_LDA
#undef PG8_LDB
#undef PG8_MMA
#undef PG8_WAIT_V
#undef PG8_WAIT_L
#undef PG8_BAR
#undef PG8_SCHED
}
}

constexpr int NWAVES = 8;
constexpr int T = 16384, D = 2048, DIN = 8320, NPROJ = 8448;
constexpr int RW_H = 16, RW_N = 64, MB_H = 8, MB_D = 128, MB_BLK = 256, MB_NB = 64, LORA = 64;
constexpr float RMS_EPS = 1e-6f, LNX_EPS = 64e-5f;

constexpr size_t MiB = 1u << 20;
constexpr size_t WS_CTL = 0, CTL_ZERO_BYTES = 1 * MiB;
constexpr size_t WS_KMEAN = 1 * MiB;
constexpr size_t WS_KMEANB = WS_KMEAN + 256 * 1024;
constexpr size_t WS_BSC = 2 * MiB;
constexpr size_t WS_W2T = 4 * MiB;
constexpr size_t WS_ROPE = 12 * MiB;
constexpr size_t WS_W1T = 16 * MiB;
constexpr size_t WS_LIST = 16 * MiB;
constexpr size_t WS_XN = 52 * MiB;
constexpr size_t WS_Y = 52 * MiB;
constexpr size_t WS_PROJ = 116 * MiB;
constexpr size_t GRP = 32 * MiB;
constexpr size_t WS_R = WS_PROJ, WS_K = WS_PROJ + GRP, WS_V = WS_PROJ + 2 * GRP, WS_GR = WS_PROJ + 3 * GRP, WS_GM = WS_PROJ + 4 * GRP,
                 WS_Q = WS_PROJ + 5 * GRP, WS_KM = WS_PROJ + 6 * GRP, WS_VM = WS_PROJ + 7 * GRP;
constexpr size_t WS_WDAD = 372 * MiB;
constexpr size_t WS_PARTO = 376 * MiB;
constexpr size_t WS_PARTML = 504 * MiB;
constexpr size_t WS_ROWSS = 508 * MiB;
constexpr size_t WS_MIXED = WS_Q;
constexpr size_t WS_END = 510 * MiB;
constexpr int CW_BAR = 4096;
constexpr int CW_CNT = 16384;

constexpr int LDS_BYTES = 155648;
constexpr int MISC_OFF = 147456;

#define GAS __attribute__((address_space(1)))
#define LAS __attribute__((address_space(3)))
typedef unsigned short bf16;
typedef unsigned v4u __attribute__((ext_vector_type(4)));
typedef unsigned v2u __attribute__((ext_vector_type(2)));
typedef float f32x4 __attribute__((ext_vector_type(4)));
typedef float f32x2 __attribute__((ext_vector_type(2)));
typedef short bf16x8 __attribute__((ext_vector_type(8)));
typedef short s16x4 __attribute__((ext_vector_type(4)));
typedef GAS unsigned gu32;
#define RLX_AGENT __ATOMIC_RELAXED, __HIP_MEMORY_SCOPE_AGENT
#define LDS_WAIT() asm volatile("s_waitcnt lgkmcnt(0)" ::: "memory")
#define VM_WAIT() asm volatile("s_waitcnt vmcnt(0)" ::: "memory")
typedef __bf16 hwbf2 __attribute__((ext_vector_type(2)));
__device__ __forceinline__ unsigned f2bf(float f) { return (unsigned)__builtin_bit_cast(unsigned short, (__bf16)f); }
__device__ __forceinline__ unsigned pk2(float lo, float hi) { return __builtin_bit_cast(unsigned, __builtin_convertvector((f32x2){lo, hi}, hwbf2)); }
__device__ __forceinline__ float bflo(unsigned w) { return __builtin_bit_cast(float, w << 16); }
__device__ __forceinline__ float bfhi(unsigned w) { return __builtin_bit_cast(float, w & 0xffff0000u); }
__device__ __forceinline__ float bf2f(bf16 b) { return __builtin_bit_cast(float, (unsigned)b << 16); }
__device__ __forceinline__ float sigmoidf_(float x) { return __builtin_amdgcn_rcpf(1.f + __expf(-x)); }

#define XB_TMO      128
#define XB_XCNT(j)  (256  + 64 * (j))
#define XB_XSUB(j)  (1280 + 64 * (j))
#define XB_XGEN(j)  (2304 + 64 * (j))
#define XB_TOP      3328
#define XB_TOPGEN   3392
#define XCD_BAR_WORDS 3456
#define XB_SPIN_CAP (1u << 22)

__device__ __forceinline__ unsigned xb_ld(unsigned* p)              { return __hip_atomic_load(p, __ATOMIC_RELAXED, __HIP_MEMORY_SCOPE_AGENT); }
__device__ __forceinline__ unsigned xb_add(unsigned* p, unsigned v) { return __hip_atomic_fetch_add(p, v, __ATOMIC_RELAXED, __HIP_MEMORY_SCOPE_AGENT); }
__device__ __forceinline__ unsigned xb_xcc_id() { return (unsigned)__builtin_amdgcn_s_getreg((3 << 11) | 20) & 0xFu; }
#define XB_SPIN(cond, bar) do { unsigned _sp = 0; while (cond) { __builtin_amdgcn_s_sleep(1); \
    if ((++_sp & 255u) == 0u) { if (xb_ld(&(bar)[XB_TMO])) break; if (_sp > XB_SPIN_CAP) { atomicAdd(&(bar)[XB_TMO], 1u); break; } } } } while (0)

struct XcdBarrier { unsigned* bar; unsigned x; volatile LAS unsigned* st; };

__device__ __forceinline__ XcdBarrier xcd_barrier_post(unsigned* bar, volatile LAS unsigned* st) {
    XcdBarrier b; b.bar = bar; b.x = xb_xcc_id(); b.st = st;
    if (threadIdx.x == 0) (void)xb_add(&bar[XB_XCNT(b.x)], 1u);
    return b;
}
__device__ __forceinline__ void xcd_barrier_complete(unsigned* bar, unsigned x, unsigned& nloc, unsigned& nx) {
    const unsigned G = gridDim.x * gridDim.y * gridDim.z;
    unsigned sum, cnt, mine, sp = 0u;
    for (;;) {
        sum = 0u; cnt = 0u; mine = 0u;
#pragma unroll
        for (unsigned j = 0; j < 16; ++j) { const unsigned c = xb_ld(&bar[XB_XCNT(j)]); sum += c; cnt += (c > 0u) ? 1u : 0u; mine = (j == x) ? c : mine; }
        if (sum == G) break;
        __builtin_amdgcn_s_sleep(1);
        if ((++sp & 255u) == 0u) { if (xb_ld(&bar[XB_TMO])) break; if (sp > XB_SPIN_CAP) { atomicAdd(&bar[XB_TMO], 1u); break; } }
    }
    nloc = mine > 0u ? mine : 1u; nx = cnt > 0u ? cnt : 1u;
}
__device__ __forceinline__ void xcd_barrier(const XcdBarrier& b) {
    asm volatile("s_waitcnt vmcnt(0)" ::: "memory");
    __syncthreads();
    if (threadIdx.x == 0) {
        unsigned* bar = b.bar;
        __builtin_amdgcn_s_waitcnt(0);
        unsigned nloc = b.st[0], nx = b.st[1];
        if (nloc == 0u) { xcd_barrier_complete(bar, b.x, nloc, nx); b.st[0] = nloc; b.st[1] = nx; }
        const unsigned old = xb_add(&bar[XB_XSUB(b.x)], 1u);
        const unsigned gen = old / nloc;
        if (old + 1u == (gen + 1u) * nloc) {
            __builtin_amdgcn_fence(__ATOMIC_RELEASE, "agent");
            asm volatile("s_waitcnt vmcnt(0)" ::: "memory");
            const unsigned og = xb_add(&bar[XB_TOP], 1u);
            const unsigned tg = og / nx;
            if (og + 1u == (tg + 1u) * nx) xb_add(&bar[XB_TOPGEN], 1u);
            else XB_SPIN(xb_ld(&bar[XB_TOPGEN]) == tg, bar);
            __builtin_amdgcn_fence(__ATOMIC_ACQUIRE, "agent");
            xb_add(&bar[XB_XGEN(b.x)], 1u);
            asm volatile("s_waitcnt vmcnt(0)" ::: "memory");
        } else {
            XB_SPIN(xb_ld(&bar[XB_XGEN(b.x)]) == gen, bar);
            __builtin_amdgcn_fence(__ATOMIC_ACQUIRE, "agent");
            asm volatile("s_waitcnt vmcnt(0)" ::: "memory");
        }
    }
    __syncthreads();
}

struct Frame {
    LAS unsigned char* lds;
    volatile LAS unsigned* MISC;
    gu32* ctl;
    int tid, lane, wave;
    int G, bid;
    unsigned char* ws;
    const float *x, *norm_w, *w_in, *mu_rkv, *mu_lora, *w_decay_up, *w_decay_bias, *w_iclr_up, *w_iclr_bias, *k_k, *k_a, *r_k, *lnx_w, *lnx_b, *w_out, *final_norm_w;
    float* out;
};

__device__ __forceinline__ float wave_sum(float v) {
#pragma unroll
    for (int o = 1; o < 64; o <<= 1) v += __shfl_xor(v, o);
    return v;
}
__device__ __forceinline__ float wave_max(float v) {
#pragma unroll
    for (int o = 1; o < 64; o <<= 1) v = fmaxf(v, __shfl_xor(v, o));
    return v;
}

__device__ __forceinline__ int w1_src_col(int n) {
    if (n < 8192) {
        const int g = n >> 10, w = n & 1023;
        if (g == 5 || g == 6) {
            const int base = (g == 5) ? 4224 : 5248, hh = w >> 7, p = w & 127; int d = p;
            if (p < 32) { const int a = p >> 3, b = p & 7; d = (b < 4) ? (4 * a + b) : (16 + 4 * a + (b - 4)); }
            return base + hh * 128 + d;
        }
        const int base = (g == 0) ? 0 : (g == 1) ? 1024 : (g == 2) ? 2048 : (g == 3) ? 3200 : (g == 4) ? 7296 : 6272;
        return base + w;
    }
    if (n < 8320) return 3072 + (n - 8192);
    return -1;
}
template <bool MAP>
__device__ __forceinline__ void p0_transpose_item(const float* W, const float* rowscale, int K, int N, bf16* WT, int nblk, LAS float* scr, int item, int lane) {
    const int kb = item / nblk, nb = item % nblk, k0 = 64 * kb, n0 = 32 * nb;
    const int nd = n0 + (lane & 31); const int src = MAP ? w1_src_col(nd) : nd;
#pragma unroll 8
    for (int i = 0; i < 32; ++i) { const int kk = 2 * i + (lane >> 5);
        float v = 0.f; if (src >= 0) { v = W[(size_t)(k0 + kk) * N + src]; if (MAP) v *= rowscale[k0 + kk]; }
        scr[kk * 33 + (lane & 31)] = v; }
    LDS_WAIT(); asm volatile("" ::: "memory");
    const int c = lane & 7;
#pragma unroll
    for (int j = 0; j < 4; ++j) { const int n = (lane >> 3) + 8 * j; const LAS float* s = scr + (8 * c) * 33 + n;
        v4u o; o.x = pk2(s[0 * 33], s[1 * 33]); o.y = pk2(s[2 * 33], s[3 * 33]); o.z = pk2(s[4 * 33], s[5 * 33]); o.w = pk2(s[6 * 33], s[7 * 33]);
        *(GAS v4u*)(WT + (size_t)(n0 + n) * K + k0 + 8 * c) = o; }
    LDS_WAIT(); asm volatile("" ::: "memory");
}
__device__ __forceinline__ void rms_row_to_bf16(const float* xrow, bf16* orow, int lane) {
    const GAS f32x4* xr = (const GAS f32x4*)xrow + lane;
    f32x4 v[8]; float s = 0.f;
#pragma unroll
    for (int j = 0; j < 8; ++j) { v[j] = xr[64 * j]; s += (v[j].x * v[j].x + v[j].y * v[j].y) + (v[j].z * v[j].z + v[j].w * v[j].w); }
    const float rs = 1.f / sqrtf(wave_sum(s) * (1.f / D) + RMS_EPS);
    GAS unsigned long long* o8 = (GAS unsigned long long*)orow + lane;
#pragma unroll
    for (int j = 0; j < 8; ++j) o8[64 * j] = (unsigned long long)pk2(v[j].x * rs, v[j].y * rs) | ((unsigned long long)pk2(v[j].z * rs, v[j].w * rs) << 32);
}
__device__ __forceinline__ void p0_prologue(Frame& F) {
    LAS float* scr = (LAS float*)(F.lds + F.wave * 16384);
    const int gw = F.bid * NWAVES + F.wave, NGW = F.G * NWAVES;
    constexpr int I_1 = (D / 64) * (NPROJ / 32), I_2 = (D / 64) * (D / 32);
    for (int it = gw; it < I_1 + I_2; it += NGW) {
        if (it < I_1) p0_transpose_item<true>(F.w_in, F.norm_w, D, DIN, (bf16*)(F.ws + WS_W1T), NPROJ / 32, scr, it, F.lane);
        else p0_transpose_item<false>(F.w_out, nullptr, D, D, (bf16*)(F.ws + WS_W2T), D / 32, scr, it - I_1, F.lane);
    }
    for (int m = gw; m < T; m += NGW) rms_row_to_bf16(F.x + (size_t)m * D, (bf16*)(F.ws + WS_XN) + (size_t)m * D, F.lane);
    { bf16* wdt = (bf16*)(F.ws + 1 * MiB + 512 * 1024); bf16* wit = (bf16*)(F.ws + 1 * MiB + 640 * 1024);
      for (int e = F.bid * 512 + F.tid; e < 1024 * 64; e += F.G * 512) { const int c = e >> 6, l = e & 63; wdt[e] = (bf16)f2bf(F.w_decay_up[(size_t)l * 1024 + c]); wit[e] = (bf16)f2bf(F.w_iclr_up[(size_t)l * 1024 + c]); } }
    { float* rc = (float*)(F.ws + WS_ROPE); float* rsn = rc + (size_t)T * 16;
      for (int e = F.bid * 512 + F.tid; e < T * 16; e += F.G * 512) { const int t = e >> 4, i = e & 15;
          const double invf = exp2(-(double)i * (18.931568569324174 / 16.0));
          const double ang = (double)t * invf; const double n = rint(ang * 0.15915494309189535);
          double r = fma(-n, 6.283185307179586, ang); r = fma(-n, 2.4492935982947064e-16, r);
          const float rf = (float)r; rc[e] = cosf(rf); rsn[e] = sinf(rf); } }
}

__device__ __forceinline__ f32x4 mfma16(bf16x8 a, bf16x8 b, f32x4 c) { return __builtin_amdgcn_mfma_f32_16x16x32_bf16(a, b, c, 0, 0, 0); }
__device__ __forceinline__ int list_off(int h, int j) { return h * 516096 + 256 * (63 * j - (j * (j - 1)) / 2); }

__device__ __forceinline__ void p2_kmean(Frame& F) {
    const bf16* KM = (const bf16*)(F.ws + WS_KM); float* kmean = (float*)(F.ws + WS_KMEAN); bf16* kmeanb = (bf16*)(F.ws + WS_KMEANB);
    LAS float* red = (LAS float*)F.lds;
    const int dp = F.tid & 63, rg = F.tid >> 6;
    for (int u = F.bid; u < MB_NB * MB_H; u += F.G) { const int c = u >> 3, h = u & 7;
        float s0 = 0.f, s1 = 0.f;
        const unsigned* p = (const unsigned*)(KM + (size_t)(c * 256 + rg * 32) * 1024 + 128 * h) + dp;
#pragma unroll 8
        for (int r = 0; r < 32; ++r) { const unsigned w = p[(size_t)r * 512]; s0 += bflo(w); s1 += bfhi(w); }
        red[rg * 128 + 2 * dp] = s0; red[rg * 128 + 2 * dp + 1] = s1;
        __syncthreads();
        if (F.tid < 128) { float s = 0.f;
#pragma unroll
            for (int g = 0; g < 8; ++g) s += red[g * 128 + F.tid];
            s *= (1.f / 256.f); kmean[(size_t)(h * 64 + c) * 128 + F.tid] = s; kmeanb[(size_t)(h * 64 + c) * 128 + F.tid] = (bf16)f2bf(s); }
        __syncthreads();
    }
}

__device__ __forceinline__ void top3_insert(float v, int i, float& v1, int& i1, float& v2, int& i2, float& v3, int& i3) {
    const bool b1 = (v > v1) || (v == v1 && i < i1), b2 = (v > v2) || (v == v2 && i < i2), b3 = (v > v3) || (v == v3 && i < i3);
    const float n3 = b2 ? v2 : (b3 ? v : v3), n2 = b1 ? v1 : (b2 ? v : v2), n1 = b1 ? v : v1;
    const int m3 = b2 ? i2 : (b3 ? i : i3), m2 = b1 ? i1 : (b2 ? i : i2), m1 = b1 ? i : i1;
    v1 = n1; v2 = n2; v3 = n3; i1 = m1; i2 = m2; i3 = m3;
}
__device__ __forceinline__ void p3_gate(Frame& F) {
    const bf16* Q = (const bf16*)(F.ws + WS_Q); const bf16* kmb = (const bf16*)(F.ws + WS_KMEANB);
    unsigned* cnt = (unsigned*)(F.ctl + CW_CNT); int* list = (int*)(F.ws + WS_LIST);
    const int gw = F.bid * NWAVES + F.wave, NGW = F.G * NWAVES, lane = F.lane, qi = lane & 15, g = lane >> 4;
    for (int u = gw; u < (T / 16) * MB_H; u += NGW) { const int qt = u >> 3, h = u & 7, cur = qt >> 4;
        if (cur == 0) continue;
        const int t = qt * 16 + qi;
        bf16x8 qf[4];
#pragma unroll
        for (int ks = 0; ks < 4; ++ks) qf[ks] = *(const bf16x8*)(Q + (size_t)t * 1024 + 128 * h + 32 * ks + 8 * g);
        float v1 = -INFINITY, v2 = -INFINITY, v3 = -INFINITY; int i1 = 1 << 20, i2 = 1 << 20, i3 = 1 << 20;
        const int njt = ((cur - 1) >> 4) + 1;
#pragma unroll
        for (int jt = 0; jt < 4; ++jt) { if (jt < njt) {
            f32x4 acc = (f32x4){0.f, 0.f, 0.f, 0.f};
#pragma unroll
            for (int ks = 0; ks < 4; ++ks) { const bf16x8 a = *(const bf16x8*)(kmb + (size_t)(h * 64 + jt * 16 + qi) * 128 + 32 * ks + 8 * g); acc = mfma16(a, qf[ks], acc); }
#pragma unroll
            for (int r = 0; r < 4; ++r) { const int j = jt * 16 + 4 * g + r; const float v = (j < cur) ? acc[r] : -INFINITY; top3_insert(v, j, v1, i1, v2, i2, v3, i3); }
        } }
#pragma unroll
        for (int o = 16; o <= 32; o <<= 1) {
            const float a1 = __shfl_xor(v1, o), a2 = __shfl_xor(v2, o), a3 = __shfl_xor(v3, o); const int b1 = __shfl_xor(i1, o), b2 = __shfl_xor(i2, o), b3 = __shfl_xor(i3, o);
            top3_insert(a1, b1, v1, i1, v2, i2, v3, i3); top3_insert(a2, b2, v1, i1, v2, i2, v3, i3); top3_insert(a3, b3, v1, i1, v2, i2, v3, i3);
        }
        const int vc = cur < 3 ? cur : 3;
        if (g == 0) {
            if (vc > 0) { const unsigned pos = atomicAdd(&cnt[h * 64 + i1], 1u); list[list_off(h, i1) + pos] = (t << 2) | 0; }
            if (vc > 1) { const unsigned pos = atomicAdd(&cnt[h * 64 + i2], 1u); list[list_off(h, i2) + pos] = (t << 2) | 1; }
            if (vc > 2) { const unsigned pos = atomicAdd(&cnt[h * 64 + i3], 1u); list[list_off(h, i3) + pos] = (t << 2) | 2; }
        }
    }
}

constexpr int KV_STRIDE = 288;
constexpr int KLDS_OFF = 0, VLDS_OFF = 256 * KV_STRIDE, PFX_OFF = MISC_OFF + 1024;
__device__ __forceinline__ void tr_read2(s16x4& r0, s16x4& r1, unsigned a0, unsigned a1) {
    asm volatile("ds_read_b64_tr_b16 %0, %2\n\tds_read_b64_tr_b16 %1, %3\n\ts_waitcnt lgkmcnt(0)" : "=&v"(r0), "=&v"(r1) : "v"(a0), "v"(a1) : "memory"); }

template <int B0, int B1> __device__ __forceinline__ void tr_read16(s16x4 (&r)[16], unsigned base) {
    asm volatile(
        "ds_read_b64_tr_b16 %0, %16 offset:%17\n\tds_read_b64_tr_b16 %1, %16 offset:%18\n\tds_read_b64_tr_b16 %2, %16 offset:%19\n\tds_read_b64_tr_b16 %3, %16 offset:%20\n\t"
        "ds_read_b64_tr_b16 %4, %16 offset:%21\n\tds_read_b64_tr_b16 %5, %16 offset:%22\n\tds_read_b64_tr_b16 %6, %16 offset:%23\n\tds_read_b64_tr_b16 %7, %16 offset:%24\n\t"
        "ds_read_b64_tr_b16 %8, %16 offset:%25\n\tds_read_b64_tr_b16 %9, %16 offset:%26\n\tds_read_b64_tr_b16 %10, %16 offset:%27\n\tds_read_b64_tr_b16 %11, %16 offset:%28\n\t"
        "ds_read_b64_tr_b16 %12, %16 offset:%29\n\tds_read_b64_tr_b16 %13, %16 offset:%30\n\tds_read_b64_tr_b16 %14, %16 offset:%31\n\tds_read_b64_tr_b16 %15, %16 offset:%32\n\t"
        "s_waitcnt lgkmcnt(0)"
        : "=&v"(r[0]), "=&v"(r[1]), "=&v"(r[2]), "=&v"(r[3]), "=&v"(r[4]), "=&v"(r[5]), "=&v"(r[6]), "=&v"(r[7]), "=&v"(r[8]), "=&v"(r[9]), "=&v"(r[10]), "=&v"(r[11]), "=&v"(r[12]), "=&v"(r[13]), "=&v"(r[14]), "=&v"(r[15])
        : "v"(base), "i"(B0), "i"(B0 + 32), "i"(B0 + 64), "i"(B0 + 96), "i"(B0 + 128), "i"(B0 + 160), "i"(B0 + 192), "i"(B0 + 224),
          "i"(B1), "i"(B1 + 32), "i"(B1 + 64), "i"(B1 + 96), "i"(B1 + 128), "i"(B1 + 160), "i"(B1 + 192), "i"(B1 + 224)
        : "memory");
}
template <int S> __device__ __forceinline__ void pv_step(const f32x4& p0, const f32x4& p1, f32x4 (&o)[8], unsigned vb) {
    const v4u w = (v4u){pk2(p0[0], p0[1]), pk2(p0[2], p0[3]), pk2(p1[0], p1[1]), pk2(p1[2], p1[3])}; const bf16x8 pf = __builtin_bit_cast(bf16x8, w);
    s16x4 r[16]; tr_read16<32 * S * KV_STRIDE, (32 * S + 16) * KV_STRIDE>(r, vb);
#pragma unroll
    for (int dt = 0; dt < 8; ++dt) { const bf16x8 a = (bf16x8){r[dt][0], r[dt][1], r[dt][2], r[dt][3], r[8 + dt][0], r[8 + dt][1], r[8 + dt][2], r[8 + dt][3]}; o[dt] = mfma16(a, pf, o[dt]); }
}

__device__ __forceinline__ void p4_attn_items(Frame& F) {
    const bf16* Q = (const bf16*)(F.ws + WS_Q); const bf16* KM = (const bf16*)(F.ws + WS_KM); const bf16* VM = (const bf16*)(F.ws + WS_VM);
    const unsigned* cnt = (const unsigned*)(F.ctl + CW_CNT); const int* list = (const int*)(F.ws + WS_LIST);
    bf16* parto = (bf16*)(F.ws + WS_PARTO); float* partml = (float*)(F.ws + WS_PARTML);
    LAS int* pfx = (LAS int*)(F.lds + PFX_OFF);
    const int lane = F.lane, qi = lane & 15, g = lane >> 4, wv = F.wave;
    { LAS int* tmp = (LAS int*)(F.lds + PFX_OFF + 2560);
      const int c = (int)__hip_atomic_load(cnt + F.tid, RLX_AGENT); int val = ((c + 127) >> 7) + 2;
      __syncthreads();
      for (int d = 1; d < 512; d <<= 1) { tmp[F.tid] = val; __syncthreads(); if (F.tid >= d) val += tmp[F.tid - d]; __syncthreads(); }
      pfx[1 + F.tid] = val; if (F.tid == 0) pfx[0] = 0; }
    __syncthreads();
    const int total = pfx[512];
    const int per = (total + F.G - 1) / F.G, lo = F.bid * per, hi = (lo + per < total) ? lo + per : total;
    int u = 0; { int a = 0, b = 512; while (b - a > 1) { const int mid = (a + b) >> 1; if (pfx[mid] <= lo) a = mid; else b = mid; } u = a; }
    int loaded = -1;
    const float scale = 0.08838834764831845f;
    for (int it = lo; it < hi; ++it) {
        while (it >= pfx[u + 1]) ++u;
        const int h = u >> 6, j = u & 63, tl = it - pfx[u], nsel = pfx[u + 1] - pfx[u] - 2;
        if (u != loaded) {
            __syncthreads();
#pragma unroll
            for (int i = 0; i < 8; ++i) { const int pz = F.tid + 512 * i, row = pz >> 4, cc = pz & 15;
                const v4u kv = *(const GAS v4u*)(KM + (size_t)(256 * j + row) * 1024 + 128 * h + 8 * cc); const v4u vv = *(const GAS v4u*)(VM + (size_t)(256 * j + row) * 1024 + 128 * h + 8 * cc);
                *(LAS v4u*)(F.lds + KLDS_OFF + row * KV_STRIDE + 16 * cc) = kv; *(LAS v4u*)(F.lds + VLDS_OFF + row * KV_STRIDE + 16 * cc) = vv; }
            __syncthreads();
            loaded = u;
        }
        const bool own = tl >= nsel; const int hf = tl - nsel;
        int t, slot; bool valid = true;
        if (own) { t = 256 * j + 128 * hf + 16 * wv + qi; slot = 3; }
        else { const int n = (int)__hip_atomic_load(cnt + u, RLX_AGENT); int e = tl * 128 + 16 * wv + qi; valid = e < n; if (!valid) e = n - 1; const int en = list[list_off(h, j) + e]; t = en >> 2; slot = en & 3; }
        const int nkt = own ? (8 * hf + wv + 1) : 16;
        bf16x8 qf[4];
#pragma unroll
        for (int ks = 0; ks < 4; ++ks) qf[ks] = *(const bf16x8*)(Q + (size_t)t * 1024 + 128 * h + 32 * ks + 8 * g);
        f32x4 acc[16];
#pragma unroll
        for (int kt = 0; kt < 16; ++kt) { acc[kt] = (f32x4){0.f, 0.f, 0.f, 0.f};
            if (kt < nkt) {
#pragma unroll
                for (int ks = 0; ks < 4; ++ks) { const bf16x8 a = *(const LAS bf16x8*)(F.lds + KLDS_OFF + (16 * kt + qi) * KV_STRIDE + 64 * ks + 16 * g); acc[kt] = mfma16(a, qf[ks], acc[kt]); } } }
        const int tq = t - 256 * j;
        float m = -INFINITY;
#pragma unroll
        for (int kt = 0; kt < 16; ++kt)
#pragma unroll
            for (int r = 0; r < 4; ++r) { float s = acc[kt][r] * scale; const int key = 16 * kt + 4 * g + r; if (kt >= nkt || (own && key > tq)) s = -INFINITY; acc[kt][r] = s; m = fmaxf(m, s); }
        m = fmaxf(m, __shfl_xor(m, 16)); m = fmaxf(m, __shfl_xor(m, 32));
        float l = 0.f;
#pragma unroll
        for (int kt = 0; kt < 16; ++kt)
#pragma unroll
            for (int r = 0; r < 4; ++r) { const float p = __expf(acc[kt][r] - m); acc[kt][r] = p; l += p; }
        l += __shfl_xor(l, 16); l += __shfl_xor(l, 32);
        f32x4 o[8];
#pragma unroll
        for (int dt = 0; dt < 8; ++dt) o[dt] = (f32x4){0.f, 0.f, 0.f, 0.f};
        const unsigned vb0 = (unsigned)(VLDS_OFF + (4 * g + (qi >> 2)) * KV_STRIDE + 8 * (qi & 3)), vb1 = vb0 + 128u * KV_STRIDE;
        if (0 < nkt) pv_step<0>(acc[0], acc[1], o, vb0);
        if (2 < nkt) pv_step<1>(acc[2], acc[3], o, vb0);
        if (4 < nkt) pv_step<2>(acc[4], acc[5], o, vb0);
        if (6 < nkt) pv_step<3>(acc[6], acc[7], o, vb0);
        if (8 < nkt) pv_step<0>(acc[8], acc[9], o, vb1);
        if (10 < nkt) pv_step<1>(acc[10], acc[11], o, vb1);
        if (12 < nkt) pv_step<2>(acc[12], acc[13], o, vb1);
        if (14 < nkt) pv_step<3>(acc[14], acc[15], o, vb1);
        if (valid) { const float il = 1.f / l; const size_t pb = ((size_t)t * 8 + h) * 4 + slot;
#pragma unroll
            for (int dt = 0; dt < 8; ++dt) { v2u w; w.x = pk2(o[dt][0] * il, o[dt][1] * il); w.y = pk2(o[dt][2] * il, o[dt][3] * il); *(GAS v2u*)(parto + pb * 128 + 16 * dt + 4 * g) = w; }
            if (g == 0) { f32x2 ml; ml.x = m; ml.y = l; *(GAS f32x2*)(partml + pb * 2) = ml; } }
    }
}

__device__ __forceinline__ void p5_combine(Frame& F) {
    const bf16* parto = (const bf16*)(F.ws + WS_PARTO); const float* partml = (const float*)(F.ws + WS_PARTML); const bf16* GM = (const bf16*)(F.ws + WS_GM);
    bf16* mixed = (bf16*)(F.ws + WS_MIXED);
    const int gw = F.bid * NWAVES + F.wave, NGW = F.G * NWAVES, sub = F.lane >> 4, d0 = 8 * (F.lane & 15);
    for (int pq = gw; pq < T * MB_H / 4; pq += NGW) { const int pr = pq * 4 + sub, t = pr >> 3, h = pr & 7, cur = t >> 8, vc = cur < 3 ? cur : 3;
        float mm[4], ll[4]; float M = -INFINITY;
#pragma unroll
        for (int s = 0; s < 4; ++s) { const bool on = (s == 3) || (s < vc); f32x2 ml = (f32x2){-INFINITY, 0.f}; if (on) ml = *(const GAS f32x2*)(partml + ((size_t)pr * 4 + s) * 2); mm[s] = ml.x; ll[s] = ml.y; M = fmaxf(M, ml.x); }
        float acc[8]; float W = 0.f;
#pragma unroll
        for (int e = 0; e < 8; ++e) acc[e] = 0.f;
#pragma unroll
        for (int s = 0; s < 4; ++s) { const bool on = (s == 3) || (s < vc); if (on) { const float w = __expf(mm[s] - M) * ll[s]; W += w;
            const v4u ov = *(const GAS v4u*)(parto + ((size_t)pr * 4 + s) * 128 + d0);
            acc[0] += w * bflo(ov.x); acc[1] += w * bfhi(ov.x); acc[2] += w * bflo(ov.y); acc[3] += w * bfhi(ov.y); acc[4] += w * bflo(ov.z); acc[5] += w * bfhi(ov.z); acc[6] += w * bflo(ov.w); acc[7] += w * bfhi(ov.w); } }
        const float iw = 1.f / W;
        const v4u gv = *(const GAS v4u*)(GM + (size_t)t * 1024 + 128 * h + d0);
        const float gg[8] = {bflo(gv.x), bfhi(gv.x), bflo(gv.y), bfhi(gv.y), bflo(gv.z), bfhi(gv.z), bflo(gv.w), bfhi(gv.w)};
        float r[8];
#pragma unroll
        for (int e = 0; e < 8; ++e) r[e] = acc[e] * iw * gg[e] * sigmoidf_(gg[e]);
        v4u w; w.x = pk2(r[0], r[1]); w.y = pk2(r[2], r[3]); w.z = pk2(r[4], r[5]); w.w = pk2(r[6], r[7]);
        *(GAS v4u*)(mixed + (size_t)t * 2048 + 1024 + 128 * h + d0) = w;
    }
}

constexpr size_t WS_SR = 52 * MiB;
constexpr size_t WS_SA = 16 * MiB;
constexpr size_t WS_SK = 376 * MiB;
constexpr size_t WS_SV = 440 * MiB;
constexpr size_t WS_SB = WS_GM;
constexpr size_t WS_SW = WS_VM;
constexpr size_t WS_YS = WS_R;

__device__ __forceinline__ void p6_rwkv_prep(Frame& F) {
    const bf16* R = (const bf16*)(F.ws + WS_R); const bf16* K = (const bf16*)(F.ws + WS_K); const bf16* V = (const bf16*)(F.ws + WS_V); const bf16* WDAD = (const bf16*)(F.ws + WS_WDAD);
    float* SR = (float*)(F.ws + WS_SR); float* SK = (float*)(F.ws + WS_SK); float* SV = (float*)(F.ws + WS_SV);
    bf16* SA = (bf16*)(F.ws + WS_SA); bf16* SB = (bf16*)(F.ws + WS_SB); bf16* SW = (bf16*)(F.ws + WS_SW); float* BSC = (float*)(F.ws + WS_BSC);
    LAS float* WD = (LAS float*)(F.lds);
    LAS float* WI = (LAS float*)(F.lds + 16384);
    LAS float* Rs = (LAS float*)(F.lds + 32768);
    LAS float* Ks = (LAS float*)(F.lds + 49152);
    LAS float* TW = (LAS float*)(F.lds + 65536);
    LAS float* AD = (LAS float*)(F.lds + 81920);
    constexpr int NU = RW_H * (T / 64);
    const int upw = (NU + F.G - 1) / F.G;
    const int c = F.tid & 63, tg = F.tid >> 6;
    int hl_ = -1; float kkc = 0.f, kac = 0.f, rkc = 0.f, wb = 0.f, ib = 0.f;
    for (int ui = 0; ui < upw; ++ui) { const int u = F.bid * upw + ui; if (u >= NU) break; const int h = u / (T / 64), chunk = u % (T / 64), t0 = chunk * 64, ch = 64 * h + c;
        __syncthreads();
        if (h != hl_) { hl_ = h;
            for (int e = F.tid; e < 64 * 64; e += 512) { const int l = e >> 6, cc = e & 63; WD[e] = F.w_decay_up[(size_t)l * 1024 + 64 * h + cc]; WI[e] = F.w_iclr_up[(size_t)l * 1024 + 64 * h + cc]; }
            kkc = F.k_k[ch]; kac = F.k_a[ch]; rkc = F.r_k[ch]; wb = F.w_decay_bias[ch]; ib = F.w_iclr_bias[ch]; }
        { const int row = F.tid >> 3, cv = F.tid & 7, t = t0 + row; const size_t o = (size_t)t * 1024 + 64 * h + 8 * cv;
          const v4u z = (v4u){0u, 0u, 0u, 0u};
          const v4u rc = *(const GAS v4u*)(R + o), kc = *(const GAS v4u*)(K + o), vc = *(const GAS v4u*)(V + o);
          const v4u rp = t > 0 ? *(const GAS v4u*)(R + o - 1024) : z, kp = t > 0 ? *(const GAS v4u*)(K + o - 1024) : z, vp = t > 0 ? *(const GAS v4u*)(V + o - 1024) : z;
          const unsigned rcw[4] = {rc.x, rc.y, rc.z, rc.w}, rpw[4] = {rp.x, rp.y, rp.z, rp.w}, kcw[4] = {kc.x, kc.y, kc.z, kc.w}, kpw[4] = {kp.x, kp.y, kp.z, kp.w}, vcw[4] = {vc.x, vc.y, vc.z, vc.w}, vpw[4] = {vp.x, vp.y, vp.z, vp.w};
          float vs[8];
#pragma unroll
          for (int q = 0; q < 4; ++q) {
#pragma unroll
              for (int hl = 0; hl < 2; ++hl) { const int cc = 8 * cv + 2 * q + hl, chn = 64 * h + cc;
                  const float r0 = hl ? bfhi(rcw[q]) : bflo(rcw[q]), r1 = hl ? bfhi(rpw[q]) : bflo(rpw[q]);
                  const float k0 = hl ? bfhi(kcw[q]) : bflo(kcw[q]), k1 = hl ? bfhi(kpw[q]) : bflo(kpw[q]);
                  const float v0 = hl ? bfhi(vcw[q]) : bflo(vcw[q]), v1 = hl ? bfhi(vpw[q]) : bflo(vpw[q]);
                  Rs[row * 64 + cc] = r0 + F.mu_rkv[chn] * (r1 - r0); Ks[row * 64 + cc] = k0 + F.mu_rkv[1024 + chn] * (k1 - k0); vs[2 * q + hl] = v0 + F.mu_rkv[2048 + chn] * (v1 - v0); } }
          *(GAS f32x4*)(SV + o) = (f32x4){vs[0], vs[1], vs[2], vs[3]}; *(GAS f32x4*)(SV + o + 4) = (f32x4){vs[4], vs[5], vs[6], vs[7]};
#pragma unroll
          for (int part = 0; part < 2; ++part) { const int lv = 8 * cv + 64 * part;
              const v4u wc4 = *(const GAS v4u*)(WDAD + (size_t)t * 128 + lv); const v4u wp4 = t > 0 ? *(const GAS v4u*)(WDAD + (size_t)(t - 1) * 128 + lv) : z;
              const unsigned cw[4] = {wc4.x, wc4.y, wc4.z, wc4.w}, pw[4] = {wp4.x, wp4.y, wp4.z, wp4.w};
#pragma unroll
              for (int q = 0; q < 4; ++q)
#pragma unroll
                  for (int hl = 0; hl < 2; ++hl) { const int l = 8 * cv + 2 * q + hl; const float x0 = hl ? bfhi(cw[q]) : bflo(cw[q]), x1 = hl ? bfhi(pw[q]) : bflo(pw[q]);
                      const float xs = x0 + F.mu_lora[64 * part + l] * (x1 - x0);
                      if (part == 0) TW[row * 64 + l] = tanhf(xs); else AD[row * 64 + l] = xs; } } }
        __syncthreads();
        float aw[8], ai[8];
#pragma unroll
        for (int r = 0; r < 8; ++r) { aw[r] = 0.f; ai[r] = 0.f; }
        for (int l4 = 0; l4 < 16; ++l4) {
            const float wd0 = WD[(4 * l4 + 0) * 64 + c], wd1 = WD[(4 * l4 + 1) * 64 + c], wd2 = WD[(4 * l4 + 2) * 64 + c], wd3 = WD[(4 * l4 + 3) * 64 + c];
            const float wi0 = WI[(4 * l4 + 0) * 64 + c], wi1 = WI[(4 * l4 + 1) * 64 + c], wi2 = WI[(4 * l4 + 2) * 64 + c], wi3 = WI[(4 * l4 + 3) * 64 + c];
#pragma unroll
            for (int r = 0; r < 8; ++r) { const f32x4 tw = *(const LAS f32x4*)(TW + (8 * tg + r) * 64 + 4 * l4); const f32x4 ad = *(const LAS f32x4*)(AD + (8 * tg + r) * 64 + 4 * l4);
                aw[r] += tw.x * wd0 + tw.y * wd1 + tw.z * wd2 + tw.w * wd3; ai[r] += ad.x * wi0 + ad.y * wi1 + ad.z * wi2 + ad.w * wi3; }
        }
#pragma unroll
        for (int r = 0; r < 8; ++r) { const int row = 8 * tg + r, t = t0 + row; const size_t o = (size_t)t * 1024 + ch;
            const float lw = -0.6065306597126334f * sigmoidf_(wb + aw[r]);
            const float ic = sigmoidf_(ib + ai[r]);
            const float kr = Ks[row * 64 + c], rr = Rs[row * 64 + c];
            const float kk = kr * kkc; const float nrm = sqrtf(wave_sum(kk * kk)); const float kkn = kk / fmaxf(nrm, 1e-12f);
            const float kp = kr * (1.f + (ic - 1.f) * kac);
            const float bs = wave_sum(rr * kp * rkc);
            SR[o] = rr; SK[o] = kp; SA[o] = (bf16)f2bf(-kkn); SB[o] = (bf16)f2bf(kkn * ic); SW[o] = (bf16)f2bf(lw);
            if (c == 0) BSC[(size_t)t * 16 + h] = bs; }
    }
}

__device__ __forceinline__ float dpp_add16(float x) {
    x += __builtin_bit_cast(float, __builtin_amdgcn_update_dpp(0, __builtin_bit_cast(int, x), 0xB1, 0xf, 0xf, false));
    x += __builtin_bit_cast(float, __builtin_amdgcn_update_dpp(0, __builtin_bit_cast(int, x), 0x4E, 0xf, 0xf, false));
    x += __builtin_bit_cast(float, __builtin_amdgcn_update_dpp(0, __builtin_bit_cast(int, x), 0x141, 0xf, 0xf, false));
    x += __builtin_bit_cast(float, __builtin_amdgcn_update_dpp(0, __builtin_bit_cast(int, x), 0x140, 0xf, 0xf, false));
    return x;
}
constexpr int SC_CH = 64;
__device__ __forceinline__ void p7_rwkv_scan(Frame& F) {
    if (F.bid >= 32) return;
    const float* SR = (const float*)(F.ws + WS_SR); const float* SK = (const float*)(F.ws + WS_SK); const float* SV = (const float*)(F.ws + WS_SV);
    const bf16* SA = (const bf16*)(F.ws + WS_SA); const bf16* SB = (const bf16*)(F.ws + WS_SB); const bf16* SW = (const bf16*)(F.ws + WS_SW); float* Y = (float*)(F.ws + WS_YS);
    const int h = F.bid >> 1, i0 = 32 * (F.bid & 1);
    LAS float* Lr = (LAS float*)(F.lds);
    LAS float* Lk = (LAS float*)(F.lds + 16384);
    LAS float* La = (LAS float*)(F.lds + 32768);
    LAS float* Lb = (LAS float*)(F.lds + 49152);
    LAS float* Lw = (LAS float*)(F.lds + 65536);
    LAS float* Lv = (LAS float*)(F.lds + 81920);
    const int jg = F.lane & 15, rl = 4 * F.wave + (F.lane >> 4);
    f32x4 st = (f32x4){0.f, 0.f, 0.f, 0.f};
    const int srow = F.tid >> 3, scv = F.tid & 7;
    for (int t0 = 0; t0 < T; t0 += SC_CH) {
        __syncthreads();
        { const size_t o = (size_t)(t0 + srow) * 1024 + 64 * h + 8 * scv;
          const f32x4 r0 = *(const GAS f32x4*)(SR + o), r1 = *(const GAS f32x4*)(SR + o + 4), k0 = *(const GAS f32x4*)(SK + o), k1 = *(const GAS f32x4*)(SK + o + 4);
          const v4u a4 = *(const GAS v4u*)(SA + o), b4 = *(const GAS v4u*)(SB + o), w4 = *(const GAS v4u*)(SW + o);
          const f32x4 vv = *(const GAS f32x4*)(SV + (size_t)(t0 + srow) * 1024 + 64 * h + i0 + 4 * scv);
          LAS float* d = Lr + srow * 64 + 8 * scv; *(LAS f32x4*)d = r0; *(LAS f32x4*)(d + 4) = r1;
          d = Lk + srow * 64 + 8 * scv; *(LAS f32x4*)d = k0; *(LAS f32x4*)(d + 4) = k1;
          d = La + srow * 64 + 8 * scv; *(LAS f32x4*)d = (f32x4){bflo(a4.x), bfhi(a4.x), bflo(a4.y), bfhi(a4.y)}; *(LAS f32x4*)(d + 4) = (f32x4){bflo(a4.z), bfhi(a4.z), bflo(a4.w), bfhi(a4.w)};
          d = Lb + srow * 64 + 8 * scv; *(LAS f32x4*)d = (f32x4){bflo(b4.x), bfhi(b4.x), bflo(b4.y), bfhi(b4.y)}; *(LAS f32x4*)(d + 4) = (f32x4){bflo(b4.z), bfhi(b4.z), bflo(b4.w), bfhi(b4.w)};
          d = Lw + srow * 64 + 8 * scv; *(LAS f32x4*)d = (f32x4){__expf(bflo(w4.x)), __expf(bfhi(w4.x)), __expf(bflo(w4.y)), __expf(bfhi(w4.y))}; *(LAS f32x4*)(d + 4) = (f32x4){__expf(bflo(w4.z)), __expf(bfhi(w4.z)), __expf(bflo(w4.w)), __expf(bfhi(w4.w))};
          *(LAS f32x4*)(Lv + srow * 32 + 4 * scv) = vv; }
        __syncthreads();
#pragma unroll 2
        for (int s = 0; s < SC_CH; ++s) {
            const f32x4 a = *(const LAS f32x4*)(La + s * 64 + 4 * jg), b = *(const LAS f32x4*)(Lb + s * 64 + 4 * jg), w = *(const LAS f32x4*)(Lw + s * 64 + 4 * jg);
            const f32x4 k = *(const LAS f32x4*)(Lk + s * 64 + 4 * jg), r = *(const LAS f32x4*)(Lr + s * 64 + 4 * jg); const float vi = Lv[s * 32 + rl];
            const float sa = dpp_add16((st.x * a.x + st.y * a.y) + (st.z * a.z + st.w * a.w));
            st = st * w + (b * sa + k * vi);
            const float y = dpp_add16((st.x * r.x + st.y * r.y) + (st.z * r.z + st.w * r.w));
            if (jg == 0) Y[(size_t)(t0 + s) * 1024 + 64 * h + i0 + rl] = y;
        }
    }
}

__device__ __forceinline__ void p8_rwkv_final(Frame& F) {
    const float* Y = (const float*)(F.ws + WS_YS); const float* SV = (const float*)(F.ws + WS_SV); const float* BSC = (const float*)(F.ws + WS_BSC); const bf16* GR = (const bf16*)(F.ws + WS_GR);
    bf16* mixed = (bf16*)(F.ws + WS_MIXED);
    const int gw = F.bid * NWAVES + F.wave, NGW = F.G * NWAVES, c0 = 16 * F.lane, hd = F.lane >> 2;
    for (int t = gw; t < T; t += NGW) {
        float y[16]; float s = 0.f;
#pragma unroll
        for (int q = 0; q < 4; ++q) { const f32x4 v = *(const GAS f32x4*)(Y + (size_t)t * 1024 + c0 + 4 * q); y[4 * q] = v.x; y[4 * q + 1] = v.y; y[4 * q + 2] = v.z; y[4 * q + 3] = v.w; s += (v.x + v.y) + (v.z + v.w); }
        s += __shfl_xor(s, 1); s += __shfl_xor(s, 2);
        const float mean = s * (1.f / 64.f); float q2 = 0.f;
#pragma unroll
        for (int e = 0; e < 16; ++e) { y[e] -= mean; q2 += y[e] * y[e]; }
        q2 += __shfl_xor(q2, 1); q2 += __shfl_xor(q2, 2);
        const float rstd = 1.f / sqrtf(q2 * (1.f / 64.f) + LNX_EPS);
        const float bs = BSC[(size_t)t * 16 + hd];
        const v4u g0 = *(const GAS v4u*)(GR + (size_t)t * 1024 + c0), g1 = *(const GAS v4u*)(GR + (size_t)t * 1024 + c0 + 8);
        const float gg[16] = {bflo(g0.x), bfhi(g0.x), bflo(g0.y), bfhi(g0.y), bflo(g0.z), bfhi(g0.z), bflo(g0.w), bfhi(g0.w), bflo(g1.x), bfhi(g1.x), bflo(g1.y), bfhi(g1.y), bflo(g1.z), bfhi(g1.z), bflo(g1.w), bfhi(g1.w)};
        float r[16];
#pragma unroll
        for (int q = 0; q < 4; ++q) { const f32x4 v = *(const GAS f32x4*)(SV + (size_t)t * 1024 + c0 + 4 * q); const f32x4 lw = *(const GAS f32x4*)(F.lnx_w + c0 + 4 * q), lb = *(const GAS f32x4*)(F.lnx_b + c0 + 4 * q);
            const float vv[4] = {v.x, v.y, v.z, v.w}, lww[4] = {lw.x, lw.y, lw.z, lw.w}, lbb[4] = {lb.x, lb.y, lb.z, lb.w};
#pragma unroll
            for (int e = 0; e < 4; ++e) { const int i = 4 * q + e; const float o = y[i] * rstd * lww[e] + lbb[e] + bs * vv[e]; r[i] = o * gg[i] * sigmoidf_(gg[i]); } }
        v4u w0, w1; w0.x = pk2(r[0], r[1]); w0.y = pk2(r[2], r[3]); w0.z = pk2(r[4], r[5]); w0.w = pk2(r[6], r[7]); w1.x = pk2(r[8], r[9]); w1.y = pk2(r[10], r[11]); w1.z = pk2(r[12], r[13]); w1.w = pk2(r[14], r[15]);
        *(GAS v4u*)(mixed + (size_t)t * 2048 + c0) = w0; *(GAS v4u*)(mixed + (size_t)t * 2048 + c0 + 8) = w1;
    }
}

constexpr size_t WS_WDT = 1 * MiB + 512 * 1024;
constexpr size_t WS_WIT = 1 * MiB + 640 * 1024;
constexpr size_t WS_PB = 16 * MiB;
constexpr size_t WS_QC = 52 * MiB;
constexpr size_t WS_HT = 84 * MiB;
constexpr size_t WS_GT = 376 * MiB;
constexpr size_t WS_Y0T = 440 * MiB;
constexpr int IMS = 144;
constexpr int L_AT = 0, L_RT = 9216, L_BT = 18432, L_KT = 27648, L_BHT = 36864, L_KHT = 46080, L_VT = 55296, L_XT = 64512;
constexpr int L_RA = 82944;
constexpr int L_TW = L_RA, L_AD = L_RA + 9216, L_WP = L_RA + 18432, L_AP = L_WP + 16640;
constexpr int L_LAB = L_RA, L_LAK = L_RA + 17408, L_MRB = L_LAK + 9216, L_MRK = L_MRB + 9216, L_TII = L_MRK + 9216;
constexpr int L_CUMP = 134656, L_GC = L_CUMP + 2048;

__device__ __forceinline__ f32x4 mfma4f(float a, float b, f32x4 c) { return __builtin_amdgcn_mfma_f32_16x16x4f32(a, b, c, 0, 0, 0); }
__device__ __forceinline__ bf16x8 lds_frag(LAS unsigned char* img, int row, int ks, int g) { return *(const LAS bf16x8*)(img + row * IMS + 64 * ks + 16 * g); }

__device__ __forceinline__ float wave_sum_dpp(float x) {
    x = dpp_add16(x);
    x += __builtin_bit_cast(float, __builtin_amdgcn_update_dpp(0, __builtin_bit_cast(int, x), 0x142, 0xa, 0xf, false));
    x += __builtin_bit_cast(float, __builtin_amdgcn_update_dpp(0, __builtin_bit_cast(int, x), 0x143, 0xc, 0xf, false));
    return __builtin_bit_cast(float, __builtin_amdgcn_readlane(__builtin_bit_cast(int, x), 63));
}
struct R1In { v4u wd0, wd1, wp0, wp1, rc, rp, kc, kp, vc, vp; };
__device__ __forceinline__ void r1_load(Frame& F, int h, int chunk, R1In& in) {
    const bf16* R = (const bf16*)(F.ws + WS_R); const bf16* K = (const bf16*)(F.ws + WS_K); const bf16* V = (const bf16*)(F.ws + WS_V); const bf16* WDAD = (const bf16*)(F.ws + WS_WDAD);
    const int row = F.tid >> 3, cv = F.tid & 7, t = chunk * 64 + row; const size_t o = (size_t)t * 1024 + 64 * h + 8 * cv; const v4u z4 = (v4u){0u, 0u, 0u, 0u};
    in.wd0 = *(const GAS v4u*)(WDAD + (size_t)t * 128 + 8 * cv); in.wd1 = *(const GAS v4u*)(WDAD + (size_t)t * 128 + 64 + 8 * cv);
    in.rc = *(const GAS v4u*)(R + o); in.kc = *(const GAS v4u*)(K + o); in.vc = *(const GAS v4u*)(V + o);
    if (t > 0) { in.wp0 = *(const GAS v4u*)(WDAD + (size_t)(t - 1) * 128 + 8 * cv); in.wp1 = *(const GAS v4u*)(WDAD + (size_t)(t - 1) * 128 + 64 + 8 * cv);
        in.rp = *(const GAS v4u*)(R + o - 1024); in.kp = *(const GAS v4u*)(K + o - 1024); in.vp = *(const GAS v4u*)(V + o - 1024); }
    else { in.wp0 = z4; in.wp1 = z4; in.rp = z4; in.kp = z4; in.vp = z4; }
}
constexpr int L_RS = L_AT, L_KS = L_BT, L_VS = L_BHT;

__device__ __forceinline__ void r1_unit(Frame& F, int h, int chunk, R1In& in, const bf16x8 (&wfr)[2][2][2], int un) {
    float* BSC = (float*)(F.ws + WS_BSC);
    LAS unsigned char* L = F.lds;
    int tid = F.tid; asm volatile("" : "+v"(tid));
    const int t0 = chunk * 64, u = h * 256 + chunk, lane = tid & 63, wv = __builtin_amdgcn_readfirstlane(tid >> 6), fr = lane & 15, g = lane >> 4;
    __syncthreads();
    { const int row = tid >> 3, cv = tid & 7;
#pragma unroll
      for (int part = 0; part < 2; ++part) { const v4u wc4 = part ? in.wd1 : in.wd0, wp4 = part ? in.wp1 : in.wp0;
          const unsigned cw[4] = {wc4.x, wc4.y, wc4.z, wc4.w}, pw[4] = {wp4.x, wp4.y, wp4.z, wp4.w}; unsigned ow[4];
#pragma unroll
          for (int q = 0; q < 4; ++q) { float xs[2];
#pragma unroll
              for (int hl = 0; hl < 2; ++hl) { const int l = 8 * cv + 2 * q + hl; const float x0 = hl ? bfhi(cw[q]) : bflo(cw[q]), x1 = hl ? bfhi(pw[q]) : bflo(pw[q]);
                  xs[hl] = x0 + F.mu_lora[64 * part + l] * (x1 - x0); if (part == 0) { const float e2 = __expf(2.f * xs[hl]); xs[hl] = 1.f - 2.f / (e2 + 1.f); } }
              ow[q] = pk2(xs[0], xs[1]); }
          *(LAS v4u*)(L + (part == 0 ? L_TW : L_AD) + row * IMS + 16 * cv) = (v4u){ow[0], ow[1], ow[2], ow[3]}; }
      const unsigned rcw[4] = {in.rc.x, in.rc.y, in.rc.z, in.rc.w}, rpw[4] = {in.rp.x, in.rp.y, in.rp.z, in.rp.w}, kcw[4] = {in.kc.x, in.kc.y, in.kc.z, in.kc.w}, kpw[4] = {in.kp.x, in.kp.y, in.kp.z, in.kp.w},
                     vcw[4] = {in.vc.x, in.vc.y, in.vc.z, in.vc.w}, vpw[4] = {in.vp.x, in.vp.y, in.vp.z, in.vp.w};
#pragma unroll
      for (int q = 0; q < 4; ++q)
#pragma unroll
          for (int hl = 0; hl < 2; ++hl) { const int cc = 8 * cv + 2 * q + hl, chn = 64 * h + cc;
              const float r0 = hl ? bfhi(rcw[q]) : bflo(rcw[q]), r1 = hl ? bfhi(rpw[q]) : bflo(rpw[q]), k0 = hl ? bfhi(kcw[q]) : bflo(kcw[q]), k1 = hl ? bfhi(kpw[q]) : bflo(kpw[q]);
              const float v0 = hl ? bfhi(vcw[q]) : bflo(vcw[q]), v1 = hl ? bfhi(vpw[q]) : bflo(vpw[q]);
              ((LAS float*)(L + L_RS))[row * 65 + cc] = r0 + F.mu_rkv[chn] * (r1 - r0); ((LAS float*)(L + L_KS))[row * 65 + cc] = k0 + F.mu_rkv[1024 + chn] * (k1 - k0);
              ((LAS float*)(L + L_VS))[row * 65 + cc] = v0 + F.mu_rkv[2048 + chn] * (v1 - v0); } }
    if (un >= 0) r1_load(F, un >> 8, un & 255, in);
    __syncthreads();
    { const int tr = wv >> 1;
#pragma unroll
      for (int prod = 0; prod < 2; ++prod) { LAS unsigned char* aimg = L + (prod == 0 ? L_TW : L_AD); LAS float* o = (LAS float*)(L + (prod == 0 ? L_WP : L_AP));
#pragma unroll
          for (int cc = 0; cc < 2; ++cc) { const int ct = (wv & 1) * 2 + cc; f32x4 acc = (f32x4){0.f, 0.f, 0.f, 0.f};
#pragma unroll
              for (int ks = 0; ks < 2; ++ks) acc = mfma16(lds_frag(aimg, 16 * tr + fr, ks, g), wfr[prod][cc][ks], acc);
#pragma unroll
              for (int r = 0; r < 4; ++r) o[(16 * tr + 4 * g + r) * 65 + 16 * ct + fr] = acc[r]; } } }
    __syncthreads();
    { const int c = tid & 63, tg = tid >> 6, ch = 64 * h + c;
      const float kkc = F.k_k[ch], kac = F.k_a[ch], rkc = F.r_k[ch], wb = F.w_decay_bias[ch], ib = F.w_iclr_bias[ch];
      const LAS float* WP = (const LAS float*)(L + L_WP); const LAS float* AP = (const LAS float*)(L + L_AP); LAS float* CUMP = (LAS float*)(L + L_CUMP);
      float rr[8], kr[8], vv[8], lw[8], ic[8];
      float ps = 0.f;
#pragma unroll
      for (int r = 0; r < 8; ++r) { const int row = 8 * tg + r; rr[r] = ((const LAS float*)(L + L_RS))[row * 65 + c]; kr[r] = ((const LAS float*)(L + L_KS))[row * 65 + c]; vv[r] = ((const LAS float*)(L + L_VS))[row * 65 + c];
          lw[r] = -0.6065306597126334f * sigmoidf_(wb + WP[row * 65 + c]); ic[r] = sigmoidf_(ib + AP[row * 65 + c]); ps += lw[r]; }
      CUMP[tg * 64 + c] = ps;
      __syncthreads();
      float off = 0.f, tot = 0.f;
#pragma unroll
      for (int q = 0; q < 8; ++q) { const float p = CUMP[q * 64 + c]; tot += p; if (q < tg) off += p; }
      if (tg == 0) ((LAS float*)(L + L_GC))[c] = __expf(tot);
      float av[8], rv[8], bv[8], kv[8], bhv[8], khv[8]; float cum = off;
#pragma unroll
      for (int r = 0; r < 8; ++r) { const int t = t0 + 8 * tg + r;
          const float gprev = __expf(cum); cum += lw[r]; const float gam = __expf(cum), ig = __expf(-cum), gh = __expf(tot - cum);
          const float kk = kr[r] * kkc; const float kkn = kk * __builtin_amdgcn_rsqf(fmaxf(wave_sum_dpp(kk * kk), 1e-24f));
          const float kpm = kr[r] * (1.f + (ic[r] - 1.f) * kac); const float bs = wave_sum_dpp(rr[r] * kpm * rkc);
          if (c == 0) BSC[(size_t)t * 16 + h] = bs;
          const float bq = kkn * ic[r];
          av[r] = -kkn * gprev; rv[r] = rr[r] * gam; bv[r] = bq * ig; kv[r] = kpm * ig; bhv[r] = bq * gh; khv[r] = kpm * gh; }
#define R1_PUT(OFF, A) *(LAS v4u*)(L + (OFF) + c * IMS + 16 * tg) = (v4u){pk2(A[0], A[1]), pk2(A[2], A[3]), pk2(A[4], A[5]), pk2(A[6], A[7])}
      R1_PUT(L_AT, av); R1_PUT(L_RT, rv); R1_PUT(L_BT, bv); R1_PUT(L_KT, kv); R1_PUT(L_BHT, bhv); R1_PUT(L_KHT, khv); R1_PUT(L_VT, vv);
#undef R1_PUT
    }
    __syncthreads();
    { const int prod = wv >> 1; const unsigned ximg = (unsigned)((prod < 2) ? L_AT : L_RT), yimg = (unsigned)((prod & 1) ? L_KT : L_BT);
      const unsigned trb = (unsigned)((8 * g + (fr >> 2)) * IMS + 8 * (fr & 3));
#pragma unroll
      for (int q = 0; q < 8; ++q) { const int tl = 8 * (wv & 1) + q, ti = tl >> 2, si = tl & 3; f32x4 acc = (f32x4){0.f, 0.f, 0.f, 0.f};
          if (si <= ti) {
#pragma unroll
              for (int ks = 0; ks < 2; ++ks) { s16x4 y0, y1, x0, x1;
                  tr_read2(y0, y1, yimg + trb + (unsigned)(32 * ks * IMS + 32 * si), yimg + trb + (unsigned)((32 * ks + 4) * IMS + 32 * si));
                  tr_read2(x0, x1, ximg + trb + (unsigned)(32 * ks * IMS + 32 * ti), ximg + trb + (unsigned)((32 * ks + 4) * IMS + 32 * ti));
                  acc = mfma16((bf16x8){y0[0], y0[1], y0[2], y0[3], y1[0], y1[1], y1[2], y1[3]}, (bf16x8){x0[0], x0[1], x0[2], x0[3], x1[0], x1[1], x1[2], x1[3]}, acc); } }
          const int t = 16 * ti + fr, s0 = 16 * si + 4 * g;
#pragma unroll
          for (int r = 0; r < 4; ++r) { const bool keep = (prod < 2) ? (s0 + r < t) : (s0 + r <= t); acc[r] = keep ? acc[r] : 0.f; }
          if (prod == 0) *(LAS f32x4*)(L + L_LAB + (t * 68 + s0) * 4) = acc;
          else *(LAS v2u*)(L + (prod == 1 ? L_LAK : prod == 2 ? L_MRB : L_MRK) + t * IMS + 2 * s0) = (v2u){pk2(acc[0], acc[1]), pk2(acc[2], acc[3])}; } }
    __syncthreads();
    f32x4 x[4];
    if (wv < 4) {
#pragma unroll
        for (int bi = 0; bi < 4; ++bi) { const v2u w = *(const LAS v2u*)(L + L_AT + (16 * wv + fr) * IMS + 2 * (16 * bi + 4 * g)); x[bi] = (f32x4){bflo(w.x), bfhi(w.x), bflo(w.y), bfhi(w.y)}; }
    } else {
#pragma unroll
        for (int bi = 0; bi < 4; ++bi) { x[bi] = (f32x4){0.f, 0.f, 0.f, 0.f};
#pragma unroll
            for (int ks = 0; ks < 2; ++ks) x[bi] = mfma16(lds_frag(L + L_LAK, 16 * bi + fr, ks, g), lds_frag(L + L_VT, 16 * (wv - 4) + fr, ks, g), x[bi]); }
    }
    if (wv == 0) { const int bi = g, c = fr; const LAS float* Lb = (const LAS float*)(L + L_LAB) + (16 * bi) * 68 + 16 * bi; LAS float* Tb = (LAS float*)(L + L_TII) + bi * 320;
        float xc[16];
#pragma unroll
        for (int r = 0; r < 16; ++r) { float s0 = (r == c) ? 1.f : 0.f, s1 = 0.f, s2 = 0.f, s3 = 0.f;
#pragma unroll
            for (int q = 0; q < r; ++q) { const float p = Lb[r * 68 + q] * xc[q]; if ((q & 3) == 0) s0 += p; else if ((q & 3) == 1) s1 += p; else if ((q & 3) == 2) s2 += p; else s3 += p; }
            const float s = (s0 + s1) + (s2 + s3); xc[r] = s; Tb[r * 20 + c] = s; } }
    __syncthreads();
    { const LAS float* Lab = (const LAS float*)(L + L_LAB); const LAS float* Tii = (const LAS float*)(L + L_TII);
#pragma unroll
      for (int bi = 0; bi < 4; ++bi) { f32x4 acc = x[bi];
#pragma unroll
          for (int bj = 0; bj < 4; ++bj) { if (bj < bi) { const f32x4 a = *(const LAS f32x4*)(Lab + (16 * bi + fr) * 68 + 16 * bj + 4 * g);
#pragma unroll
              for (int kk = 0; kk < 4; ++kk) acc = mfma4f(a[kk], x[bj][kk], acc); } }
          const f32x4 tq = *(const LAS f32x4*)(Tii + bi * 320 + fr * 20 + 4 * g); f32x4 xo = (f32x4){0.f, 0.f, 0.f, 0.f};
#pragma unroll
          for (int kk = 0; kk < 4; ++kk) xo = mfma4f(tq[kk], acc[kk], xo);
          x[bi] = xo;
          *(LAS v2u*)(L + L_XT + (16 * wv + fr) * IMS + 2 * (16 * bi + 4 * g)) = (v2u){pk2(xo[0], xo[1]), pk2(xo[2], xo[3])}; } }
    __syncthreads();
    { bf16* PB = (bf16*)(F.ws + WS_PB) + (size_t)u * 4096; bf16* QC = (bf16*)(F.ws + WS_QC) + (size_t)u * 4096; float* GT = (float*)(F.ws + WS_GT) + (size_t)u * 4096; bf16* Y0 = (bf16*)(F.ws + WS_Y0T) + (size_t)u * 4096;
      const LAS float* GC = (const LAS float*)(L + L_GC);
#pragma unroll
      for (int q = 0; q < 2; ++q) { const int tl = 2 * wv + q, ra = tl >> 2, cb = tl & 3;
          { f32x4 acc = (f32x4){0.f, 0.f, 0.f, 0.f};
#pragma unroll
            for (int ks = 0; ks < 2; ++ks) acc = mfma16(lds_frag(L + L_XT, 16 * ra + fr, ks, g), lds_frag(L + L_MRB, 16 * cb + fr, ks, g), acc);
            const int t = 16 * cb + fr, j0 = 16 * ra + 4 * g;
#pragma unroll
            for (int r = 0; r < 4; ++r) acc[r] += bf2f(*(const LAS bf16*)(L + L_RT + (j0 + r) * IMS + 2 * t));
            *(GAS v2u*)(QC + (size_t)t * 64 + j0) = (v2u){pk2(acc[0], acc[1]), pk2(acc[2], acc[3])}; }
          { f32x4 acc = (f32x4){0.f, 0.f, 0.f, 0.f};
#pragma unroll
            for (int ks = 0; ks < 2; ++ks) { acc = mfma16(lds_frag(L + L_XT, 64 + 16 * ra + fr, ks, g), lds_frag(L + L_MRB, 16 * cb + fr, ks, g), acc); acc = mfma16(lds_frag(L + L_VT, 16 * ra + fr, ks, g), lds_frag(L + L_MRK, 16 * cb + fr, ks, g), acc); }
            *(GAS v2u*)(Y0 + (size_t)(16 * cb + fr) * 64 + 16 * ra + 4 * g) = (v2u){pk2(acc[0], acc[1]), pk2(acc[2], acc[3])}; }
          { f32x4 acc = (f32x4){0.f, 0.f, 0.f, 0.f};
#pragma unroll
            for (int ks = 0; ks < 2; ++ks) acc = mfma16(lds_frag(L + L_XT, 16 * ra + fr, ks, g), lds_frag(L + L_BHT, 16 * cb + fr, ks, g), acc);
            const int jp = 16 * cb + fr;
#pragma unroll
            for (int r = 0; r < 4; ++r) if (16 * ra + 4 * g + r == jp) acc[r] += GC[jp];
            *(GAS v2u*)(PB + (size_t)jp * 64 + 32 * (ra >> 1) + 8 * g + 4 * (ra & 1)) = (v2u){pk2(acc[0], acc[1]), pk2(acc[2], acc[3])}; }
          { f32x4 acc = (f32x4){0.f, 0.f, 0.f, 0.f};
#pragma unroll
            for (int ks = 0; ks < 2; ++ks) { acc = mfma16(lds_frag(L + L_BHT, 16 * ra + fr, ks, g), lds_frag(L + L_XT, 64 + 16 * cb + fr, ks, g), acc); acc = mfma16(lds_frag(L + L_KHT, 16 * ra + fr, ks, g), lds_frag(L + L_VT, 16 * cb + fr, ks, g), acc); }
            *(GAS f32x4*)(GT + (size_t)(16 * cb + fr) * 64 + 16 * ra + 4 * g) = acc; } } }
}

__device__ __forceinline__ void r1_chunk_local(Frame& F) {
    constexpr int NU = RW_H * (T / 64);
    const int upw = (NU + F.G - 1) / F.G;
    const int u0 = F.bid * upw; if (u0 >= NU) return;
    const bf16* WDT = (const bf16*)(F.ws + WS_WDT); const bf16* WIT = (const bf16*)(F.ws + WS_WIT);
    const int fr = F.lane & 15, g = F.lane >> 4;
    R1In in; r1_load(F, u0 >> 8, u0 & 255, in);
    bf16x8 wfr[2][2][2]; int hw = -1;
    for (int ui = 0; ui < upw; ++ui) { const int u = u0 + ui; if (u >= NU) break; const int h = u >> 8;
        if (h != hw) { hw = h;
#pragma unroll
            for (int prod = 0; prod < 2; ++prod)
#pragma unroll
                for (int cc = 0; cc < 2; ++cc)
#pragma unroll
                    for (int ks = 0; ks < 2; ++ks) wfr[prod][cc][ks] = *(const bf16x8*)((prod ? WIT : WDT) + (size_t)(64 * h + 16 * ((F.wave & 1) * 2 + cc) + fr) * 64 + 32 * ks + 8 * g); }
        r1_unit(F, h, u & 255, in, wfr, (ui + 1 < upw && u + 1 < NU) ? u + 1 : -1); }
}

constexpr int R2_SLOT = 12288, R2_D = 8, R2_NS = 10;
__device__ __forceinline__ void r2_recurrence(Frame& F) {
    if (F.bid >= 64) return;
    const int h = 2 * (F.bid & 7) + (F.bid >> 5), cg = (F.bid >> 3) & 3, lane = F.lane, fr = lane & 15, g = lane >> 4, wv = F.wave;
    const bf16* PB = (const bf16*)(F.ws + WS_PB) + (size_t)h * 256 * 4096; const float* GT = (const float*)(F.ws + WS_GT) + (size_t)h * 256 * 4096 + (size_t)(16 * cg) * 64;
    bf16* HT = (bf16*)(F.ws + WS_HT) + (size_t)h * 256 * 4096 + (size_t)(16 * cg) * 64;
    LAS unsigned char* L = F.lds;
#define R2_BAR() do { asm volatile("" ::: "memory"); __builtin_amdgcn_s_barrier(); asm volatile("" ::: "memory"); } while (0)
    __syncthreads();
    if (wv == 0) {
#define R2_FRAGS(step, PF, GF) do { const LAS unsigned char* sl_ = L + ((step) % R2_NS) * R2_SLOT; _Pragma("unroll") for (int rt = 0; rt < 4; ++rt) { GF[rt] = *(const LAS f32x4*)(sl_ + 8192 + (fr * 64 + 16 * rt + 4 * g) * 4); \
        _Pragma("unroll") for (int ks = 0; ks < 2; ++ks) PF[rt][ks] = *(const LAS bf16x8*)(sl_ + ((16 * rt + fr) * 64 + 32 * ks + 8 * g) * 2); } } while (0)
#define R2_STEP(PF, GF) do { \
        _Pragma("unroll") for (int rt = 0; rt < 4; ++rt) *(GAS v2u*)(HT + (size_t)c * 4096 + (size_t)fr * 64 + 16 * rt + 4 * g) = (v2u){pk2(hs[rt][0], hs[rt][1]), pk2(hs[rt][2], hs[rt][3])}; \
        bf16x8 bfr[2]; \
        _Pragma("unroll") for (int ks = 0; ks < 2; ++ks) { const v4u w = (v4u){pk2(hs[2 * ks][0], hs[2 * ks][1]), pk2(hs[2 * ks][2], hs[2 * ks][3]), pk2(hs[2 * ks + 1][0], hs[2 * ks + 1][1]), pk2(hs[2 * ks + 1][2], hs[2 * ks + 1][3])}; bfr[ks] = __builtin_bit_cast(bf16x8, w); } \
        _Pragma("unroll") for (int rt = 0; rt < 4; ++rt) { f32x4 acc = GF[rt]; _Pragma("unroll") for (int ks = 0; ks < 2; ++ks) acc = mfma16(PF[rt][ks], bfr[ks], acc); hs[rt] = acc; } } while (0)
        f32x4 hs[4], gfa[4], gfb[4]; bf16x8 pfa[4][2], pfb[4][2];
#pragma unroll
        for (int rt = 0; rt < 4; ++rt) hs[rt] = (f32x4){0.f, 0.f, 0.f, 0.f};
        R2_BAR();
        R2_FRAGS(0, pfa, gfa);
        for (int c = 0; c < 256; c += 2) {
            { R2_FRAGS(c + 1, pfb, gfb); R2_STEP(pfa, gfa); asm volatile("s_waitcnt lgkmcnt(0)" ::: "memory"); R2_BAR(); }
            { const int c1 = c + 1; const int cn = (c1 + 1 < 256) ? c1 + 1 : 255; R2_FRAGS(cn, pfa, gfa); { const int c = c1; R2_STEP(pfb, gfb); } asm volatile("s_waitcnt lgkmcnt(0)" ::: "memory"); R2_BAR(); }
        }
#undef R2_FRAGS
#undef R2_STEP
    } else if (wv <= 6) {
        const int p0 = 2 * (wv - 1);
#define R2_DMA(step) do { const int st_ = (step) < 256 ? (step) : 255; LAS unsigned char* sl_ = L + ((step) % R2_NS) * R2_SLOT; \
        _Pragma("unroll") for (int q_ = 0; q_ < 2; ++q_) { const int pc_ = p0 + q_; const char* src_ = (pc_ < 8) ? ((const char*)(PB + (size_t)st_ * 4096) + pc_ * 1024) : ((const char*)(GT + (size_t)st_ * 4096) + (pc_ - 8) * 1024); \
            __builtin_amdgcn_global_load_lds((const unsigned*)(src_ + lane * 16), (LAS unsigned*)(sl_ + pc_ * 1024), 16, 0, 0); } } while (0)
#pragma unroll
        for (int s0 = 0; s0 < R2_D; ++s0) R2_DMA(s0);
        asm volatile("s_waitcnt vmcnt(12)" ::: "memory");
        R2_BAR();
        for (int c = 0; c < 256; ++c) {
            R2_DMA(c + R2_D);
            asm volatile("s_waitcnt vmcnt(12)" ::: "memory");
            R2_BAR();
        }
        asm volatile("s_waitcnt vmcnt(0)" ::: "memory");
#undef R2_DMA
    } else {
        R2_BAR();
        for (int c = 0; c < 256; ++c) R2_BAR();
    }
    __syncthreads();
#undef R2_BAR
}

__device__ __forceinline__ void r3_output(Frame& F) {
    const bf16* QC = (const bf16*)(F.ws + WS_QC); const bf16* HT = (const bf16*)(F.ws + WS_HT); const bf16* Y0 = (const bf16*)(F.ws + WS_Y0T); const float* BSC = (const float*)(F.ws + WS_BSC);
    const bf16* V = (const bf16*)(F.ws + WS_V); const bf16* GR = (const bf16*)(F.ws + WS_GR); bf16* mixed = (bf16*)(F.ws + WS_MIXED);
    const int gw = F.bid * NWAVES + F.wave, NGW = F.G * NWAVES, lane = F.lane, fr = lane & 15, g = lane >> 4;
    for (int w = gw; w < 4096 * 4; w += NGW) { const int u = w >> 2, tt = w & 3, h = u >> 8, chunk = u & 255, t = chunk * 64 + 16 * tt + fr;
        bf16x8 qb[2];
#pragma unroll
        for (int ks = 0; ks < 2; ++ks) qb[ks] = *(const bf16x8*)(QC + (size_t)u * 4096 + (size_t)(16 * tt + fr) * 64 + 32 * ks + 8 * g);
        f32x4 y[4]; float s = 0.f;
#pragma unroll
        for (int it = 0; it < 4; ++it) { const v2u y0 = *(const GAS v2u*)(Y0 + (size_t)u * 4096 + (size_t)(16 * tt + fr) * 64 + 16 * it + 4 * g); y[it] = (f32x4){bflo(y0.x), bfhi(y0.x), bflo(y0.y), bfhi(y0.y)};
#pragma unroll
            for (int ks = 0; ks < 2; ++ks) y[it] = mfma16(*(const bf16x8*)(HT + (size_t)u * 4096 + (size_t)(16 * it + fr) * 64 + 32 * ks + 8 * g), qb[ks], y[it]);
            s += (y[it][0] + y[it][1]) + (y[it][2] + y[it][3]); }
        s += __shfl_xor(s, 16); s += __shfl_xor(s, 32);
        const float mean = s * (1.f / 64.f); float q2 = 0.f;
#pragma unroll
        for (int it = 0; it < 4; ++it)
#pragma unroll
            for (int r = 0; r < 4; ++r) { y[it][r] -= mean; q2 += y[it][r] * y[it][r]; }
        q2 += __shfl_xor(q2, 16); q2 += __shfl_xor(q2, 32);
        const float rstd = __builtin_amdgcn_rsqf(q2 * (1.f / 64.f) + LNX_EPS), bs = BSC[(size_t)t * 16 + h];
#pragma unroll
        for (int it = 0; it < 4; ++it) { const int ch = 64 * h + 16 * it + 4 * g; const size_t o = (size_t)t * 1024 + ch;
            const v2u vc = *(const GAS v2u*)(V + o), vp = t > 0 ? *(const GAS v2u*)(V + o - 1024) : (v2u){0u, 0u}, gg = *(const GAS v2u*)(GR + o);
            const f32x4 mu = *(const GAS f32x4*)(F.mu_rkv + 2048 + ch), lw = *(const GAS f32x4*)(F.lnx_w + ch), lb = *(const GAS f32x4*)(F.lnx_b + ch);
            const f32x4 vcf = (f32x4){bflo(vc.x), bfhi(vc.x), bflo(vc.y), bfhi(vc.y)}, vpf = (f32x4){bflo(vp.x), bfhi(vp.x), bflo(vp.y), bfhi(vp.y)}, gf = (f32x4){bflo(gg.x), bfhi(gg.x), bflo(gg.y), bfhi(gg.y)};
            const f32x4 vs = vcf + mu * (vpf - vcf); f32x4 o4 = y[it] * rstd * lw + lb + vs * bs;
#pragma unroll
            for (int r = 0; r < 4; ++r) o4[r] = o4[r] * gf[r] * sigmoidf_(gf[r]);
            *(GAS v2u*)(mixed + (size_t)t * 2048 + ch) = (v2u){pk2(o4[0], o4[1]), pk2(o4[2], o4[3])}; }
    }
}
#define PHASES_MID \
    p2_kmean(F); GRID_BAR(); \
    p3_gate(F); GRID_BAR(); \
    p4_attn_items(F); GRID_BAR(); \
    p5_combine(F); GRID_BAR(); \
    r1_chunk_local(F); GRID_BAR(); \
    r2_recurrence(F); GRID_BAR(); \
    r3_output(F); GRID_BAR();
#define HOST_EXTRA

__device__ __forceinline__ void p7_final_norm(Frame& F) {
    const int gw = F.bid * NWAVES + F.wave, NGW = F.G * NWAVES;
    const float* rowss = (const float*)(F.ws + WS_ROWSS);
    for (int m = gw; m < T; m += NGW) {
        const float p = (F.lane < 32) ? rowss[(size_t)m * 32 + F.lane] : 0.f;
        const float rs = 1.f / sqrtf(wave_sum(p) * (1.f / D) + RMS_EPS);
        GAS f32x4* o = (GAS f32x4*)(F.out + (size_t)m * D) + F.lane; const GAS f32x4* w = (const GAS f32x4*)F.final_norm_w + F.lane;
#pragma unroll
        for (int j = 0; j < 8; ++j) { const f32x4 h = o[64 * j]; o[64 * j] = h * rs * w[64 * j]; }
    }
}

struct Args { const float* in[16]; float* out; unsigned char* ws; };
__global__ void __launch_bounds__(NWAVES * 64, 2) hymba_fwd(Args args) {
    extern __shared__ __attribute__((aligned(16))) unsigned char lds[];
    Frame F;
    F.lds = (LAS unsigned char*)lds;
    F.MISC = (volatile LAS unsigned*)(F.lds + MISC_OFF);
    F.tid = threadIdx.x; F.lane = F.tid & 63; F.wave = __builtin_amdgcn_readfirstlane(F.tid >> 6);
    F.G = gridDim.x; F.bid = blockIdx.x;
    F.ws = args.ws; F.ctl = (gu32*)(args.ws + WS_CTL);
    F.x = args.in[0]; F.norm_w = args.in[1]; F.w_in = args.in[2]; F.mu_rkv = args.in[3]; F.mu_lora = args.in[4]; F.w_decay_up = args.in[5]; F.w_decay_bias = args.in[6];
    F.w_iclr_up = args.in[7]; F.w_iclr_bias = args.in[8]; F.k_k = args.in[9]; F.k_a = args.in[10]; F.r_k = args.in[11]; F.lnx_w = args.in[12]; F.lnx_b = args.in[13];
    F.w_out = args.in[14]; F.final_norm_w = args.in[15]; F.out = args.out;
    for (int u = F.tid; u < (LDS_BYTES - MISC_OFF) / 4; u += NWAVES * 64) ((LAS unsigned*)(F.lds + MISC_OFF))[u] = 0u;
    __syncthreads();
    XcdBarrier bar = xcd_barrier_post((unsigned*)(F.ctl + CW_BAR), F.MISC + 8);
#define GRID_BAR() do { xcd_barrier(bar); int t_ = threadIdx.x; asm volatile("" : "+v"(t_)); F.tid = t_; F.lane = t_ & 63; F.wave = __builtin_amdgcn_readfirstlane(t_ >> 6); } while (0)

    p0_prologue(F);
    GRID_BAR();
    {
        pg8::Gemm g{(const pg8::bf16_t*)(F.ws + WS_XN), (const pg8::bf16_t*)(F.ws + WS_W1T), T, NPROJ, D}; pg8::StaticOrder S; S.init(T, NPROJ, F.G, F.bid);
        pg8::EpiProj E{(pg8::bf16_t*)(F.ws + WS_PROJ), (pg8::bf16_t*)(F.ws + WS_WDAD), (const float*)(F.ws + WS_ROPE), (const float*)(F.ws + WS_ROPE) + (size_t)T * 16, (size_t)T * 1024};
        pg8::gemm_phase<pg8::EpiProj, pg8::StaticOrder, true, true>(F.lds, g, S, E);
    }
    GRID_BAR();
    PHASES_MID
    {
        pg8::Gemm g{(const pg8::bf16_t*)(F.ws + WS_MIXED), (const pg8::bf16_t*)(F.ws + WS_W2T), T, D, D}; pg8::StaticOrder S; S.init(T, D, F.G, F.bid);
        pg8::EpiOut E{F.x, F.out, (float*)(F.ws + WS_ROWSS), D};
        pg8::gemm_phase<pg8::EpiOut, pg8::StaticOrder, true, true>(F.lds, g, S, E);
    }
    GRID_BAR();
    p7_final_norm(F);
}

extern "C" void kernel_launch(void* const* d_in, const int* in_sizes, int n_in, void* d_out, int out_size, void* d_ws, size_t ws_size, hipStream_t stream) {
    static int grid = 0;
    if (grid == 0) {
        if (n_in != 16 || in_sizes[0] != T * D || out_size != T * D || ws_size < WS_END) { fprintf(stderr, "kernel_launch: unexpected shapes / workspace (n_in %d, in0 %d, out %d, ws %zu < %zu); nothing launched\n", n_in, n_in > 0 ? in_sizes[0] : -1, out_size, ws_size, (size_t)WS_END); grid = -1; return; }
        int dev = 0, cus = 0, per_cu = 0;
        if (hipGetDevice(&dev) != hipSuccess || hipDeviceGetAttribute(&cus, hipDeviceAttributeMultiprocessorCount, dev) != hipSuccess) { grid = -1; return; }
        if (hipFuncSetAttribute((const void*)hymba_fwd, hipFuncAttributeMaxDynamicSharedMemorySize, LDS_BYTES) != hipSuccess) { fprintf(stderr, "kernel_launch: hipFuncSetAttribute failed\n"); grid = -1; return; }
        if (hipOccupancyMaxActiveBlocksPerMultiprocessor(&per_cu, (const void*)hymba_fwd, NWAVES * 64, LDS_BYTES) != hipSuccess || per_cu < 1) { fprintf(stderr, "kernel_launch: occupancy query reports %d workgroups per CU\n", per_cu); per_cu = 1; }
        (void)hipGetLastError();
        grid = cus;
    }
    if (grid < 0) return;
    (void)hipMemsetAsync((char*)d_ws + WS_CTL, 0, CTL_ZERO_BYTES, stream);
    HOST_EXTRA
    Args a{};
    for (int i = 0; i < 16; ++i) a.in[i] = (const float*)d_in[i];
    a.out = (float*)d_out; a.ws = (unsigned char*)d_ws;
    hipLaunchKernelGGL(hymba_fwd, dim3(grid), dim3(NWAVES * 64), LDS_BYTES, stream, a);
}
```

```cpp
#include <hip/hip_runtime.h>
#include <cstdio>
#include <cstdint>
namespace pg8 {
#define PG8_LAS __attribute__((address_space(3)))
typedef unsigned short bf16_t;
typedef short bf16x8 __attribute__((ext_vector_type(8)));
typedef float f32x4 __attribute__((ext_vector_type(4)));
typedef unsigned u32x4 __attribute__((ext_vector_type(4)));
constexpr int BM = 256, BK = 64, HALF = 128, HTB = HALF * BK * 2  , STAGE_BYTES = 8 * HTB, NXCD = 8, WGM = 8;

__host__ __device__ __forceinline__ int lds_byte(int r, int c) { const int st = (r >> 4) * 2 + (c >> 5), rr = r & 15, cc = c & 31, ob = rr * 64 + cc * 2; return st * 1024 + (ob ^ (((ob >> 9) & 1) << 5)); }
__host__ __device__ __forceinline__ void stage_rc(int b, int& R, int& C) { const int st = b / 1024, sb = b % 1024, swz = sb ^ (((sb >> 9) & 1) << 5); R = (st >> 1) * 16 + swz / 64; C = (st & 1) * 32 + (swz % 64) / 2; }
__host__ __device__ __forceinline__ int perm32(int rho) { const int n = rho >> 4, i = rho & 15; return 8 * (i >> 2) + 4 * n + (i & 3); }

struct Unit { int pm, pn; };
struct Gemm { const bf16_t* A; const bf16_t* Bt; int M, N, K; };

struct StaticOrder {
    int nM, nN, nwg, G, c;
    __host__ __device__ void init(int M, int N, int G_, int c_) { nM = M / BM; nN = N / BM; nwg = nM * nN; G = G_; c = c_; }
    __host__ __device__ bool next(int i, Unit& u) const {
        const long L = (long)i * G + c; if (L >= nwg) return false;
        int wgid = (int)L; { const int q = nwg / NXCD, r = nwg % NXCD, xcd = wgid % NXCD, off = wgid / NXCD; wgid = (xcd < r ? xcd * (q + 1) : r * (q + 1) + (xcd - r) * q) + off; }
        const int nig = WGM * nN, gid = wgid / nig, fm = gid * WGM, gsz = (nM - fm) < WGM ? (nM - fm) : WGM;
        u.pm = fm + ((wgid % nig) % gsz); u.pn = (wgid % nig) / gsz; return true;
    }
    __device__ __forceinline__ void a_ready(const Unit&) const {}
    __device__ __forceinline__ void done(const Unit&) const {}
};

__device__ __forceinline__ unsigned cvt_pk_bf16(float lo, float hi) { unsigned r; asm volatile("v_cvt_pk_bf16_f32 %0, %1, %2" : "=v"(r) : "v"(lo), "v"(hi)); return r; }

struct EpiProj {
    static constexpr bool PERM = true, AFTER_DRAIN = false;
    bf16_t* base; bf16_t* wdad; const float* ropec; const float* ropes; size_t gstride;
    __device__ __forceinline__ void operator()(const f32x4 (&acc)[2][2][4][2], const Unit& u, int wr, int wc, int fr, int fq) const {
        const int row0 = u.pm * BM + wr * 64 + fr;
        if (u.pn < 32) {
            const int group = u.pn >> 2; bf16_t* bg = base + (size_t)group * gstride;
            const int col0 = (u.pn & 3) * BM + wc * 32 + 8 * fq;
            const bool rope = (group == 5 || group == 6) && wc == 0;
#pragma unroll
            for (int ai = 0; ai < 2; ++ai)
#pragma unroll
                for (int m = 0; m < 4; ++m) { const int row = row0 + ai * HALF + m * 16; bf16_t* rowp = bg + (size_t)row * 1024 + col0;
                    f32x4 cs = (f32x4){1.f, 1.f, 1.f, 1.f}, sn = (f32x4){0.f, 0.f, 0.f, 0.f};
                    if (rope) { cs = *(const f32x4*)(ropec + (size_t)row * 16 + 4 * fq); sn = *(const f32x4*)(ropes + (size_t)row * 16 + 4 * fq); }
#pragma unroll
                    for (int bj = 0; bj < 2; ++bj) { f32x4 v0 = acc[ai][bj][m][0], v1 = acc[ai][bj][m][1];
                        if (rope) { const f32x4 a = v0 * cs - v1 * sn, b = v1 * cs + v0 * sn; v0 = a; v1 = b; }
                        u32x4 w; w.x = cvt_pk_bf16(v0[0], v0[1]); w.y = cvt_pk_bf16(v0[2], v0[3]); w.z = cvt_pk_bf16(v1[0], v1[1]); w.w = cvt_pk_bf16(v1[2], v1[3]);
                        *(u32x4*)(rowp + bj * HALF) = w; } }
        } else {
            const int col0 = wc * 32 + 8 * fq;
#pragma unroll
            for (int ai = 0; ai < 2; ++ai)
#pragma unroll
                for (int m = 0; m < 4; ++m) { const int row = row0 + ai * HALF + m * 16; bf16_t* rowp = wdad + (size_t)row * 128 + col0;
                    const f32x4 v0 = acc[ai][0][m][0], v1 = acc[ai][0][m][1];
                    u32x4 w; w.x = cvt_pk_bf16(v0[0], v0[1]); w.y = cvt_pk_bf16(v0[2], v0[3]); w.z = cvt_pk_bf16(v1[0], v1[1]); w.w = cvt_pk_bf16(v1[2], v1[3]);
                    *(u32x4*)rowp = w; }
        }
    }
};

struct EpiOut {
    static constexpr bool PERM = false, AFTER_DRAIN = false;
    const float* x; float* out; float* rowss; int ldc;
    __device__ __forceinline__ void operator()(const f32x4 (&acc)[2][2][4][2], const Unit& u, int wr, int wc, int fr, int fq) const {
        const int row0 = u.pm * BM + wr * 64 + fr, col0 = u.pn * BM + wc * 32 + 4 * fq;
#pragma unroll
        for (int ai = 0; ai < 2; ++ai)
#pragma unroll
            for (int m = 0; m < 4; ++m) { const int row = row0 + ai * HALF + m * 16; const size_t off = (size_t)row * ldc + col0; float ss = 0.f;
#pragma unroll
                for (int bj = 0; bj < 2; ++bj)
#pragma unroll
                    for (int n = 0; n < 2; ++n) { const f32x4 xv = *(const f32x4*)(x + off + bj * HALF + n * 16); const f32x4 h = xv + acc[ai][bj][m][n];
                        *(f32x4*)(out + off + bj * HALF + n * 16) = h; ss += (h[0] * h[0] + h[1] * h[1]) + (h[2] * h[2] + h[3] * h[3]); }
                ss += __shfl_xor(ss, 16); ss += __shfl_xor(ss, 32);
                if (fq == 0) rowss[(size_t)row * 32 + u.pn * 4 + wc] = ss; }
    }
};
template <class Epi, class Sched, bool ALIGN_EPI = false, bool SP2 = false>
__device__ __forceinline__ void gemm_phase(PG8_LAS unsigned char* lds, const Gemm g, const Sched& S, const Epi& E) {
    int tid_ = threadIdx.x; asm volatile("" : "+v"(tid_));
    const int tid = tid_, wid = __builtin_amdgcn_readfirstlane(tid >> 6), lane = tid & 63, wr = wid >> 2, wc = wid & 3, fr = lane & 15, fq = lane >> 4;
    const int K = g.K, nt = K / BK;
    unsigned voffA[2], voffB[2];
#pragma unroll
    for (int i = 0; i < 2; ++i) { int R, C; stage_rc(tid * 16 + i * 8192, R, C); const int Rb = Epi::PERM ? ((R & ~31) + perm32(R & 31)) : R;
        voffA[i] = (unsigned)(R * K + C) * 2u; voffB[i] = (unsigned)(Rb * K + C) * 2u; }
    const size_t kstep = (size_t)(BK * 2);
    const size_t hstep = (size_t)HALF * K * 2;
    const size_t tstep = 2 * hstep;
    const unsigned ldsw = (unsigned)wid * 1024u;
    const int aoff = lds_byte(wr * 64 + fr, fq * 8), boff = lds_byte(wc * 32 + fr, fq * 8);
#define PG8_SA(b, h) (((b) * 2 + (h)) * HTB)
#define PG8_SB(b, h) ((4 + (b) * 2 + (h)) * HTB)
#define PG8_STAGE(bufoff, gbase, voff) do { _Pragma("unroll") for (int _i = 0; _i < 2; ++_i) \
        __builtin_amdgcn_global_load_lds((const unsigned*)((const char*)(gbase) + (voff)[_i]), (PG8_LAS unsigned*)(lds + (bufoff) + ldsw + _i * 8192), 16, 0, 0); } while (0)
#define PG8_LDA(dst, b, h) do { _Pragma("unroll") for (int m = 0; m < 4; ++m) _Pragma("unroll") for (int k = 0; k < 2; ++k) dst[m][k] = *(const PG8_LAS bf16x8*)(lds + PG8_SA(b, h) + aoff + m * 2048 + k * 1024); } while (0)
#define PG8_LDB(dst, b, h) do { _Pragma("unroll") for (int n = 0; n < 2; ++n) _Pragma("unroll") for (int k = 0; k < 2; ++k) dst[n][k] = *(const PG8_LAS bf16x8*)(lds + PG8_SB(b, h) + boff + n * 2048 + k * 1024); } while (0)
#define PG8_MMA(ai, bj, At, Bt) do { __builtin_amdgcn_s_setprio(1); _Pragma("unroll") for (int m = 0; m < 4; ++m) _Pragma("unroll") for (int n = 0; n < 2; ++n) _Pragma("unroll") for (int k = 0; k < 2; ++k) \
        acc[ai][bj][m][n] = __builtin_amdgcn_mfma_f32_16x16x32_bf16(Bt[n][k], At[m][k], acc[ai][bj][m][n], 0, 0, 0); __builtin_amdgcn_s_setprio(0); } while (0)
#define PG8_WAIT_V(n) asm volatile("s_waitcnt vmcnt(" #n ")" ::: "memory")
#define PG8_WAIT_L(n) asm volatile("s_waitcnt lgkmcnt(" #n ")" ::: "memory")
#define PG8_BAR __builtin_amdgcn_s_barrier()
#define PG8_SCHED __builtin_amdgcn_sched_barrier(0)
    Unit cur, nxt; int ui = 0;
    if (!S.next(0, cur)) return;
    f32x4 acc[2][2][4][2];
#pragma unroll
    for (int a = 0; a < 2; ++a)
#pragma unroll
        for (int b = 0; b < 2; ++b)
#pragma unroll
            for (int m = 0; m < 4; ++m)
#pragma unroll
                for (int n = 0; n < 2; ++n) acc[a][b][m][n] = (f32x4){0.f, 0.f, 0.f, 0.f};
    bf16x8 At[4][2], B0[2][2], B1[2][2];
    const char* cA = (const char*)g.A + (size_t)cur.pm * tstep; const char* cB = (const char*)g.Bt + (size_t)cur.pn * tstep;
    S.a_ready(cur);
    if constexpr (SP2) {
        PG8_STAGE(PG8_SB(0, 0), cB, voffB); PG8_STAGE(PG8_SB(0, 1), cB + hstep, voffB); PG8_STAGE(PG8_SA(0, 0), cA, voffA); PG8_STAGE(PG8_SA(0, 1), cA + hstep, voffA);
        if (wr == 1) PG8_BAR;
        PG8_WAIT_V(2); PG8_BAR;
        PG8_STAGE(PG8_SB(1, 0), cB + kstep, voffB); PG8_STAGE(PG8_SA(1, 0), cA + kstep, voffA); PG8_STAGE(PG8_SB(1, 1), cB + hstep + kstep, voffB);
        PG8_WAIT_V(6); PG8_BAR;
    } else {
        PG8_STAGE(PG8_SB(0, 0), cB, voffB); PG8_STAGE(PG8_SA(0, 0), cA, voffA); PG8_STAGE(PG8_SB(0, 1), cB + hstep, voffB); PG8_STAGE(PG8_SA(0, 1), cA + hstep, voffA);
        if (wr == 1) PG8_BAR;
        PG8_WAIT_V(4); PG8_BAR;
        PG8_STAGE(PG8_SB(1, 0), cB + kstep, voffB); PG8_STAGE(PG8_SA(1, 0), cA + kstep, voffA); PG8_STAGE(PG8_SB(1, 1), cB + hstep + kstep, voffB);
        PG8_WAIT_V(6); PG8_BAR;
    }
    for (;;) {
        const bool has_next = S.next(ui + 1, nxt);
        const char* nA = has_next ? (const char*)g.A + (size_t)nxt.pm * tstep : cA; const char* nB = has_next ? (const char*)g.Bt + (size_t)nxt.pn * tstep : cB;
        for (int t = 0; t < nt; t += 2) {
            const bool last = (t == nt - 2);
            const char* a1 = cA + (size_t)(t + 1) * kstep;
            const char* a2 = last ? nA : cA + (size_t)(t + 2) * kstep; const char* b2 = last ? nB : cB + (size_t)(t + 2) * kstep;
            const char* a3 = a2 + kstep; const char* b3 = b2 + kstep;
            if (last && has_next) S.a_ready(nxt);
            if constexpr (SP2) {
            PG8_LDB(B0, 0, 0); PG8_LDB(B1, 0, 1); PG8_SCHED; PG8_LDA(At, 0, 0); PG8_STAGE(PG8_SA(1, 1), a1 + hstep, voffA);
            PG8_WAIT_V(8); PG8_WAIT_L(0); PG8_BAR; PG8_MMA(0, 0, At, B0); PG8_MMA(0, 1, At, B1); PG8_BAR; PG8_SCHED;
            PG8_LDA(At, 0, 1); PG8_STAGE(PG8_SB(0, 0), b2, voffB); PG8_STAGE(PG8_SB(0, 1), b2 + hstep, voffB); PG8_STAGE(PG8_SA(0, 0), a2, voffA);
            PG8_WAIT_V(8); PG8_WAIT_L(0); PG8_BAR; PG8_MMA(1, 0, At, B0); PG8_MMA(1, 1, At, B1); PG8_BAR; PG8_SCHED;
            PG8_LDB(B0, 1, 0); PG8_LDB(B1, 1, 1); PG8_SCHED; PG8_LDA(At, 1, 0); PG8_STAGE(PG8_SA(0, 1), a2 + hstep, voffA);
            PG8_WAIT_V(8); PG8_WAIT_L(0); PG8_BAR; PG8_MMA(0, 0, At, B0); PG8_MMA(0, 1, At, B1); PG8_BAR; PG8_SCHED;
            PG8_LDA(At, 1, 1); PG8_STAGE(PG8_SB(1, 0), b3, voffB); PG8_STAGE(PG8_SB(1, 1), b3 + hstep, voffB); PG8_STAGE(PG8_SA(1, 0), a3, voffA);
            PG8_WAIT_V(8); PG8_WAIT_L(0); PG8_BAR; PG8_MMA(1, 0, At, B0); PG8_MMA(1, 1, At, B1); PG8_BAR; PG8_SCHED;
            } else {
            PG8_LDB(B0, 0, 0); PG8_SCHED; PG8_LDA(At, 0, 0); PG8_STAGE(PG8_SA(1, 1), a1 + hstep, voffA);
            PG8_WAIT_L(8); PG8_BAR; PG8_WAIT_L(0); PG8_MMA(0, 0, At, B0); PG8_BAR; PG8_SCHED;
            PG8_LDB(B1, 0, 1); PG8_STAGE(PG8_SB(0, 0), b2, voffB);
            PG8_BAR; PG8_WAIT_L(0); PG8_MMA(0, 1, At, B1); PG8_BAR;
            PG8_LDA(At, 0, 1); PG8_STAGE(PG8_SA(0, 0), a2, voffA);
            PG8_BAR; PG8_WAIT_L(0); PG8_MMA(1, 0, At, B0); PG8_BAR; PG8_SCHED;
            PG8_STAGE(PG8_SB(0, 1), b2 + hstep, voffB);
            PG8_WAIT_V(6); PG8_BAR; PG8_MMA(1, 1, At, B1); PG8_BAR;
            PG8_LDB(B0, 1, 0); PG8_SCHED; PG8_LDA(At, 1, 0); PG8_STAGE(PG8_SA(0, 1), a2 + hstep, voffA);
            PG8_WAIT_L(8); PG8_BAR; PG8_WAIT_L(0); PG8_MMA(0, 0, At, B0); PG8_BAR; PG8_SCHED;
            PG8_LDB(B1, 1, 1); PG8_STAGE(PG8_SB(1, 0), b3, voffB);
            PG8_BAR; PG8_WAIT_L(0); PG8_MMA(0, 1, At, B1); PG8_BAR;
            PG8_LDA(At, 1, 1); PG8_STAGE(PG8_SA(1, 0), a3, voffA);
            PG8_BAR; PG8_WAIT_L(0); PG8_MMA(1, 0, At, B0); PG8_BAR; PG8_SCHED;
            PG8_STAGE(PG8_SB(1, 1), b3 + hstep, voffB);
            PG8_WAIT_V(6); PG8_BAR; PG8_MMA(1, 1, At, B1); PG8_BAR;
            }
        }
        if constexpr (ALIGN_EPI) { if (wr == 0) PG8_BAR; }
        if constexpr (!Epi::AFTER_DRAIN) { E(acc, cur, wr, wc, fr, fq); S.done(cur); }
        if (!has_next) break;
#pragma unroll
        for (int a = 0; a < 2; ++a)
#pragma unroll
            for (int b = 0; b < 2; ++b)
#pragma unroll
                for (int m = 0; m < 4; ++m)
#pragma unroll
                    for (int n = 0; n < 2; ++n) acc[a][b][m][n] = (f32x4){0.f, 0.f, 0.f, 0.f};
        cur = nxt; cA = nA; cB = nB; ++ui;
        if constexpr (ALIGN_EPI) { if (wr == 1) PG8_BAR; }
    }
    PG8_WAIT_V(0);
    if constexpr (!ALIGN_EPI) { if (wr == 0) PG8_BAR; }
    PG8_BAR;
    if constexpr (Epi::AFTER_DRAIN) { E.fused(acc, cur, wr, wc, fr, fq, lds, wid, lane); S.done(cur); }
#undef PG8_SA
#undef PG8_SB
#undef PG8_STAGE
#undef PG8_LDA
#undef PG8_LDB
#undef PG8_MMA
#undef PG8_WAIT_V
#undef PG8_WAIT_L
#undef PG8_BAR
#undef PG8_SCHED
}
}

constexpr int NWAVES = 8;
constexpr int T = 16384, D = 2048, DIN = 8320, NPROJ = 8448;
constexpr int RW_H = 16, RW_N = 64, MB_H = 8, MB_D = 128, MB_BLK = 256, MB_NB = 64, LORA = 64;
constexpr float RMS_EPS = 1e-6f, LNX_EPS = 64e-5f;

constexpr size_t MiB = 1u << 20;
constexpr size_t WS_CTL = 0, CTL_ZERO_BYTES = 1 * MiB;
constexpr size_t WS_KMEAN = 1 * MiB;
constexpr size_t WS_KMEANB = WS_KMEAN + 256 * 1024;
constexpr size_t WS_BSC = 2 * MiB;
constexpr size_t WS_W2T = 4 * MiB;
constexpr size_t WS_ROPE = 12 * MiB;
constexpr size_t WS_W1T = 16 * MiB;
constexpr size_t WS_LIST = 16 * MiB;
constexpr size_t WS_XN = 52 * MiB;
constexpr size_t WS_Y = 52 * MiB;
constexpr size_t WS_PROJ = 116 * MiB;
constexpr size_t GRP = 32 * MiB;
constexpr size_t WS_R = WS_PROJ, WS_K = WS_PROJ + GRP, WS_V = WS_PROJ + 2 * GRP, WS_GR = WS_PROJ + 3 * GRP, WS_GM = WS_PROJ + 4 * GRP,
                 WS_Q = WS_PROJ + 5 * GRP, WS_KM = WS_PROJ + 6 * GRP, WS_VM = WS_PROJ + 7 * GRP;
constexpr size_t WS_WDAD = 372 * MiB;
constexpr size_t WS_PARTO = 376 * MiB;
constexpr size_t WS_PARTML = 504 * MiB;
constexpr size_t WS_ROWSS = 508 * MiB;
constexpr size_t WS_MIXED = WS_Q;
constexpr size_t WS_END = 510 * MiB;
constexpr int CW_BAR = 4096;
constexpr int CW_CNT = 16384;

constexpr int LDS_BYTES = 155648;
constexpr int MISC_OFF = 147456;

#define GAS __attribute__((address_space(1)))
#define LAS __attribute__((address_space(3)))
typedef unsigned short bf16;
typedef unsigned v4u __attribute__((ext_vector_type(4)));
typedef unsigned v2u __attribute__((ext_vector_type(2)));
typedef float f32x4 __attribute__((ext_vector_type(4)));
typedef float f32x2 __attribute__((ext_vector_type(2)));
typedef short bf16x8 __attribute__((ext_vector_type(8)));
typedef short s16x4 __attribute__((ext_vector_type(4)));
typedef GAS unsigned gu32;
#define RLX_AGENT __ATOMIC_RELAXED, __HIP_MEMORY_SCOPE_AGENT
#define LDS_WAIT() asm volatile("s_waitcnt lgkmcnt(0)" ::: "memory")
#define VM_WAIT() asm volatile("s_waitcnt vmcnt(0)" ::: "memory")
typedef __bf16 hwbf2 __attribute__((ext_vector_type(2)));
__device__ __forceinline__ unsigned f2bf(float f) { return (unsigned)__builtin_bit_cast(unsigned short, (__bf16)f); }
__device__ __forceinline__ unsigned pk2(float lo, float hi) { return __builtin_bit_cast(unsigned, __builtin_convertvector((f32x2){lo, hi}, hwbf2)); }
__device__ __forceinline__ float bflo(unsigned w) { return __builtin_bit_cast(float, w << 16); }
__device__ __forceinline__ float bfhi(unsigned w) { return __builtin_bit_cast(float, w & 0xffff0000u); }
__device__ __forceinline__ float bf2f(bf16 b) { return __builtin_bit_cast(float, (unsigned)b << 16); }
__device__ __forceinline__ float sigmoidf_(float x) { return __builtin_amdgcn_rcpf(1.f + __expf(-x)); }

#define XB_TMO      128
#define XB_XCNT(j)  (256  + 64 * (j))
#define XB_XSUB(j)  (1280 + 64 * (j))
#define XB_XGEN(j)  (2304 + 64 * (j))
#define XB_TOP      3328
#define XB_TOPGEN   3392
#define XCD_BAR_WORDS 3456
#define XB_SPIN_CAP (1u << 22)

__device__ __forceinline__ unsigned xb_ld(unsigned* p)              { return __hip_atomic_load(p, __ATOMIC_RELAXED, __HIP_MEMORY_SCOPE_AGENT); }
__device__ __forceinline__ unsigned xb_add(unsigned* p, unsigned v) { return __hip_atomic_fetch_add(p, v, __ATOMIC_RELAXED, __HIP_MEMORY_SCOPE_AGENT); }
__device__ __forceinline__ unsigned xb_xcc_id() { return (unsigned)__builtin_amdgcn_s_getreg((3 << 11) | 20) & 0xFu; }
#define XB_SPIN(cond, bar) do { unsigned _sp = 0; while (cond) { __builtin_amdgcn_s_sleep(1); \
    if ((++_sp & 255u) == 0u) { if (xb_ld(&(bar)[XB_TMO])) break; if (_sp > XB_SPIN_CAP) { atomicAdd(&(bar)[XB_TMO], 1u); break; } } } } while (0)

struct XcdBarrier { unsigned* bar; unsigned x; volatile LAS unsigned* st; };

__device__ __forceinline__ XcdBarrier xcd_barrier_post(unsigned* bar, volatile LAS unsigned* st) {
    XcdBarrier b; b.bar = bar; b.x = xb_xcc_id(); b.st = st;
    if (threadIdx.x == 0) (void)xb_add(&bar[XB_XCNT(b.x)], 1u);
    return b;
}
__device__ __forceinline__ void xcd_barrier_complete(unsigned* bar, unsigned x, unsigned& nloc, unsigned& nx) {
    const unsigned G = gridDim.x * gridDim.y * gridDim.z;
    unsigned sum, cnt, mine, sp = 0u;
    for (;;) {
        sum = 0u; cnt = 0u; mine = 0u;
#pragma unroll
        for (unsigned j = 0; j < 16; ++j) { const unsigned c = xb_ld(&bar[XB_XCNT(j)]); sum += c; cnt += (c > 0u) ? 1u : 0u; mine = (j == x) ? c : mine; }
        if (sum == G) break;
        __builtin_amdgcn_s_sleep(1);
        if ((++sp & 255u) == 0u) { if (xb_ld(&bar[XB_TMO])) break; if (sp > XB_SPIN_CAP) { atomicAdd(&bar[XB_TMO], 1u); break; } }
    }
    nloc = mine > 0u ? mine : 1u; nx = cnt > 0u ? cnt : 1u;
}
__device__ __forceinline__ void xcd_barrier(const XcdBarrier& b) {
    asm volatile("s_waitcnt vmcnt(0)" ::: "memory");
    __syncthreads();
    if (threadIdx.x == 0) {
        unsigned* bar = b.bar;
        __builtin_amdgcn_s_waitcnt(0);
        unsigned nloc = b.st[0], nx = b.st[1];
        if (nloc == 0u) { xcd_barrier_complete(bar, b.x, nloc, nx); b.st[0] = nloc; b.st[1] = nx; }
        const unsigned old = xb_add(&bar[XB_XSUB(b.x)], 1u);
        const unsigned gen = old / nloc;
        if (old + 1u == (gen + 1u) * nloc) {
            __builtin_amdgcn_fence(__ATOMIC_RELEASE, "agent");
            asm volatile("s_waitcnt vmcnt(0)" ::: "memory");
            const unsigned og = xb_add(&bar[XB_TOP], 1u);
            const unsigned tg = og / nx;
            if (og + 1u == (tg + 1u) * nx) xb_add(&bar[XB_TOPGEN], 1u);
            else XB_SPIN(xb_ld(&bar[XB_TOPGEN]) == tg, bar);
            __builtin_amdgcn_fence(__ATOMIC_ACQUIRE, "agent");
            xb_add(&bar[XB_XGEN(b.x)], 1u);
            asm volatile("s_waitcnt vmcnt(0)" ::: "memory");
        } else {
            XB_SPIN(xb_ld(&bar[XB_XGEN(b.x)]) == gen, bar);
            __builtin_amdgcn_fence(__ATOMIC_ACQUIRE, "agent");
            asm volatile("s_waitcnt vmcnt(0)" ::: "memory");
        }
    }
    __syncthreads();
}

struct Frame {
    LAS unsigned char* lds;
    volatile LAS unsigned* MISC;
    gu32* ctl;
    int tid, lane, wave;
    int G, bid;
    unsigned char* ws;
    const float *x, *norm_w, *w_in, *mu_rkv, *mu_lora, *w_decay_up, *w_decay_bias, *w_iclr_up, *w_iclr_bias, *k_k, *k_a, *r_k, *lnx_w, *lnx_b, *w_out, *final_norm_w;
    float* out;
};

__device__ __forceinline__ float wave_sum(float v) {
#pragma unroll
    for (int o = 1; o < 64; o <<= 1) v += __shfl_xor(v, o);
    return v;
}
__device__ __forceinline__ float wave_max(float v) {
#pragma unroll
    for (int o = 1; o < 64; o <<= 1) v = fmaxf(v, __shfl_xor(v, o));
    return v;
}

__device__ __forceinline__ int w1_src_col(int n) {
    if (n < 8192) {
        const int g = n >> 10, w = n & 1023;
        if (g == 5 || g == 6) {
            const int base = (g == 5) ? 4224 : 5248, hh = w >> 7, p = w & 127; int d = p;
            if (p < 32) { const int a = p >> 3, b = p & 7; d = (b < 4) ? (4 * a + b) : (16 + 4 * a + (b - 4)); }
            return base + hh * 128 + d;
        }
        const int base = (g == 0) ? 0 : (g == 1) ? 1024 : (g == 2) ? 2048 : (g == 3) ? 3200 : (g == 4) ? 7296 : 6272;
        return base + w;
    }
    if (n < 8320) return 3072 + (n - 8192);
    return -1;
}
template <bool MAP>
__device__ __forceinline__ void p0_transpose_item(const float* W, const float* rowscale, int K, int N, bf16* WT, int nblk, LAS float* scr, int item, int lane) {
    const int kb = item / nblk, nb = item % nblk, k0 = 64 * kb, n0 = 32 * nb;
    const int nd = n0 + (lane & 31); const int src = MAP ? w1_src_col(nd) : nd;
#pragma unroll 8
    for (int i = 0; i < 32; ++i) { const int kk = 2 * i + (lane >> 5);
        float v = 0.f; if (src >= 0) { v = W[(size_t)(k0 + kk) * N + src]; if (MAP) v *= rowscale[k0 + kk]; }
        scr[kk * 33 + (lane & 31)] = v; }
    LDS_WAIT(); asm volatile("" ::: "memory");
    const int c = lane & 7;
#pragma unroll
    for (int j = 0; j < 4; ++j) { const int n = (lane >> 3) + 8 * j; const LAS float* s = scr + (8 * c) * 33 + n;
        v4u o; o.x = pk2(s[0 * 33], s[1 * 33]); o.y = pk2(s[2 * 33], s[3 * 33]); o.z = pk2(s[4 * 33], s[5 * 33]); o.w = pk2(s[6 * 33], s[7 * 33]);
        *(GAS v4u*)(WT + (size_t)(n0 + n) * K + k0 + 8 * c) = o; }
    LDS_WAIT(); asm volatile("" ::: "memory");
}
__device__ __forceinline__ void rms_row_to_bf16(const float* xrow, bf16* orow, int lane) {
    const GAS f32x4* xr = (const GAS f32x4*)xrow + lane;
    f32x4 v[8]; float s = 0.f;
#pragma unroll
    for (int j = 0; j < 8; ++j) { v[j] = xr[64 * j]; s += (v[j].x * v[j].x + v[j].y * v[j].y) + (v[j].z * v[j].z + v[j].w * v[j].w); }
    const float rs = 1.f / sqrtf(wave_sum(s) * (1.f / D) + RMS_EPS);
    GAS unsigned long long* o8 = (GAS unsigned long long*)orow + lane;
#pragma unroll
    for (int j = 0; j < 8; ++j) o8[64 * j] = (unsigned long long)pk2(v[j].x * rs, v[j].y * rs) | ((unsigned long long)pk2(v[j].z * rs, v[j].w * rs) << 32);
}
__device__ __forceinline__ void p0_prologue(Frame& F) {
    LAS float* scr = (LAS float*)(F.lds + F.wave * 16384);
    const int gw = F.bid * NWAVES + F.wave, NGW = F.G * NWAVES;
    constexpr int I_1 = (D / 64) * (NPROJ / 32), I_2 = (D / 64) * (D / 32);
    for (int it = gw; it < I_1 + I_2; it += NGW) {
        if (it < I_1) p0_transpose_item<true>(F.w_in, F.norm_w, D, DIN, (bf16*)(F.ws + WS_W1T), NPROJ / 32, scr, it, F.lane);
        else p0_transpose_item<false>(F.w_out, nullptr, D, D, (bf16*)(F.ws + WS_W2T), D / 32, scr, it - I_1, F.lane);
    }
    for (int m = gw; m < T; m += NGW) rms_row_to_bf16(F.x + (size_t)m * D, (bf16*)(F.ws + WS_XN) + (size_t)m * D, F.lane);
    { bf16* wdt = (bf16*)(F.ws + 1 * MiB + 512 * 1024); bf16* wit = (bf16*)(F.ws + 1 * MiB + 640 * 1024);
      for (int e = F.bid * 512 + F.tid; e < 1024 * 64; e += F.G * 512) { const int c = e >> 6, l = e & 63; wdt[e] = (bf16)f2bf(F.w_decay_up[(size_t)l * 1024 + c]); wit[e] = (bf16)f2bf(F.w_iclr_up[(size_t)l * 1024 + c]); } }
    { float* rc = (float*)(F.ws + WS_ROPE); float* rsn = rc + (size_t)T * 16;
      for (int e = F.bid * 512 + F.tid; e < T * 16; e += F.G * 512) { const int t = e >> 4, i = e & 15;
          const double invf = exp2(-(double)i * (18.931568569324174 / 16.0));
          const double ang = (double)t * invf; const double n = rint(ang * 0.15915494309189535);
          double r = fma(-n, 6.283185307179586, ang); r = fma(-n, 2.4492935982947064e-16, r);
          const float rf = (float)r; rc[e] = cosf(rf); rsn[e] = sinf(rf); } }
}

__device__ __forceinline__ f32x4 mfma16(bf16x8 a, bf16x8 b, f32x4 c) { return __builtin_amdgcn_mfma_f32_16x16x32_bf16(a, b, c, 0, 0, 0); }
__device__ __forceinline__ int list_off(int h, int j) { return h * 516096 + 256 * (63 * j - (j * (j - 1)) / 2); }

__device__ __forceinline__ void p2_kmean(Frame& F) {
    const bf16* KM = (const bf16*)(F.ws + WS_KM); float* kmean = (float*)(F.ws + WS_KMEAN); bf16* kmeanb = (bf16*)(F.ws + WS_KMEANB);
    LAS float* red = (LAS float*)F.lds;
    const int dp = F.tid & 63, rg = F.tid >> 6;
    for (int u = F.bid; u < MB_NB * MB_H; u += F.G) { const int c = u >> 3, h = u & 7;
        float s0 = 0.f, s1 = 0.f;
        const unsigned* p = (const unsigned*)(KM + (size_t)(c * 256 + rg * 32) * 1024 + 128 * h) + dp;
#pragma unroll 8
        for (int r = 0; r < 32; ++r) { const unsigned w = p[(size_t)r * 512]; s0 += bflo(w); s1 += bfhi(w); }
        red[rg * 128 + 2 * dp] = s0; red[rg * 128 + 2 * dp + 1] = s1;
        __syncthreads();
        if (F.tid < 128) { float s = 0.f;
#pragma unroll
            for (int g = 0; g < 8; ++g) s += red[g * 128 + F.tid];
            s *= (1.f / 256.f); kmean[(size_t)(h * 64 + c) * 128 + F.tid] = s; kmeanb[(size_t)(h * 64 + c) * 128 + F.tid] = (bf16)f2bf(s); }
        __syncthreads();
    }
}

__device__ __forceinline__ void top3_insert(float v, int i, float& v1, int& i1, float& v2, int& i2, float& v3, int& i3) {
    const bool b1 = (v > v1) || (v == v1 && i < i1), b2 = (v > v2) || (v == v2 && i < i2), b3 = (v > v3) || (v == v3 && i < i3);
    const float n3 = b2 ? v2 : (b3 ? v : v3), n2 = b1 ? v1 : (b2 ? v : v2), n1 = b1 ? v : v1;
    const int m3 = b2 ? i2 : (b3 ? i : i3), m2 = b1 ? i1 : (b2 ? i : i2), m1 = b1 ? i : i1;
    v1 = n1; v2 = n2; v3 = n3; i1 = m1; i2 = m2; i3 = m3;
}
__device__ __forceinline__ void p3_gate(Frame& F) {
    const bf16* Q = (const bf16*)(F.ws + WS_Q); const bf16* kmb = (const bf16*)(F.ws + WS_KMEANB);
    unsigned* cnt = (unsigned*)(F.ctl + CW_CNT); int* list = (int*)(F.ws + WS_LIST);
    const int gw = F.bid * NWAVES + F.wave, NGW = F.G * NWAVES, lane = F.lane, qi = lane & 15, g = lane >> 4;
    for (int u = gw; u < (T / 16) * MB_H; u += NGW) { const int qt = u >> 3, h = u & 7, cur = qt >> 4;
        if (cur == 0) continue;
        const int t = qt * 16 + qi;
        bf16x8 qf[4];
#pragma unroll
        for (int ks = 0; ks < 4; ++ks) qf[ks] = *(const bf16x8*)(Q + (size_t)t * 1024 + 128 * h + 32 * ks + 8 * g);
        float v1 = -INFINITY, v2 = -INFINITY, v3 = -INFINITY; int i1 = 1 << 20, i2 = 1 << 20, i3 = 1 << 20;
        const int njt = ((cur - 1) >> 4) + 1;
#pragma unroll
        for (int jt = 0; jt < 4; ++jt) { if (jt < njt) {
            f32x4 acc = (f32x4){0.f, 0.f, 0.f, 0.f};
#pragma unroll
            for (int ks = 0; ks < 4; ++ks) { const bf16x8 a = *(const bf16x8*)(kmb + (size_t)(h * 64 + jt * 16 + qi) * 128 + 32 * ks + 8 * g); acc = mfma16(a, qf[ks], acc); }
#pragma unroll
            for (int r = 0; r < 4; ++r) { const int j = jt * 16 + 4 * g + r; const float v = (j < cur) ? acc[r] : -INFINITY; top3_insert(v, j, v1, i1, v2, i2, v3, i3); }
        } }
#pragma unroll
        for (int o = 16; o <= 32; o <<= 1) {
            const float a1 = __shfl_xor(v1, o), a2 = __shfl_xor(v2, o), a3 = __shfl_xor(v3, o); const int b1 = __shfl_xor(i1, o), b2 = __shfl_xor(i2, o), b3 = __shfl_xor(i3, o);
            top3_insert(a1, b1, v1, i1, v2, i2, v3, i3); top3_insert(a2, b2, v1, i1, v2, i2, v3, i3); top3_insert(a3, b3, v1, i1, v2, i2, v3, i3);
        }
        const int vc = cur < 3 ? cur : 3;
        if (g == 0) {
            if (vc > 0) { const unsigned pos = atomicAdd(&cnt[h * 64 + i1], 1u); list[list_off(h, i1) + pos] = (t << 2) | 0; }
            if (vc > 1) { const unsigned pos = atomicAdd(&cnt[h * 64 + i2], 1u); list[list_off(h, i2) + pos] = (t << 2) | 1; }
            if (vc > 2) { const unsigned pos = atomicAdd(&cnt[h * 64 + i3], 1u); list[list_off(h, i3) + pos] = (t << 2) | 2; }
        }
    }
}

constexpr int KV_STRIDE = 288;
constexpr int KLDS_OFF = 0, VLDS_OFF = 256 * KV_STRIDE, PFX_OFF = MISC_OFF + 1024;
__device__ __forceinline__ void tr_read2(s16x4& r0, s16x4& r1, unsigned a0, unsigned a1) {
    asm volatile("ds_read_b64_tr_b16 %0, %2\n\tds_read_b64_tr_b16 %1, %3\n\ts_waitcnt lgkmcnt(0)" : "=&v"(r0), "=&v"(r1) : "v"(a0), "v"(a1) : "memory"); }

template <int B0, int B1> __device__ __forceinline__ void tr_read16(s16x4 (&r)[16], unsigned base) {
    asm volatile(
        "ds_read_b64_tr_b16 %0, %16 offset:%17\n\tds_read_b64_tr_b16 %1, %16 offset:%18\n\tds_read_b64_tr_b16 %2, %16 offset:%19\n\tds_read_b64_tr_b16 %3, %16 offset:%20\n\t"
        "ds_read_b64_tr_b16 %4, %16 offset:%21\n\tds_read_b64_tr_b16 %5, %16 offset:%22\n\tds_read_b64_tr_b16 %6, %16 offset:%23\n\tds_read_b64_tr_b16 %7, %16 offset:%24\n\t"
        "ds_read_b64_tr_b16 %8, %16 offset:%25\n\tds_read_b64_tr_b16 %9, %16 offset:%26\n\tds_read_b64_tr_b16 %10, %16 offset:%27\n\tds_read_b64_tr_b16 %11, %16 offset:%28\n\t"
        "ds_read_b64_tr_b16 %12, %16 offset:%29\n\tds_read_b64_tr_b16 %13, %16 offset:%30\n\tds_read_b64_tr_b16 %14, %16 offset:%31\n\tds_read_b64_tr_b16 %15, %16 offset:%32\n\t"
        "s_waitcnt lgkmcnt(0)"
        : "=&v"(r[0]), "=&v"(r[1]), "=&v"(r[2]), "=&v"(r[3]), "=&v"(r[4]), "=&v"(r[5]), "=&v"(r[6]), "=&v"(r[7]), "=&v"(r[8]), "=&v"(r[9]), "=&v"(r[10]), "=&v"(r[11]), "=&v"(r[12]), "=&v"(r[13]), "=&v"(r[14]), "=&v"(r[15])
        : "v"(base), "i"(B0), "i"(B0 + 32), "i"(B0 + 64), "i"(B0 + 96), "i"(B0 + 128), "i"(B0 + 160), "i"(B0 + 192), "i"(B0 + 224),
          "i"(B1), "i"(B1 + 32), "i"(B1 + 64), "i"(B1 + 96), "i"(B1 + 128), "i"(B1 + 160), "i"(B1 + 192), "i"(B1 + 224)
        : "memory");
}
template <int S> __device__ __forceinline__ void pv_step(const f32x4& p0, const f32x4& p1, f32x4 (&o)[8], unsigned vb) {
    const v4u w = (v4u){pk2(p0[0], p0[1]), pk2(p0[2], p0[3]), pk2(p1[0], p1[1]), pk2(p1[2], p1[3])}; const bf16x8 pf = __builtin_bit_cast(bf16x8, w);
    s16x4 r[16]; tr_read16<32 * S * KV_STRIDE, (32 * S + 16) * KV_STRIDE>(r, vb);
#pragma unroll
    for (int dt = 0; dt < 8; ++dt) { const bf16x8 a = (bf16x8){r[dt][0], r[dt][1], r[dt][2], r[dt][3], r[8 + dt][0], r[8 + dt][1], r[8 + dt][2], r[8 + dt][3]}; o[dt] = mfma16(a, pf, o[dt]); }
}

__device__ __forceinline__ void p4_attn_items(Frame& F) {
    const bf16* Q = (const bf16*)(F.ws + WS_Q); const bf16* KM = (const bf16*)(F.ws + WS_KM); const bf16* VM = (const bf16*)(F.ws + WS_VM);
    const unsigned* cnt = (const unsigned*)(F.ctl + CW_CNT); const int* list = (const int*)(F.ws + WS_LIST);
    bf16* parto = (bf16*)(F.ws + WS_PARTO); float* partml = (float*)(F.ws + WS_PARTML);
    LAS int* pfx = (LAS int*)(F.lds + PFX_OFF);
    const int lane = F.lane, qi = lane & 15, g = lane >> 4, wv = F.wave;
    { LAS int* tmp = (LAS int*)(F.lds + PFX_OFF + 2560);
      const int c = (int)__hip_atomic_load(cnt + F.tid, RLX_AGENT); int val = ((c + 127) >> 7) + 2;
      __syncthreads();
      for (int d = 1; d < 512; d <<= 1) { tmp[F.tid] = val; __syncthreads(); if (F.tid >= d) val += tmp[F.tid - d]; __syncthreads(); }
      pfx[1 + F.tid] = val; if (F.tid == 0) pfx[0] = 0; }
    __syncthreads();
#define PFX(i) __builtin_amdgcn_readfirstlane(pfx[i])
    const int total = PFX(512);
    const int per = (total + F.G - 1) / F.G, lo = F.bid * per, hi = (lo + per < total) ? lo + per : total;
    if (lo >= hi) return;
    int u = 0; { int a = 0, b = 512; while (b - a > 1) { const int mid = (a + b) >> 1; if (PFX(mid) <= lo) a = mid; else b = mid; } u = a; }
    int loaded = -1;
    const float scale = 0.08838834764831845f;
#define P4_ENTRY(IT, UU, EN) do { const int it_ = (IT) < hi ? (IT) : hi - 1; while (it_ >= PFX(UU + 1)) ++UU; const int h_ = UU >> 6, j_ = UU & 63, tl_ = it_ - PFX(UU), ns_ = PFX(UU + 1) - PFX(UU) - 2; \
        if (tl_ >= ns_) EN = ((256 * j_ + 128 * (tl_ - ns_) + 16 * wv + qi) << 2) | 3; \
        else { const int n_ = (int)__hip_atomic_load(cnt + UU, RLX_AGENT); int e_ = tl_ * 128 + 16 * wv + qi; const bool ok_ = e_ < n_; if (!ok_) e_ = n_ - 1; const int en_ = list[list_off(h_, j_) + e_]; EN = ok_ ? en_ : (en_ | (int)0x80000000); } } while (0)
#define P4_QLOAD(QF, EN, UU) do { const int t_ = ((EN) & 0x7fffffff) >> 2; _Pragma("unroll") for (int ks = 0; ks < 4; ++ks) QF[ks] = *(const bf16x8*)(Q + (size_t)t_ * 1024 + 128 * ((UU) >> 6) + 32 * ks + 8 * g); } while (0)
    int u1 = u, u2 = u, en0, en1, en2 = 0; bf16x8 qf[4], qn[4];
    P4_ENTRY(lo, u, en0); u1 = u; P4_ENTRY(lo + 1, u1, en1); u2 = u1;
    P4_QLOAD(qf, en0, u);
    for (int it = lo; it < hi; ++it) {
        P4_QLOAD(qn, en1, u1);
        P4_ENTRY(it + 2, u2, en2);
        const int h = u >> 6, j = u & 63, tl = it - PFX(u), nsel = PFX(u + 1) - PFX(u) - 2;
        if (u != loaded) {
            __syncthreads();
#pragma unroll
            for (int i = 0; i < 8; ++i) { const int pz = F.tid + 512 * i, row = pz >> 4, cc = pz & 15;
                const v4u kv = *(const GAS v4u*)(KM + (size_t)(256 * j + row) * 1024 + 128 * h + 8 * cc); const v4u vv = *(const GAS v4u*)(VM + (size_t)(256 * j + row) * 1024 + 128 * h + 8 * cc);
                *(LAS v4u*)(F.lds + KLDS_OFF + row * KV_STRIDE + 16 * cc) = kv; *(LAS v4u*)(F.lds + VLDS_OFF + row * KV_STRIDE + 16 * cc) = vv; }
            __syncthreads();
            loaded = u;
        }
        const bool own = tl >= nsel; const int hf = tl - nsel;
        const int t = (en0 & 0x7fffffff) >> 2, slot = en0 & 3; const bool valid = en0 >= 0;
        const int nkt = own ? (8 * hf + wv + 1) : 16;
        f32x4 acc[16];
#pragma unroll
        for (int kt = 0; kt < 16; ++kt) { acc[kt] = (f32x4){0.f, 0.f, 0.f, 0.f};
            if (kt < nkt) {
#pragma unroll
                for (int ks = 0; ks < 4; ++ks) { const bf16x8 a = *(const LAS bf16x8*)(F.lds + KLDS_OFF + (16 * kt + qi) * KV_STRIDE + 64 * ks + 16 * g); acc[kt] = mfma16(a, qf[ks], acc[kt]); } } }
        const int tq = t - 256 * j;
        float m = -INFINITY;
#pragma unroll
        for (int kt = 0; kt < 16; ++kt)
#pragma unroll
            for (int r = 0; r < 4; ++r) { float s = acc[kt][r] * scale; const int key = 16 * kt + 4 * g + r; if (kt >= nkt || (own && key > tq)) s = -INFINITY; acc[kt][r] = s; m = fmaxf(m, s); }
        m = fmaxf(m, __shfl_xor(m, 16)); m = fmaxf(m, __shfl_xor(m, 32));
        float l = 0.f;
#pragma unroll
        for (int kt = 0; kt < 16; ++kt)
#pragma unroll
            for (int r = 0; r < 4; ++r) { const float p = __expf(acc[kt][r] - m); acc[kt][r] = p; l += p; }
        l += __shfl_xor(l, 16); l += __shfl_xor(l, 32);
        f32x4 o[8];
#pragma unroll
        for (int dt = 0; dt < 8; ++dt) o[dt] = (f32x4){0.f, 0.f, 0.f, 0.f};
        const unsigned vb0 = (unsigned)(VLDS_OFF + (4 * g + (qi >> 2)) * KV_STRIDE + 8 * (qi & 3)), vb1 = vb0 + 128u * KV_STRIDE;
        if (0 < nkt) pv_step<0>(acc[0], acc[1], o, vb0);
        if (2 < nkt) pv_step<1>(acc[2], acc[3], o, vb0);
        if (4 < nkt) pv_step<2>(acc[4], acc[5], o, vb0);
        if (6 < nkt) pv_step<3>(acc[6], acc[7], o, vb0);
        if (8 < nkt) pv_step<0>(acc[8], acc[9], o, vb1);
        if (10 < nkt) pv_step<1>(acc[10], acc[11], o, vb1);
        if (12 < nkt) pv_step<2>(acc[12], acc[13], o, vb1);
        if (14 < nkt) pv_step<3>(acc[14], acc[15], o, vb1);
        if (valid) { const float il = 1.f / l; const size_t pb = ((size_t)t * 8 + h) * 4 + slot;
#pragma unroll
            for (int dt = 0; dt < 8; ++dt) { v2u w; w.x = pk2(o[dt][0] * il, o[dt][1] * il); w.y = pk2(o[dt][2] * il, o[dt][3] * il); *(GAS v2u*)(parto + pb * 128 + 16 * dt + 4 * g) = w; }
            if (g == 0) { f32x2 ml; ml.x = m; ml.y = l; *(GAS f32x2*)(partml + pb * 2) = ml; } }
        en0 = en1; en1 = en2; u = u1; u1 = u2;
#pragma unroll
        for (int ks = 0; ks < 4; ++ks) qf[ks] = qn[ks];
    }
#undef P4_ENTRY
#undef P4_QLOAD
#undef PFX
}

__device__ __forceinline__ void p5_combine(Frame& F) {
    const bf16* parto = (const bf16*)(F.ws + WS_PARTO); const float* partml = (const float*)(F.ws + WS_PARTML); const bf16* GM = (const bf16*)(F.ws + WS_GM);
    bf16* mixed = (bf16*)(F.ws + WS_MIXED);
    const int gw = F.bid * NWAVES + F.wave, NGW = F.G * NWAVES, sub = F.lane >> 4, d0 = 8 * (F.lane & 15);
    for (int pq = gw; pq < T * MB_H / 4; pq += NGW) { const int pr = pq * 4 + sub, t = pr >> 3, h = pr & 7, cur = t >> 8, vc = cur < 3 ? cur : 3;
        float mm[4], ll[4]; float M = -INFINITY;
#pragma unroll
        for (int s = 0; s < 4; ++s) { const bool on = (s == 3) || (s < vc); f32x2 ml = (f32x2){-INFINITY, 0.f}; if (on) ml = *(const GAS f32x2*)(partml + ((size_t)pr * 4 + s) * 2); mm[s] = ml.x; ll[s] = ml.y; M = fmaxf(M, ml.x); }
        float acc[8]; float W = 0.f;
#pragma unroll
        for (int e = 0; e < 8; ++e) acc[e] = 0.f;
#pragma unroll
        for (int s = 0; s < 4; ++s) { const bool on = (s == 3) || (s < vc); if (on) { const float w = __expf(mm[s] - M) * ll[s]; W += w;
            const v4u ov = *(const GAS v4u*)(parto + ((size_t)pr * 4 + s) * 128 + d0);
            acc[0] += w * bflo(ov.x); acc[1] += w * bfhi(ov.x); acc[2] += w * bflo(ov.y); acc[3] += w * bfhi(ov.y); acc[4] += w * bflo(ov.z); acc[5] += w * bfhi(ov.z); acc[6] += w * bflo(ov.w); acc[7] += w * bfhi(ov.w); } }
        const float iw = 1.f / W;
        const v4u gv = *(const GAS v4u*)(GM + (size_t)t * 1024 + 128 * h + d0);
        const float gg[8] = {bflo(gv.x), bfhi(gv.x), bflo(gv.y), bfhi(gv.y), bflo(gv.z), bfhi(gv.z), bflo(gv.w), bfhi(gv.w)};
        float r[8];
#pragma unroll
        for (int e = 0; e < 8; ++e) r[e] = acc[e] * iw * gg[e] * sigmoidf_(gg[e]);
        v4u w; w.x = pk2(r[0], r[1]); w.y = pk2(r[2], r[3]); w.z = pk2(r[4], r[5]); w.w = pk2(r[6], r[7]);
        *(GAS v4u*)(mixed + (size_t)t * 2048 + 1024 + 128 * h + d0) = w;
    }
}

constexpr size_t WS_SR = 52 * MiB;
constexpr size_t WS_SA = 16 * MiB;
constexpr size_t WS_SK = 376 * MiB;
constexpr size_t WS_SV = 440 * MiB;
constexpr size_t WS_SB = WS_GM;
constexpr size_t WS_SW = WS_VM;
constexpr size_t WS_YS = WS_R;

__device__ __forceinline__ void p6_rwkv_prep(Frame& F) {
    const bf16* R = (const bf16*)(F.ws + WS_R); const bf16* K = (const bf16*)(F.ws + WS_K); const bf16* V = (const bf16*)(F.ws + WS_V); const bf16* WDAD = (const bf16*)(F.ws + WS_WDAD);
    float* SR = (float*)(F.ws + WS_SR); float* SK = (float*)(F.ws + WS_SK); float* SV = (float*)(F.ws + WS_SV);
    bf16* SA = (bf16*)(F.ws + WS_SA); bf16* SB = (bf16*)(F.ws + WS_SB); bf16* SW = (bf16*)(F.ws + WS_SW); float* BSC = (float*)(F.ws + WS_BSC);
    LAS float* WD = (LAS float*)(F.lds);
    LAS float* WI = (LAS float*)(F.lds + 16384);
    LAS float* Rs = (LAS float*)(F.lds + 32768);
    LAS float* Ks = (LAS float*)(F.lds + 49152);
    LAS float* TW = (LAS float*)(F.lds + 65536);
    LAS float* AD = (LAS float*)(F.lds + 81920);
    constexpr int NU = RW_H * (T / 64);
    const int upw = (NU + F.G - 1) / F.G;
    const int c = F.tid & 63, tg = F.tid >> 6;
    int hl_ = -1; float kkc = 0.f, kac = 0.f, rkc = 0.f, wb = 0.f, ib = 0.f;
    for (int ui = 0; ui < upw; ++ui) { const int u = F.bid * upw + ui; if (u >= NU) break; const int h = u / (T / 64), chunk = u % (T / 64), t0 = chunk * 64, ch = 64 * h + c;
        __syncthreads();
        if (h != hl_) { hl_ = h;
            for (int e = F.tid; e < 64 * 64; e += 512) { const int l = e >> 6, cc = e & 63; WD[e] = F.w_decay_up[(size_t)l * 1024 + 64 * h + cc]; WI[e] = F.w_iclr_up[(size_t)l * 1024 + 64 * h + cc]; }
            kkc = F.k_k[ch]; kac = F.k_a[ch]; rkc = F.r_k[ch]; wb = F.w_decay_bias[ch]; ib = F.w_iclr_bias[ch]; }
        { const int row = F.tid >> 3, cv = F.tid & 7, t = t0 + row; const size_t o = (size_t)t * 1024 + 64 * h + 8 * cv;
          const v4u z = (v4u){0u, 0u, 0u, 0u};
          const v4u rc = *(const GAS v4u*)(R + o), kc = *(const GAS v4u*)(K + o), vc = *(const GAS v4u*)(V + o);
          const v4u rp = t > 0 ? *(const GAS v4u*)(R + o - 1024) : z, kp = t > 0 ? *(const GAS v4u*)(K + o - 1024) : z, vp = t > 0 ? *(const GAS v4u*)(V + o - 1024) : z;
          const unsigned rcw[4] = {rc.x, rc.y, rc.z, rc.w}, rpw[4] = {rp.x, rp.y, rp.z, rp.w}, kcw[4] = {kc.x, kc.y, kc.z, kc.w}, kpw[4] = {kp.x, kp.y, kp.z, kp.w}, vcw[4] = {vc.x, vc.y, vc.z, vc.w}, vpw[4] = {vp.x, vp.y, vp.z, vp.w};
          float vs[8];
#pragma unroll
          for (int q = 0; q < 4; ++q) {
#pragma unroll
              for (int hl = 0; hl < 2; ++hl) { const int cc = 8 * cv + 2 * q + hl, chn = 64 * h + cc;
                  const float r0 = hl ? bfhi(rcw[q]) : bflo(rcw[q]), r1 = hl ? bfhi(rpw[q]) : bflo(rpw[q]);
                  const float k0 = hl ? bfhi(kcw[q]) : bflo(kcw[q]), k1 = hl ? bfhi(kpw[q]) : bflo(kpw[q]);
                  const float v0 = hl ? bfhi(vcw[q]) : bflo(vcw[q]), v1 = hl ? bfhi(vpw[q]) : bflo(vpw[q]);
                  Rs[row * 64 + cc] = r0 + F.mu_rkv[chn] * (r1 - r0); Ks[row * 64 + cc] = k0 + F.mu_rkv[1024 + chn] * (k1 - k0); vs[2 * q + hl] = v0 + F.mu_rkv[2048 + chn] * (v1 - v0); } }
          *(GAS f32x4*)(SV + o) = (f32x4){vs[0], vs[1], vs[2], vs[3]}; *(GAS f32x4*)(SV + o + 4) = (f32x4){vs[4], vs[5], vs[6], vs[7]};
#pragma unroll
          for (int part = 0; part < 2; ++part) { const int lv = 8 * cv + 64 * part;
              const v4u wc4 = *(const GAS v4u*)(WDAD + (size_t)t * 128 + lv); const v4u wp4 = t > 0 ? *(const GAS v4u*)(WDAD + (size_t)(t - 1) * 128 + lv) : z;
              const unsigned cw[4] = {wc4.x, wc4.y, wc4.z, wc4.w}, pw[4] = {wp4.x, wp4.y, wp4.z, wp4.w};
#pragma unroll
              for (int q = 0; q < 4; ++q)
#pragma unroll
                  for (int hl = 0; hl < 2; ++hl) { const int l = 8 * cv + 2 * q + hl; const float x0 = hl ? bfhi(cw[q]) : bflo(cw[q]), x1 = hl ? bfhi(pw[q]) : bflo(pw[q]);
                      const float xs = x0 + F.mu_lora[64 * part + l] * (x1 - x0);
                      if (part == 0) TW[row * 64 + l] = tanhf(xs); else AD[row * 64 + l] = xs; } } }
        __syncthreads();
        float aw[8], ai[8];
#pragma unroll
        for (int r = 0; r < 8; ++r) { aw[r] = 0.f; ai[r] = 0.f; }
        for (int l4 = 0; l4 < 16; ++l4) {
            const float wd0 = WD[(4 * l4 + 0) * 64 + c], wd1 = WD[(4 * l4 + 1) * 64 + c], wd2 = WD[(4 * l4 + 2) * 64 + c], wd3 = WD[(4 * l4 + 3) * 64 + c];
            const float wi0 = WI[(4 * l4 + 0) * 64 + c], wi1 = WI[(4 * l4 + 1) * 64 + c], wi2 = WI[(4 * l4 + 2) * 64 + c], wi3 = WI[(4 * l4 + 3) * 64 + c];
#pragma unroll
            for (int r = 0; r < 8; ++r) { const f32x4 tw = *(const LAS f32x4*)(TW + (8 * tg + r) * 64 + 4 * l4); const f32x4 ad = *(const LAS f32x4*)(AD + (8 * tg + r) * 64 + 4 * l4);
                aw[r] += tw.x * wd0 + tw.y * wd1 + tw.z * wd2 + tw.w * wd3; ai[r] += ad.x * wi0 + ad.y * wi1 + ad.z * wi2 + ad.w * wi3; }
        }
#pragma unroll
        for (int r = 0; r < 8; ++r) { const int row = 8 * tg + r, t = t0 + row; const size_t o = (size_t)t * 1024 + ch;
            const float lw = -0.6065306597126334f * sigmoidf_(wb + aw[r]);
            const float ic = sigmoidf_(ib + ai[r]);
            const float kr = Ks[row * 64 + c], rr = Rs[row * 64 + c];
            const float kk = kr * kkc; const float nrm = sqrtf(wave_sum(kk * kk)); const float kkn = kk / fmaxf(nrm, 1e-12f);
            const float kp = kr * (1.f + (ic - 1.f) * kac);
            const float bs = wave_sum(rr * kp * rkc);
            SR[o] = rr; SK[o] = kp; SA[o] = (bf16)f2bf(-kkn); SB[o] = (bf16)f2bf(kkn * ic); SW[o] = (bf16)f2bf(lw);
            if (c == 0) BSC[(size_t)t * 16 + h] = bs; }
    }
}

__device__ __forceinline__ float dpp_add16(float x) {
    x += __builtin_bit_cast(float, __builtin_amdgcn_update_dpp(0, __builtin_bit_cast(int, x), 0xB1, 0xf, 0xf, false));
    x += __builtin_bit_cast(float, __builtin_amdgcn_update_dpp(0, __builtin_bit_cast(int, x), 0x4E, 0xf, 0xf, false));
    x += __builtin_bit_cast(float, __builtin_amdgcn_update_dpp(0, __builtin_bit_cast(int, x), 0x141, 0xf, 0xf, false));
    x += __builtin_bit_cast(float, __builtin_amdgcn_update_dpp(0, __builtin_bit_cast(int, x), 0x140, 0xf, 0xf, false));
    return x;
}
constexpr int SC_CH = 64;
__device__ __forceinline__ void p7_rwkv_scan(Frame& F) {
    if (F.bid >= 32) return;
    const float* SR = (const float*)(F.ws + WS_SR); const float* SK = (const float*)(F.ws + WS_SK); const float* SV = (const float*)(F.ws + WS_SV);
    const bf16* SA = (const bf16*)(F.ws + WS_SA); const bf16* SB = (const bf16*)(F.ws + WS_SB); const bf16* SW = (const bf16*)(F.ws + WS_SW); float* Y = (float*)(F.ws + WS_YS);
    const int h = F.bid >> 1, i0 = 32 * (F.bid & 1);
    LAS float* Lr = (LAS float*)(F.lds);
    LAS float* Lk = (LAS float*)(F.lds + 16384);
    LAS float* La = (LAS float*)(F.lds + 32768);
    LAS float* Lb = (LAS float*)(F.lds + 49152);
    LAS float* Lw = (LAS float*)(F.lds + 65536);
    LAS float* Lv = (LAS float*)(F.lds + 81920);
    const int jg = F.lane & 15, rl = 4 * F.wave + (F.lane >> 4);
    f32x4 st = (f32x4){0.f, 0.f, 0.f, 0.f};
    const int srow = F.tid >> 3, scv = F.tid & 7;
    for (int t0 = 0; t0 < T; t0 += SC_CH) {
        __syncthreads();
        { const size_t o = (size_t)(t0 + srow) * 1024 + 64 * h + 8 * scv;
          const f32x4 r0 = *(const GAS f32x4*)(SR + o), r1 = *(const GAS f32x4*)(SR + o + 4), k0 = *(const GAS f32x4*)(SK + o), k1 = *(const GAS f32x4*)(SK + o + 4);
          const v4u a4 = *(const GAS v4u*)(SA + o), b4 = *(const GAS v4u*)(SB + o), w4 = *(const GAS v4u*)(SW + o);
          const f32x4 vv = *(const GAS f32x4*)(SV + (size_t)(t0 + srow) * 1024 + 64 * h + i0 + 4 * scv);
          LAS float* d = Lr + srow * 64 + 8 * scv; *(LAS f32x4*)d = r0; *(LAS f32x4*)(d + 4) = r1;
          d = Lk + srow * 64 + 8 * scv; *(LAS f32x4*)d = k0; *(LAS f32x4*)(d + 4) = k1;
          d = La + srow * 64 + 8 * scv; *(LAS f32x4*)d = (f32x4){bflo(a4.x), bfhi(a4.x), bflo(a4.y), bfhi(a4.y)}; *(LAS f32x4*)(d + 4) = (f32x4){bflo(a4.z), bfhi(a4.z), bflo(a4.w), bfhi(a4.w)};
          d = Lb + srow * 64 + 8 * scv; *(LAS f32x4*)d = (f32x4){bflo(b4.x), bfhi(b4.x), bflo(b4.y), bfhi(b4.y)}; *(LAS f32x4*)(d + 4) = (f32x4){bflo(b4.z), bfhi(b4.z), bflo(b4.w), bfhi(b4.w)};
          d = Lw + srow * 64 + 8 * scv; *(LAS f32x4*)d = (f32x4){__expf(bflo(w4.x)), __expf(bfhi(w4.x)), __expf(bflo(w4.y)), __expf(bfhi(w4.y))}; *(LAS f32x4*)(d + 4) = (f32x4){__expf(bflo(w4.z)), __expf(bfhi(w4.z)), __expf(bflo(w4.w)), __expf(bfhi(w4.w))};
          *(LAS f32x4*)(Lv + srow * 32 + 4 * scv) = vv; }
        __syncthreads();
#pragma unroll 2
        for (int s = 0; s < SC_CH; ++s) {
            const f32x4 a = *(const LAS f32x4*)(La + s * 64 + 4 * jg), b = *(const LAS f32x4*)(Lb + s * 64 + 4 * jg), w = *(const LAS f32x4*)(Lw + s * 64 + 4 * jg);
            const f32x4 k = *(const LAS f32x4*)(Lk + s * 64 + 4 * jg), r = *(const LAS f32x4*)(Lr + s * 64 + 4 * jg); const float vi = Lv[s * 32 + rl];
            const float sa = dpp_add16((st.x * a.x + st.y * a.y) + (st.z * a.z + st.w * a.w));
            st = st * w + (b * sa + k * vi);
            const float y = dpp_add16((st.x * r.x + st.y * r.y) + (st.z * r.z + st.w * r.w));
            if (jg == 0) Y[(size_t)(t0 + s) * 1024 + 64 * h + i0 + rl] = y;
        }
    }
}

__device__ __forceinline__ void p8_rwkv_final(Frame& F) {
    const float* Y = (const float*)(F.ws + WS_YS); const float* SV = (const float*)(F.ws + WS_SV); const float* BSC = (const float*)(F.ws + WS_BSC); const bf16* GR = (const bf16*)(F.ws + WS_GR);
    bf16* mixed = (bf16*)(F.ws + WS_MIXED);
    const int gw = F.bid * NWAVES + F.wave, NGW = F.G * NWAVES, c0 = 16 * F.lane, hd = F.lane >> 2;
    for (int t = gw; t < T; t += NGW) {
        float y[16]; float s = 0.f;
#pragma unroll
        for (int q = 0; q < 4; ++q) { const f32x4 v = *(const GAS f32x4*)(Y + (size_t)t * 1024 + c0 + 4 * q); y[4 * q] = v.x; y[4 * q + 1] = v.y; y[4 * q + 2] = v.z; y[4 * q + 3] = v.w; s += (v.x + v.y) + (v.z + v.w); }
        s += __shfl_xor(s, 1); s += __shfl_xor(s, 2);
        const float mean = s * (1.f / 64.f); float q2 = 0.f;
#pragma unroll
        for (int e = 0; e < 16; ++e) { y[e] -= mean; q2 += y[e] * y[e]; }
        q2 += __shfl_xor(q2, 1); q2 += __shfl_xor(q2, 2);
        const float rstd = 1.f / sqrtf(q2 * (1.f / 64.f) + LNX_EPS);
        const float bs = BSC[(size_t)t * 16 + hd];
        const v4u g0 = *(const GAS v4u*)(GR + (size_t)t * 1024 + c0), g1 = *(const GAS v4u*)(GR + (size_t)t * 1024 + c0 + 8);
        const float gg[16] = {bflo(g0.x), bfhi(g0.x), bflo(g0.y), bfhi(g0.y), bflo(g0.z), bfhi(g0.z), bflo(g0.w), bfhi(g0.w), bflo(g1.x), bfhi(g1.x), bflo(g1.y), bfhi(g1.y), bflo(g1.z), bfhi(g1.z), bflo(g1.w), bfhi(g1.w)};
        float r[16];
#pragma unroll
        for (int q = 0; q < 4; ++q) { const f32x4 v = *(const GAS f32x4*)(SV + (size_t)t * 1024 + c0 + 4 * q); const f32x4 lw = *(const GAS f32x4*)(F.lnx_w + c0 + 4 * q), lb = *(const GAS f32x4*)(F.lnx_b + c0 + 4 * q);
            const float vv[4] = {v.x, v.y, v.z, v.w}, lww[4] = {lw.x, lw.y, lw.z, lw.w}, lbb[4] = {lb.x, lb.y, lb.z, lb.w};
#pragma unroll
            for (int e = 0; e < 4; ++e) { const int i = 4 * q + e; const float o = y[i] * rstd * lww[e] + lbb[e] + bs * vv[e]; r[i] = o * gg[i] * sigmoidf_(gg[i]); } }
        v4u w0, w1; w0.x = pk2(r[0], r[1]); w0.y = pk2(r[2], r[3]); w0.z = pk2(r[4], r[5]); w0.w = pk2(r[6], r[7]); w1.x = pk2(r[8], r[9]); w1.y = pk2(r[10], r[11]); w1.z = pk2(r[12], r[13]); w1.w = pk2(r[14], r[15]);
        *(GAS v4u*)(mixed + (size_t)t * 2048 + c0) = w0; *(GAS v4u*)(mixed + (size_t)t * 2048 + c0 + 8) = w1;
    }
}

constexpr size_t WS_WDT = 1 * MiB + 512 * 1024;
constexpr size_t WS_WIT = 1 * MiB + 640 * 1024;
constexpr size_t WS_PB = 16 * MiB;
constexpr size_t WS_QC = 52 * MiB;
constexpr size_t WS_HT = 84 * MiB;
constexpr size_t WS_GT = 376 * MiB;
constexpr size_t WS_Y0T = 440 * MiB;
constexpr int IMS = 144;
constexpr int L_AT = 0, L_RT = 9216, L_BT = 18432, L_KT = 27648, L_BHT = 36864, L_KHT = 46080, L_VT = 55296, L_XT = 64512;
constexpr int L_RA = 82944;
constexpr int L_TW = L_RA, L_AD = L_RA + 9216, L_WP = L_RA + 18432, L_AP = L_WP + 16640;
constexpr int L_LAB = L_RA, L_LAK = L_RA + 17408, L_MRB = L_LAK + 9216, L_MRK = L_MRB + 9216, L_TII = L_MRK + 9216;
constexpr int L_CUMP = 134656, L_GC = L_CUMP + 2048;

__device__ __forceinline__ f32x4 mfma4f(float a, float b, f32x4 c) { return __builtin_amdgcn_mfma_f32_16x16x4f32(a, b, c, 0, 0, 0); }
__device__ __forceinline__ bf16x8 lds_frag(LAS unsigned char* img, int row, int ks, int g) { return *(const LAS bf16x8*)(img + row * IMS + 64 * ks + 16 * g); }

__device__ __forceinline__ float wave_sum_dpp(float x) {
    x = dpp_add16(x);
    x += __builtin_bit_cast(float, __builtin_amdgcn_update_dpp(0, __builtin_bit_cast(int, x), 0x142, 0xa, 0xf, false));
    x += __builtin_bit_cast(float, __builtin_amdgcn_update_dpp(0, __builtin_bit_cast(int, x), 0x143, 0xc, 0xf, false));
    return __builtin_bit_cast(float, __builtin_amdgcn_readlane(__builtin_bit_cast(int, x), 63));
}
struct R1In { v4u wd0, wd1, wp0, wp1, rc, rp, kc, kp, vc, vp; };
__device__ __forceinline__ void r1_load(Frame& F, int h, int chunk, R1In& in) {
    const bf16* R = (const bf16*)(F.ws + WS_R); const bf16* K = (const bf16*)(F.ws + WS_K); const bf16* V = (const bf16*)(F.ws + WS_V); const bf16* WDAD = (const bf16*)(F.ws + WS_WDAD);
    const int row = F.tid >> 3, cv = F.tid & 7, t = chunk * 64 + row; const size_t o = (size_t)t * 1024 + 64 * h + 8 * cv; const v4u z4 = (v4u){0u, 0u, 0u, 0u};
    in.wd0 = *(const GAS v4u*)(WDAD + (size_t)t * 128 + 8 * cv); in.wd1 = *(const GAS v4u*)(WDAD + (size_t)t * 128 + 64 + 8 * cv);
    in.rc = *(const GAS v4u*)(R + o); in.kc = *(const GAS v4u*)(K + o); in.vc = *(const GAS v4u*)(V + o);
    if (t > 0) { in.wp0 = *(const GAS v4u*)(WDAD + (size_t)(t - 1) * 128 + 8 * cv); in.wp1 = *(const GAS v4u*)(WDAD + (size_t)(t - 1) * 128 + 64 + 8 * cv);
        in.rp = *(const GAS v4u*)(R + o - 1024); in.kp = *(const GAS v4u*)(K + o - 1024); in.vp = *(const GAS v4u*)(V + o - 1024); }
    else { in.wp0 = z4; in.wp1 = z4; in.rp = z4; in.kp = z4; in.vp = z4; }
}
constexpr int L_RS = L_AT, L_KS = L_BT, L_VS = L_BHT;

__device__ __forceinline__ void r1_unit(Frame& F, int h, int chunk, R1In& in, const bf16x8 (&wfr)[2][2][2], int un) {
    float* BSC = (float*)(F.ws + WS_BSC);
    LAS unsigned char* L = F.lds;
    int tid = F.tid; asm volatile("" : "+v"(tid));
    const int t0 = chunk * 64, u = h * 256 + chunk, lane = tid & 63, wv = __builtin_amdgcn_readfirstlane(tid >> 6), fr = lane & 15, g = lane >> 4;
    __syncthreads();
    { const int row = tid >> 3, cv = tid & 7;
#pragma unroll
      for (int part = 0; part < 2; ++part) { const v4u wc4 = part ? in.wd1 : in.wd0, wp4 = part ? in.wp1 : in.wp0;
          const unsigned cw[4] = {wc4.x, wc4.y, wc4.z, wc4.w}, pw[4] = {wp4.x, wp4.y, wp4.z, wp4.w}; unsigned ow[4];
#pragma unroll
          for (int q = 0; q < 4; ++q) { float xs[2];
#pragma unroll
              for (int hl = 0; hl < 2; ++hl) { const int l = 8 * cv + 2 * q + hl; const float x0 = hl ? bfhi(cw[q]) : bflo(cw[q]), x1 = hl ? bfhi(pw[q]) : bflo(pw[q]);
                  xs[hl] = x0 + F.mu_lora[64 * part + l] * (x1 - x0); if (part == 0) { const float e2 = __expf(2.f * xs[hl]); xs[hl] = 1.f - 2.f / (e2 + 1.f); } }
              ow[q] = pk2(xs[0], xs[1]); }
          *(LAS v4u*)(L + (part == 0 ? L_TW : L_AD) + row * IMS + 16 * cv) = (v4u){ow[0], ow[1], ow[2], ow[3]}; }
      const unsigned rcw[4] = {in.rc.x, in.rc.y, in.rc.z, in.rc.w}, rpw[4] = {in.rp.x, in.rp.y, in.rp.z, in.rp.w}, kcw[4] = {in.kc.x, in.kc.y, in.kc.z, in.kc.w}, kpw[4] = {in.kp.x, in.kp.y, in.kp.z, in.kp.w},
                     vcw[4] = {in.vc.x, in.vc.y, in.vc.z, in.vc.w}, vpw[4] = {in.vp.x, in.vp.y, in.vp.z, in.vp.w};
#pragma unroll
      for (int q = 0; q < 4; ++q)
#pragma unroll
          for (int hl = 0; hl < 2; ++hl) { const int cc = 8 * cv + 2 * q + hl, chn = 64 * h + cc;
              const float r0 = hl ? bfhi(rcw[q]) : bflo(rcw[q]), r1 = hl ? bfhi(rpw[q]) : bflo(rpw[q]), k0 = hl ? bfhi(kcw[q]) : bflo(kcw[q]), k1 = hl ? bfhi(kpw[q]) : bflo(kpw[q]);
              const float v0 = hl ? bfhi(vcw[q]) : bflo(vcw[q]), v1 = hl ? bfhi(vpw[q]) : bflo(vpw[q]);
              ((LAS float*)(L + L_RS))[row * 65 + cc] = r0 + F.mu_rkv[chn] * (r1 - r0); ((LAS float*)(L + L_KS))[row * 65 + cc] = k0 + F.mu_rkv[1024 + chn] * (k1 - k0);
              ((LAS float*)(L + L_VS))[row * 65 + cc] = v0 + F.mu_rkv[2048 + chn] * (v1 - v0); } }
    if (un >= 0) r1_load(F, un >> 8, un & 255, in);
    __syncthreads();
    { const int tr = wv >> 1;
#pragma unroll
      for (int prod = 0; prod < 2; ++prod) { LAS unsigned char* aimg = L + (prod == 0 ? L_TW : L_AD); LAS float* o = (LAS float*)(L + (prod == 0 ? L_WP : L_AP));
#pragma unroll
          for (int cc = 0; cc < 2; ++cc) { const int ct = (wv & 1) * 2 + cc; f32x4 acc = (f32x4){0.f, 0.f, 0.f, 0.f};
#pragma unroll
              for (int ks = 0; ks < 2; ++ks) acc = mfma16(lds_frag(aimg, 16 * tr + fr, ks, g), wfr[prod][cc][ks], acc);
#pragma unroll
              for (int r = 0; r < 4; ++r) o[(16 * tr + 4 * g + r) * 65 + 16 * ct + fr] = acc[r]; } } }
    __syncthreads();
    { const int c = tid & 63, tg = tid >> 6, ch = 64 * h + c;
      const float kkc = F.k_k[ch], kac = F.k_a[ch], rkc = F.r_k[ch], wb = F.w_decay_bias[ch], ib = F.w_iclr_bias[ch];
      const LAS float* WP = (const LAS float*)(L + L_WP); const LAS float* AP = (const LAS float*)(L + L_AP); LAS float* CUMP = (LAS float*)(L + L_CUMP);
      float rr[8], kr[8], vv[8], lw[8], ic[8];
      float ps = 0.f;
#pragma unroll
      for (int r = 0; r < 8; ++r) { const int row = 8 * tg + r; rr[r] = ((const LAS float*)(L + L_RS))[row * 65 + c]; kr[r] = ((const LAS float*)(L + L_KS))[row * 65 + c]; vv[r] = ((const LAS float*)(L + L_VS))[row * 65 + c];
          lw[r] = -0.6065306597126334f * sigmoidf_(wb + WP[row * 65 + c]); ic[r] = sigmoidf_(ib + AP[row * 65 + c]); ps += lw[r]; }
      CUMP[tg * 64 + c] = ps;
      __syncthreads();
      float off = 0.f, tot = 0.f;
#pragma unroll
      for (int q = 0; q < 8; ++q) { const float p = CUMP[q * 64 + c]; tot += p; if (q < tg) off += p; }
      if (tg == 0) ((LAS float*)(L + L_GC))[c] = __expf(tot);
      float av[8], rv[8], bv[8], kv[8], bhv[8], khv[8]; float cum = off;
#pragma unroll
      for (int r = 0; r < 8; ++r) { const int t = t0 + 8 * tg + r;
          const float gprev = __expf(cum); cum += lw[r]; const float gam = __expf(cum), ig = __expf(-cum), gh = __expf(tot - cum);
          const float kk = kr[r] * kkc; const float kkn = kk * __builtin_amdgcn_rsqf(fmaxf(wave_sum_dpp(kk * kk), 1e-24f));
          const float kpm = kr[r] * (1.f + (ic[r] - 1.f) * kac); const float bs = wave_sum_dpp(rr[r] * kpm * rkc);
          if (c == 0) BSC[(size_t)t * 16 + h] = bs;
          const float bq = kkn * ic[r];
          av[r] = -kkn * gprev; rv[r] = rr[r] * gam; bv[r] = bq * ig; kv[r] = kpm * ig; bhv[r] = bq * gh; khv[r] = kpm * gh; }
#define R1_PUT(OFF, A) *(LAS v4u*)(L + (OFF) + c * IMS + 16 * tg) = (v4u){pk2(A[0], A[1]), pk2(A[2], A[3]), pk2(A[4], A[5]), pk2(A[6], A[7])}
      R1_PUT(L_AT, av); R1_PUT(L_RT, rv); R1_PUT(L_BT, bv); R1_PUT(L_KT, kv); R1_PUT(L_BHT, bhv); R1_PUT(L_KHT, khv); R1_PUT(L_VT, vv);
#undef R1_PUT
    }
    __syncthreads();
    { const int prod = wv >> 1; const unsigned ximg = (unsigned)((prod < 2) ? L_AT : L_RT), yimg = (unsigned)((prod & 1) ? L_KT : L_BT);
      const unsigned trb = (unsigned)((8 * g + (fr >> 2)) * IMS + 8 * (fr & 3));
#pragma unroll
      for (int q = 0; q < 8; ++q) { const int tl = 8 * (wv & 1) + q, ti = tl >> 2, si = tl & 3; f32x4 acc = (f32x4){0.f, 0.f, 0.f, 0.f};
          if (si <= ti) {
#pragma unroll
              for (int ks = 0; ks < 2; ++ks) { s16x4 y0, y1, x0, x1;
                  tr_read2(y0, y1, yimg + trb + (unsigned)(32 * ks * IMS + 32 * si), yimg + trb + (unsigned)((32 * ks + 4) * IMS + 32 * si));
                  tr_read2(x0, x1, ximg + trb + (unsigned)(32 * ks * IMS + 32 * ti), ximg + trb + (unsigned)((32 * ks + 4) * IMS + 32 * ti));
                  acc = mfma16((bf16x8){y0[0], y0[1], y0[2], y0[3], y1[0], y1[1], y1[2], y1[3]}, (bf16x8){x0[0], x0[1], x0[2], x0[3], x1[0], x1[1], x1[2], x1[3]}, acc); } }
          const int t = 16 * ti + fr, s0 = 16 * si + 4 * g;
#pragma unroll
          for (int r = 0; r < 4; ++r) { const bool keep = (prod < 2) ? (s0 + r < t) : (s0 + r <= t); acc[r] = keep ? acc[r] : 0.f; }
          if (prod == 0) *(LAS f32x4*)(L + L_LAB + (t * 68 + s0) * 4) = acc;
          else *(LAS v2u*)(L + (prod == 1 ? L_LAK : prod == 2 ? L_MRB : L_MRK) + t * IMS + 2 * s0) = (v2u){pk2(acc[0], acc[1]), pk2(acc[2], acc[3])}; } }
    __syncthreads();
    f32x4 x[4];
    if (wv < 4) {
#pragma unroll
        for (int bi = 0; bi < 4; ++bi) { const v2u w = *(const LAS v2u*)(L + L_AT + (16 * wv + fr) * IMS + 2 * (16 * bi + 4 * g)); x[bi] = (f32x4){bflo(w.x), bfhi(w.x), bflo(w.y), bfhi(w.y)}; }
    } else {
#pragma unroll
        for (int bi = 0; bi < 4; ++bi) { x[bi] = (f32x4){0.f, 0.f, 0.f, 0.f};
#pragma unroll
            for (int ks = 0; ks < 2; ++ks) x[bi] = mfma16(lds_frag(L + L_LAK, 16 * bi + fr, ks, g), lds_frag(L + L_VT, 16 * (wv - 4) + fr, ks, g), x[bi]); }
    }
    if (wv == 0) { const int bi = g, c = fr; const LAS float* Lb = (const LAS float*)(L + L_LAB) + (16 * bi) * 68 + 16 * bi; LAS float* Tb = (LAS float*)(L + L_TII) + bi * 320;
        float xc[16];
#pragma unroll
        for (int r = 0; r < 16; ++r) { float s0 = (r == c) ? 1.f : 0.f, s1 = 0.f, s2 = 0.f, s3 = 0.f;
#pragma unroll
            for (int q = 0; q < r; ++q) { const float p = Lb[r * 68 + q] * xc[q]; if ((q & 3) == 0) s0 += p; else if ((q & 3) == 1) s1 += p; else if ((q & 3) == 2) s2 += p; else s3 += p; }
            const float s = (s0 + s1) + (s2 + s3); xc[r] = s; Tb[r * 20 + c] = s; } }
    __syncthreads();
    { const LAS float* Lab = (const LAS float*)(L + L_LAB); const LAS float* Tii = (const LAS float*)(L + L_TII);
#pragma unroll
      for (int bi = 0; bi < 4; ++bi) { f32x4 acc = x[bi];
#pragma unroll
          for (int bj = 0; bj < 4; ++bj) { if (bj < bi) { const f32x4 a = *(const LAS f32x4*)(Lab + (16 * bi + fr) * 68 + 16 * bj + 4 * g);
#pragma unroll
              for (int kk = 0; kk < 4; ++kk) acc = mfma4f(a[kk], x[bj][kk], acc); } }
          const f32x4 tq = *(const LAS f32x4*)(Tii + bi * 320 + fr * 20 + 4 * g); f32x4 xo = (f32x4){0.f, 0.f, 0.f, 0.f};
#pragma unroll
          for (int kk = 0; kk < 4; ++kk) xo = mfma4f(tq[kk], acc[kk], xo);
          x[bi] = xo;
          *(LAS v2u*)(L + L_XT + (16 * wv + fr) * IMS + 2 * (16 * bi + 4 * g)) = (v2u){pk2(xo[0], xo[1]), pk2(xo[2], xo[3])}; } }
    __syncthreads();
    { bf16* PB = (bf16*)(F.ws + WS_PB) + (size_t)u * 4096; bf16* QC = (bf16*)(F.ws + WS_QC) + (size_t)u * 4096; float* GT = (float*)(F.ws + WS_GT) + (size_t)u * 4096; bf16* Y0 = (bf16*)(F.ws + WS_Y0T) + (size_t)u * 4096;
      const LAS float* GC = (const LAS float*)(L + L_GC);
#pragma unroll
      for (int q = 0; q < 2; ++q) { const int tl = 2 * wv + q, ra = tl >> 2, cb = tl & 3;
          { f32x4 acc = (f32x4){0.f, 0.f, 0.f, 0.f};
#pragma unroll
            for (int ks = 0; ks < 2; ++ks) acc = mfma16(lds_frag(L + L_XT, 16 * ra + fr, ks, g), lds_frag(L + L_MRB, 16 * cb + fr, ks, g), acc);
            const int t = 16 * cb + fr, j0 = 16 * ra + 4 * g;
#pragma unroll
            for (int r = 0; r < 4; ++r) acc[r] += bf2f(*(const LAS bf16*)(L + L_RT + (j0 + r) * IMS + 2 * t));
            *(GAS v2u*)(QC + (size_t)t * 64 + j0) = (v2u){pk2(acc[0], acc[1]), pk2(acc[2], acc[3])}; }
          { f32x4 acc = (f32x4){0.f, 0.f, 0.f, 0.f};
#pragma unroll
            for (int ks = 0; ks < 2; ++ks) { acc = mfma16(lds_frag(L + L_XT, 64 + 16 * ra + fr, ks, g), lds_frag(L + L_MRB, 16 * cb + fr, ks, g), acc); acc = mfma16(lds_frag(L + L_VT, 16 * ra + fr, ks, g), lds_frag(L + L_MRK, 16 * cb + fr, ks, g), acc); }
            *(GAS v2u*)(Y0 + (size_t)(16 * cb + fr) * 64 + 16 * ra + 4 * g) = (v2u){pk2(acc[0], acc[1]), pk2(acc[2], acc[3])}; }
          { f32x4 acc = (f32x4){0.f, 0.f, 0.f, 0.f};
#pragma unroll
            for (int ks = 0; ks < 2; ++ks) acc = mfma16(lds_frag(L + L_XT, 16 * ra + fr, ks, g), lds_frag(L + L_BHT, 16 * cb + fr, ks, g), acc);
            const int jp = 16 * cb + fr;
#pragma unroll
            for (int r = 0; r < 4; ++r) if (16 * ra + 4 * g + r == jp) acc[r] += GC[jp];
            *(GAS v2u*)(PB + (size_t)jp * 64 + 32 * (ra >> 1) + 8 * g + 4 * (ra & 1)) = (v2u){pk2(acc[0], acc[1]), pk2(acc[2], acc[3])}; }
          { f32x4 acc = (f32x4){0.f, 0.f, 0.f, 0.f};
#pragma unroll
            for (int ks = 0; ks < 2; ++ks) { acc = mfma16(lds_frag(L + L_BHT, 16 * ra + fr, ks, g), lds_frag(L + L_XT, 64 + 16 * cb + fr, ks, g), acc); acc = mfma16(lds_frag(L + L_KHT, 16 * ra + fr, ks, g), lds_frag(L + L_VT, 16 * cb + fr, ks, g), acc); }
            *(GAS f32x4*)(GT + (size_t)(16 * cb + fr) * 64 + 16 * ra + 4 * g) = acc; } } }
}

__device__ __forceinline__ void r1_chunk_local(Frame& F) {
    constexpr int NU = RW_H * (T / 64);
    const int upw = (NU + F.G - 1) / F.G;
    const int u0 = F.bid * upw; if (u0 >= NU) return;
    const bf16* WDT = (const bf16*)(F.ws + WS_WDT); const bf16* WIT = (const bf16*)(F.ws + WS_WIT);
    const int fr = F.lane & 15, g = F.lane >> 4;
    R1In in; r1_load(F, u0 >> 8, u0 & 255, in);
    bf16x8 wfr[2][2][2]; int hw = -1;
    for (int ui = 0; ui < upw; ++ui) { const int u = u0 + ui; if (u >= NU) break; const int h = u >> 8;
        if (h != hw) { hw = h;
#pragma unroll
            for (int prod = 0; prod < 2; ++prod)
#pragma unroll
                for (int cc = 0; cc < 2; ++cc)
#pragma unroll
                    for (int ks = 0; ks < 2; ++ks) wfr[prod][cc][ks] = *(const bf16x8*)((prod ? WIT : WDT) + (size_t)(64 * h + 16 * ((F.wave & 1) * 2 + cc) + fr) * 64 + 32 * ks + 8 * g); }
        r1_unit(F, h, u & 255, in, wfr, (ui + 1 < upw && u + 1 < NU) ? u + 1 : -1); }
}

constexpr int R2_SLOT = 12288, R2_D = 8, R2_NS = 10;
__device__ __forceinline__ void r2_recurrence(Frame& F) {
    if (F.bid >= 64) return;
    const int h = 2 * (F.bid & 7) + (F.bid >> 5), cg = (F.bid >> 3) & 3, lane = F.lane, fr = lane & 15, g = lane >> 4, wv = F.wave;
    const bf16* PB = (const bf16*)(F.ws + WS_PB) + (size_t)h * 256 * 4096; const float* GT = (const float*)(F.ws + WS_GT) + (size_t)h * 256 * 4096 + (size_t)(16 * cg) * 64;
    bf16* HT = (bf16*)(F.ws + WS_HT) + (size_t)h * 256 * 4096 + (size_t)(16 * cg) * 64;
    LAS unsigned char* L = F.lds;
#define R2_BAR() do { asm volatile("" ::: "memory"); __builtin_amdgcn_s_barrier(); asm volatile("" ::: "memory"); } while (0)
    __syncthreads();
    if (wv == 0) {
#define R2_FRAGS(step, PF, GF) do { const LAS unsigned char* sl_ = L + ((step) % R2_NS) * R2_SLOT; _Pragma("unroll") for (int rt = 0; rt < 4; ++rt) { GF[rt] = *(const LAS f32x4*)(sl_ + 8192 + (fr * 64 + 16 * rt + 4 * g) * 4); \
        _Pragma("unroll") for (int ks = 0; ks < 2; ++ks) PF[rt][ks] = *(const LAS bf16x8*)(sl_ + ((16 * rt + fr) * 64 + 32 * ks + 8 * g) * 2); } } while (0)
#define R2_STEP(PF, GF) do { \
        _Pragma("unroll") for (int rt = 0; rt < 4; ++rt) *(GAS v2u*)(HT + (size_t)c * 4096 + (size_t)fr * 64 + 16 * rt + 4 * g) = (v2u){pk2(hs[rt][0], hs[rt][1]), pk2(hs[rt][2], hs[rt][3])}; \
        bf16x8 bfr[2]; \
        _Pragma("unroll") for (int ks = 0; ks < 2; ++ks) { const v4u w = (v4u){pk2(hs[2 * ks][0], hs[2 * ks][1]), pk2(hs[2 * ks][2], hs[2 * ks][3]), pk2(hs[2 * ks + 1][0], hs[2 * ks + 1][1]), pk2(hs[2 * ks + 1][2], hs[2 * ks + 1][3])}; bfr[ks] = __builtin_bit_cast(bf16x8, w); } \
        _Pragma("unroll") for (int rt = 0; rt < 4; ++rt) { f32x4 acc = GF[rt]; _Pragma("unroll") for (int ks = 0; ks < 2; ++ks) acc = mfma16(PF[rt][ks], bfr[ks], acc); hs[rt] = acc; } } while (0)
        f32x4 hs[4], gfa[4], gfb[4]; bf16x8 pfa[4][2], pfb[4][2];
#pragma unroll
        for (int rt = 0; rt < 4; ++rt) hs[rt] = (f32x4){0.f, 0.f, 0.f, 0.f};
        R2_BAR();
        R2_FRAGS(0, pfa, gfa);
        for (int c = 0; c < 256; c += 2) {
            { R2_FRAGS(c + 1, pfb, gfb); R2_STEP(pfa, gfa); asm volatile("s_waitcnt lgkmcnt(0)" ::: "memory"); R2_BAR(); }
            { const int c1 = c + 1; const int cn = (c1 + 1 < 256) ? c1 + 1 : 255; R2_FRAGS(cn, pfa, gfa); { const int c = c1; R2_STEP(pfb, gfb); } asm volatile("s_waitcnt lgkmcnt(0)" ::: "memory"); R2_BAR(); }
        }
#undef R2_FRAGS
#undef R2_STEP
    } else if (wv <= 6) {
        const int p0 = 2 * (wv - 1);
#define R2_DMA(step) do { const int st_ = (step) < 256 ? (step) : 255; LAS unsigned char* sl_ = L + ((step) % R2_NS) * R2_SLOT; \
        _Pragma("unroll") for (int q_ = 0; q_ < 2; ++q_) { const int pc_ = p0 + q_; const char* src_ = (pc_ < 8) ? ((const char*)(PB + (size_t)st_ * 4096) + pc_ * 1024) : ((const char*)(GT + (size_t)st_ * 4096) + (pc_ - 8) * 1024); \
            __builtin_amdgcn_global_load_lds((const unsigned*)(src_ + lane * 16), (LAS unsigned*)(sl_ + pc_ * 1024), 16, 0, 0); } } while (0)
#pragma unroll
        for (int s0 = 0; s0 < R2_D; ++s0) R2_DMA(s0);
        asm volatile("s_waitcnt vmcnt(12)" ::: "memory");
        R2_BAR();
        for (int c = 0; c < 256; ++c) {
            R2_DMA(c + R2_D);
            asm volatile("s_waitcnt vmcnt(12)" ::: "memory");
            R2_BAR();
        }
        asm volatile("s_waitcnt vmcnt(0)" ::: "memory");
#undef R2_DMA
    } else {
        R2_BAR();
        for (int c = 0; c < 256; ++c) R2_BAR();
    }
    __syncthreads();
#undef R2_BAR
}

__device__ __forceinline__ void r3_output(Frame& F) {
    const bf16* QC = (const bf16*)(F.ws + WS_QC); const bf16* HT = (const bf16*)(F.ws + WS_HT); const bf16* Y0 = (const bf16*)(F.ws + WS_Y0T); const float* BSC = (const float*)(F.ws + WS_BSC);
    const bf16* V = (const bf16*)(F.ws + WS_V); const bf16* GR = (const bf16*)(F.ws + WS_GR); bf16* mixed = (bf16*)(F.ws + WS_MIXED);
    const int gw = F.bid * NWAVES + F.wave, NGW = F.G * NWAVES, lane = F.lane, fr = lane & 15, g = lane >> 4;
    for (int w = gw; w < 4096 * 4; w += NGW) { const int u = w >> 2, tt = w & 3, h = u >> 8, chunk = u & 255, t = chunk * 64 + 16 * tt + fr;
        bf16x8 qb[2];
#pragma unroll
        for (int ks = 0; ks < 2; ++ks) qb[ks] = *(const bf16x8*)(QC + (size_t)u * 4096 + (size_t)(16 * tt + fr) * 64 + 32 * ks + 8 * g);
        f32x4 y[4]; float s = 0.f;
#pragma unroll
        for (int it = 0; it < 4; ++it) { const v2u y0 = *(const GAS v2u*)(Y0 + (size_t)u * 4096 + (size_t)(16 * tt + fr) * 64 + 16 * it + 4 * g); y[it] = (f32x4){bflo(y0.x), bfhi(y0.x), bflo(y0.y), bfhi(y0.y)};
#pragma unroll
            for (int ks = 0; ks < 2; ++ks) y[it] = mfma16(*(const bf16x8*)(HT + (size_t)u * 4096 + (size_t)(16 * it + fr) * 64 + 32 * ks + 8 * g), qb[ks], y[it]);
            s += (y[it][0] + y[it][1]) + (y[it][2] + y[it][3]); }
        s += __shfl_xor(s, 16); s += __shfl_xor(s, 32);
        const float mean = s * (1.f / 64.f); float q2 = 0.f;
#pragma unroll
        for (int it = 0; it < 4; ++it)
#pragma unroll
            for (int r = 0; r < 4; ++r) { y[it][r] -= mean; q2 += y[it][r] * y[it][r]; }
        q2 += __shfl_xor(q2, 16); q2 += __shfl_xor(q2, 32);
        const float rstd = __builtin_amdgcn_rsqf(q2 * (1.f / 64.f) + LNX_EPS), bs = BSC[(size_t)t * 16 + h];
#pragma unroll
        for (int it = 0; it < 4; ++it) { const int ch = 64 * h + 16 * it + 4 * g; const size_t o = (size_t)t * 1024 + ch;
            const v2u vc = *(const GAS v2u*)(V + o), vp = t > 0 ? *(const GAS v2u*)(V + o - 1024) : (v2u){0u, 0u}, gg = *(const GAS v2u*)(GR + o);
            const f32x4 mu = *(const GAS f32x4*)(F.mu_rkv + 2048 + ch), lw = *(const GAS f32x4*)(F.lnx_w + ch), lb = *(const GAS f32x4*)(F.lnx_b + ch);
            const f32x4 vcf = (f32x4){bflo(vc.x), bfhi(vc.x), bflo(vc.y), bfhi(vc.y)}, vpf = (f32x4){bflo(vp.x), bfhi(vp.x), bflo(vp.y), bfhi(vp.y)}, gf = (f32x4){bflo(gg.x), bfhi(gg.x), bflo(gg.y), bfhi(gg.y)};
            const f32x4 vs = vcf + mu * (vpf - vcf); f32x4 o4 = y[it] * rstd * lw + lb + vs * bs;
#pragma unroll
            for (int r = 0; r < 4; ++r) o4[r] = o4[r] * gf[r] * sigmoidf_(gf[r]);
            *(GAS v2u*)(mixed + (size_t)t * 2048 + ch) = (v2u){pk2(o4[0], o4[1]), pk2(o4[2], o4[3])}; }
    }
}
#define PHASES_MID \
    p2_kmean(F); GRID_BAR(); \
    p3_gate(F); GRID_BAR(); \
    p4_attn_items(F); GRID_BAR(); \
    p5_combine(F); GRID_BAR(); \
    r1_chunk_local(F); GRID_BAR(); \
    r2_recurrence(F); GRID_BAR(); \
    r3_output(F); GRID_BAR();
#define HOST_EXTRA

__device__ __forceinline__ void p7_final_norm(Frame& F) {
    const int gw = F.bid * NWAVES + F.wave, NGW = F.G * NWAVES;
    const float* rowss = (const float*)(F.ws + WS_ROWSS);
    for (int m = gw; m < T; m += NGW) {
        const float p = (F.lane < 32) ? rowss[(size_t)m * 32 + F.lane] : 0.f;
        const float rs = 1.f / sqrtf(wave_sum(p) * (1.f / D) + RMS_EPS);
        GAS f32x4* o = (GAS f32x4*)(F.out + (size_t)m * D) + F.lane; const GAS f32x4* w = (const GAS f32x4*)F.final_norm_w + F.lane;
#pragma unroll
        for (int j = 0; j < 8; ++j) { const f32x4 h = o[64 * j]; o[64 * j] = h * rs * w[64 * j]; }
    }
}

struct Args { const float* in[16]; float* out; unsigned char* ws; };
__global__ void __launch_bounds__(NWAVES * 64, 2) hymba_fwd(Args args) {
    extern __shared__ __attribute__((aligned(16))) unsigned char lds[];
    Frame F;
    F.lds = (LAS unsigned char*)lds;
    F.MISC = (volatile LAS unsigned*)(F.lds + MISC_OFF);
    F.tid = threadIdx.x; F.lane = F.tid & 63; F.wave = __builtin_amdgcn_readfirstlane(F.tid >> 6);
    F.G = gridDim.x; F.bid = blockIdx.x;
    F.ws = args.ws; F.ctl = (gu32*)(args.ws + WS_CTL);
    F.x = args.in[0]; F.norm_w = args.in[1]; F.w_in = args.in[2]; F.mu_rkv = args.in[3]; F.mu_lora = args.in[4]; F.w_decay_up = args.in[5]; F.w_decay_bias = args.in[6];
    F.w_iclr_up = args.in[7]; F.w_iclr_bias = args.in[8]; F.k_k = args.in[9]; F.k_a = args.in[10]; F.r_k = args.in[11]; F.lnx_w = args.in[12]; F.lnx_b = args.in[13];
    F.w_out = args.in[14]; F.final_norm_w = args.in[15]; F.out = args.out;
    for (int u = F.tid; u < (LDS_BYTES - MISC_OFF) / 4; u += NWAVES * 64) ((LAS unsigned*)(F.lds + MISC_OFF))[u] = 0u;
    __syncthreads();
    XcdBarrier bar = xcd_barrier_post((unsigned*)(F.ctl + CW_BAR), F.MISC + 8);
#define GRID_BAR() do { xcd_barrier(bar); int t_ = threadIdx.x; asm volatile("" : "+v"(t_)); F.tid = t_; F.lane = t_ & 63; F.wave = __builtin_amdgcn_readfirstlane(t_ >> 6); } while (0)

    p0_prologue(F);
    GRID_BAR();
    {
        pg8::Gemm g{(const pg8::bf16_t*)(F.ws + WS_XN), (const pg8::bf16_t*)(F.ws + WS_W1T), T, NPROJ, D}; pg8::StaticOrder S; S.init(T, NPROJ, F.G, F.bid);
        pg8::EpiProj E{(pg8::bf16_t*)(F.ws + WS_PROJ), (pg8::bf16_t*)(F.ws + WS_WDAD), (const float*)(F.ws + WS_ROPE), (const float*)(F.ws + WS_ROPE) + (size_t)T * 16, (size_t)T * 1024};
        pg8::gemm_phase<pg8::EpiProj, pg8::StaticOrder, true, true>(F.lds, g, S, E);
    }
    GRID_BAR();
    PHASES_MID
    {
        pg8::Gemm g{(const pg8::bf16_t*)(F.ws + WS_MIXED), (const pg8::bf16_t*)(F.ws + WS_W2T), T, D, D}; pg8::StaticOrder S; S.init(T, D, F.G, F.bid);
        pg8::EpiOut E{F.x, F.out, (float*)(F.ws + WS_ROWSS), D};
        pg8::gemm_phase<pg8::EpiOut, pg8::StaticOrder, true, true>(F.lds, g, S, E);
    }
    GRID_BAR();
    p7_final_norm(F);
}

extern "C" void kernel_launch(void* const* d_in, const int* in_sizes, int n_in, void* d_out, int out_size, void* d_ws, size_t ws_size, hipStream_t stream) {
    static int grid = 0;
    if (grid == 0) {
        if (n_in != 16 || in_sizes[0] != T * D || out_size != T * D || ws_size < WS_END) { fprintf(stderr, "kernel_launch: unexpected shapes / workspace (n_in %d, in0 %d, out %d, ws %zu < %zu); nothing launched\n", n_in, n_in > 0 ? in_sizes[0] : -1, out_size, ws_size, (size_t)WS_END); grid = -1; return; }
        int dev = 0, cus = 0, per_cu = 0;
        if (hipGetDevice(&dev) != hipSuccess || hipDeviceGetAttribute(&cus, hipDeviceAttributeMultiprocessorCount, dev) != hipSuccess) { grid = -1; return; }
        if (hipFuncSetAttribute((const void*)hymba_fwd, hipFuncAttributeMaxDynamicSharedMemorySize, LDS_BYTES) != hipSuccess) { fprintf(stderr, "kernel_launch: hipFuncSetAttribute failed\n"); grid = -1; return; }
        if (hipOccupancyMaxActiveBlocksPerMultiprocessor(&per_cu, (const void*)hymba_fwd, NWAVES * 64, LDS_BYTES) != hipSuccess || per_cu < 1) { fprintf(stderr, "kernel_launch: occupancy query reports %d workgroups per CU\n", per_cu); per_cu = 1; }
        (void)hipGetLastError();
        grid = cus;
    }
    if (grid < 0) return;
    (void)hipMemsetAsync((char*)d_ws + WS_CTL, 0, CTL_ZERO_BYTES, stream);
    HOST_EXTRA
    Args a{};
    for (int i = 0; i < 16; ++i) a.in[i] = (const float*)d_in[i];
    a.out = (float*)d_out; a.ws = (unsigned char*)d_ws;
    hipLaunchKernelGGL(hymba_fwd, dim3(grid), dim3(NWAVES * 64), LDS_BYTES, stream, a);
}
```

```cpp
#include <hip/hip_runtime.h>
#include <cstdio>
#include <cstdint>
namespace pg8 {
#define PG8_LAS __attribute__((address_space(3)))
typedef unsigned short bf16_t;
typedef short bf16x8 __attribute__((ext_vector_type(8)));
typedef float f32x4 __attribute__((ext_vector_type(4)));
typedef unsigned u32x4 __attribute__((ext_vector_type(4)));
constexpr int BM = 256, BK = 64, HALF = 128, HTB = HALF * BK * 2  , STAGE_BYTES = 8 * HTB, NXCD = 8, WGM = 8;

__host__ __device__ __forceinline__ int lds_byte(int r, int c) { const int st = (r >> 4) * 2 + (c >> 5), rr = r & 15, cc = c & 31, ob = rr * 64 + cc * 2; return st * 1024 + (ob ^ (((ob >> 9) & 1) << 5)); }
__host__ __device__ __forceinline__ void stage_rc(int b, int& R, int& C) { const int st = b / 1024, sb = b % 1024, swz = sb ^ (((sb >> 9) & 1) << 5); R = (st >> 1) * 16 + swz / 64; C = (st & 1) * 32 + (swz % 64) / 2; }
__host__ __device__ __forceinline__ int perm32(int rho) { const int n = rho >> 4, i = rho & 15; return 8 * (i >> 2) + 4 * n + (i & 3); }

struct Unit { int pm, pn; };
struct Gemm { const bf16_t* A; const bf16_t* Bt; int M, N, K; };

struct StaticOrder {
    int nM, nN, nwg, G, c;
    __host__ __device__ void init(int M, int N, int G_, int c_) { nM = M / BM; nN = N / BM; nwg = nM * nN; G = G_; c = c_; }
    __host__ __device__ bool next(int i, Unit& u) const {
        const long L = (long)i * G + c; if (L >= nwg) return false;
        int wgid = (int)L; { const int q = nwg / NXCD, r = nwg % NXCD, xcd = wgid % NXCD, off = wgid / NXCD; wgid = (xcd < r ? xcd * (q + 1) : r * (q + 1) + (xcd - r) * q) + off; }
        const int nig = WGM * nN, gid = wgid / nig, fm = gid * WGM, gsz = (nM - fm) < WGM ? (nM - fm) : WGM;
        u.pm = fm + ((wgid % nig) % gsz); u.pn = (wgid % nig) / gsz; return true;
    }
    __device__ __forceinline__ void a_ready(const Unit&) const {}
    __device__ __forceinline__ void done(const Unit&) const {}
};

__device__ __forceinline__ unsigned cvt_pk_bf16(float lo, float hi) { unsigned r; asm volatile("v_cvt_pk_bf16_f32 %0, %1, %2" : "=v"(r) : "v"(lo), "v"(hi)); return r; }

struct EpiProj {
    static constexpr bool PERM = true, AFTER_DRAIN = false;
    bf16_t* base; bf16_t* wdad; const float* ropec; const float* ropes; size_t gstride;
    __device__ __forceinline__ void operator()(const f32x4 (&acc)[2][2][4][2], const Unit& u, int wr, int wc, int fr, int fq) const {
        const int row0 = u.pm * BM + wr * 64 + fr;
        if (u.pn < 32) {
            const int group = u.pn >> 2; bf16_t* bg = base + (size_t)group * gstride;
            const int col0 = (u.pn & 3) * BM + wc * 32 + 8 * fq;
            const bool rope = (group == 5 || group == 6) && wc == 0;
#pragma unroll
            for (int ai = 0; ai < 2; ++ai)
#pragma unroll
                for (int m = 0; m < 4; ++m) { const int row = row0 + ai * HALF + m * 16; bf16_t* rowp = bg + (size_t)row * 1024 + col0;
                    f32x4 cs = (f32x4){1.f, 1.f, 1.f, 1.f}, sn = (f32x4){0.f, 0.f, 0.f, 0.f};
                    if (rope) { cs = *(const f32x4*)(ropec + (size_t)row * 16 + 4 * fq); sn = *(const f32x4*)(ropes + (size_t)row * 16 + 4 * fq); }
#pragma unroll
                    for (int bj = 0; bj < 2; ++bj) { f32x4 v0 = acc[ai][bj][m][0], v1 = acc[ai][bj][m][1];
                        if (rope) { const f32x4 a = v0 * cs - v1 * sn, b = v1 * cs + v0 * sn; v0 = a; v1 = b; }
                        u32x4 w; w.x = cvt_pk_bf16(v0[0], v0[1]); w.y = cvt_pk_bf16(v0[2], v0[3]); w.z = cvt_pk_bf16(v1[0], v1[1]); w.w = cvt_pk_bf16(v1[2], v1[3]);
                        *(u32x4*)(rowp + bj * HALF) = w; } }
        } else {
            const int col0 = wc * 32 + 8 * fq;
#pragma unroll
            for (int ai = 0; ai < 2; ++ai)
#pragma unroll
                for (int m = 0; m < 4; ++m) { const int row = row0 + ai * HALF + m * 16; bf16_t* rowp = wdad + (size_t)row * 128 + col0;
                    const f32x4 v0 = acc[ai][0][m][0], v1 = acc[ai][0][m][1];
                    u32x4 w; w.x = cvt_pk_bf16(v0[0], v0[1]); w.y = cvt_pk_bf16(v0[2], v0[3]); w.z = cvt_pk_bf16(v1[0], v1[1]); w.w = cvt_pk_bf16(v1[2], v1[3]);
                    *(u32x4*)rowp = w; }
        }
    }
};

struct EpiOut {
    static constexpr bool PERM = false, AFTER_DRAIN = false;
    const float* x; float* out; float* rowss; int ldc;
    __device__ __forceinline__ void operator()(const f32x4 (&acc)[2][2][4][2], const Unit& u, int wr, int wc, int fr, int fq) const {
        const int row0 = u.pm * BM + wr * 64 + fr, col0 = u.pn * BM + wc * 32 + 4 * fq;
#pragma unroll
        for (int ai = 0; ai < 2; ++ai)
#pragma unroll
            for (int m = 0; m < 4; ++m) { const int row = row0 + ai * HALF + m * 16; const size_t off = (size_t)row * ldc + col0; float ss = 0.f;
#pragma unroll
                for (int bj = 0; bj < 2; ++bj)
#pragma unroll
                    for (int n = 0; n < 2; ++n) { const f32x4 xv = *(const f32x4*)(x + off + bj * HALF + n * 16); const f32x4 h = xv + acc[ai][bj][m][n];
                        *(f32x4*)(out + off + bj * HALF + n * 16) = h; ss += (h[0] * h[0] + h[1] * h[1]) + (h[2] * h[2] + h[3] * h[3]); }
                ss += __shfl_xor(ss, 16); ss += __shfl_xor(ss, 32);
                if (fq == 0) rowss[(size_t)row * 32 + u.pn * 4 + wc] = ss; }
    }
};
template <class Epi, class Sched, bool ALIGN_EPI = false, bool SP2 = false>
__device__ __forceinline__ void gemm_phase(PG8_LAS unsigned char* lds, const Gemm g, const Sched& S, const Epi& E) {
    int tid_ = threadIdx.x; asm volatile("" : "+v"(tid_));
    const int tid = tid_, wid = __builtin_amdgcn_readfirstlane(tid >> 6), lane = tid & 63, wr = wid >> 2, wc = wid & 3, fr = lane & 15, fq = lane >> 4;
    const int K = g.K, nt = K / BK;
    unsigned voffA[2], voffB[2];
#pragma unroll
    for (int i = 0; i < 2; ++i) { int R, C; stage_rc(tid * 16 + i * 8192, R, C); const int Rb = Epi::PERM ? ((R & ~31) + perm32(R & 31)) : R;
        voffA[i] = (unsigned)(R * K + C) * 2u; voffB[i] = (unsigned)(Rb * K + C) * 2u; }
    const size_t kstep = (size_t)(BK * 2);
    const size_t hstep = (size_t)HALF * K * 2;
    const size_t tstep = 2 * hstep;
    const unsigned ldsw = (unsigned)wid * 1024u;
    const int aoff = lds_byte(wr * 64 + fr, fq * 8), boff = lds_byte(wc * 32 + fr, fq * 8);
#define PG8_SA(b, h) (((b) * 2 + (h)) * HTB)
#define PG8_SB(b, h) ((4 + (b) * 2 + (h)) * HTB)
#define PG8_STAGE(bufoff, gbase, voff) do { _Pragma("unroll") for (int _i = 0; _i < 2; ++_i) \
        __builtin_amdgcn_global_load_lds((const unsigned*)((const char*)(gbase) + (voff)[_i]), (PG8_LAS unsigned*)(lds + (bufoff) + ldsw + _i * 8192), 16, 0, 0); } while (0)
#define PG8_LDA(dst, b, h) do { _Pragma("unroll") for (int m = 0; m < 4; ++m) _Pragma("unroll") for (int k = 0; k < 2; ++k) dst[m][k] = *(const PG8_LAS bf16x8*)(lds + PG8_SA(b, h) + aoff + m * 2048 + k * 1024); } while (0)
#define PG8_LDB(dst, b, h) do { _Pragma("unroll") for (int n = 0; n < 2; ++n) _Pragma("unroll") for (int k = 0; k < 2; ++k) dst[n][k] = *(const PG8_LAS bf16x8*)(lds + PG8_SB(b, h) + boff + n * 2048 + k * 1024); } while (0)
#define PG8_MMA(ai, bj, At, Bt) do { __builtin_amdgcn_s_setprio(1); _Pragma("unroll") for (int m = 0; m < 4; ++m) _Pragma("unroll") for (int n = 0; n < 2; ++n) _Pragma("unroll") for (int k = 0; k < 2; ++k) \
        acc[ai][bj][m][n] = __builtin_amdgcn_mfma_f32_16x16x32_bf16(Bt[n][k], At[m][k], acc[ai][bj][m][n], 0, 0, 0); __builtin_amdgcn_s_setprio(0); } while (0)
#define PG8_WAIT_V(n) asm volatile("s_waitcnt vmcnt(" #n ")" ::: "memory")
#define PG8_WAIT_L(n) asm volatile("s_waitcnt lgkmcnt(" #n ")" ::: "memory")
#define PG8_BAR __builtin_amdgcn_s_barrier()
#define PG8_SCHED __builtin_amdgcn_sched_barrier(0)
    Unit cur, nxt; int ui = 0;
    if (!S.next(0, cur)) return;
    f32x4 acc[2][2][4][2];
#pragma unroll
    for (int a = 0; a < 2; ++a)
#pragma unroll
        for (int b = 0; b < 2; ++b)
#pragma unroll
            for (int m = 0; m < 4; ++m)
#pragma unroll
                for (int n = 0; n < 2; ++n) acc[a][b][m][n] = (f32x4){0.f, 0.f, 0.f, 0.f};
    bf16x8 At[4][2], B0[2][2], B1[2][2];
    const char* cA = (const char*)g.A + (size_t)cur.pm * tstep; const char* cB = (const char*)g.Bt + (size_t)cur.pn * tstep;
    S.a_ready(cur);
    if constexpr (SP2) {
        PG8_STAGE(PG8_SB(0, 0), cB, voffB); PG8_STAGE(PG8_SB(0, 1), cB + hstep, voffB); PG8_STAGE(PG8_SA(0, 0), cA, voffA); PG8_STAGE(PG8_SA(0, 1), cA + hstep, voffA);
        if (wr == 1) PG8_BAR;
        PG8_WAIT_V(2); PG8_BAR;
        PG8_STAGE(PG8_SB(1, 0), cB + kstep, voffB); PG8_STAGE(PG8_SA(1, 0), cA + kstep, voffA); PG8_STAGE(PG8_SB(1, 1), cB + hstep + kstep, voffB);
        PG8_WAIT_V(6); PG8_BAR;
    } else {
        PG8_STAGE(PG8_SB(0, 0), cB, voffB); PG8_STAGE(PG8_SA(0, 0), cA, voffA); PG8_STAGE(PG8_SB(0, 1), cB + hstep, voffB); PG8_STAGE(PG8_SA(0, 1), cA + hstep, voffA);
        if (wr == 1) PG8_BAR;
        PG8_WAIT_V(4); PG8_BAR;
        PG8_STAGE(PG8_SB(1, 0), cB + kstep, voffB); PG8_STAGE(PG8_SA(1, 0), cA + kstep, voffA); PG8_STAGE(PG8_SB(1, 1), cB + hstep + kstep, voffB);
        PG8_WAIT_V(6); PG8_BAR;
    }
    for (;;) {
        const bool has_next = S.next(ui + 1, nxt);
        const char* nA = has_next ? (const char*)g.A + (size_t)nxt.pm * tstep : cA; const char* nB = has_next ? (const char*)g.Bt + (size_t)nxt.pn * tstep : cB;
        for (int t = 0; t < nt; t += 2) {
            const bool last = (t == nt - 2);
            const char* a1 = cA + (size_t)(t + 1) * kstep;
            const char* a2 = last ? nA : cA + (size_t)(t + 2) * kstep; const char* b2 = last ? nB : cB + (size_t)(t + 2) * kstep;
            const char* a3 = a2 + kstep; const char* b3 = b2 + kstep;
            if (last && has_next) S.a_ready(nxt);
            if constexpr (SP2) {
            PG8_LDB(B0, 0, 0); PG8_LDB(B1, 0, 1); PG8_SCHED; PG8_LDA(At, 0, 0); PG8_STAGE(PG8_SA(1, 1), a1 + hstep, voffA);
            PG8_WAIT_V(8); PG8_WAIT_L(0); PG8_BAR; PG8_MMA(0, 0, At, B0); PG8_MMA(0, 1, At, B1); PG8_BAR; PG8_SCHED;
            PG8_LDA(At, 0, 1); PG8_STAGE(PG8_SB(0, 0), b2, voffB); PG8_STAGE(PG8_SB(0, 1), b2 + hstep, voffB); PG8_STAGE(PG8_SA(0, 0), a2, voffA);
            PG8_WAIT_V(8); PG8_WAIT_L(0); PG8_BAR; PG8_MMA(1, 0, At, B0); PG8_MMA(1, 1, At, B1); PG8_BAR; PG8_SCHED;
            PG8_LDB(B0, 1, 0); PG8_LDB(B1, 1, 1); PG8_SCHED; PG8_LDA(At, 1, 0); PG8_STAGE(PG8_SA(0, 1), a2 + hstep, voffA);
            PG8_WAIT_V(8); PG8_WAIT_L(0); PG8_BAR; PG8_MMA(0, 0, At, B0); PG8_MMA(0, 1, At, B1); PG8_BAR; PG8_SCHED;
            PG8_LDA(At, 1, 1); PG8_STAGE(PG8_SB(1, 0), b3, voffB); PG8_STAGE(PG8_SB(1, 1), b3 + hstep, voffB); PG8_STAGE(PG8_SA(1, 0), a3, voffA);
            PG8_WAIT_V(8); PG8_WAIT_L(0); PG8_BAR; PG8_MMA(1, 0, At, B0); PG8_MMA(1, 1, At, B1); PG8_BAR; PG8_SCHED;
            } else {
            PG8_LDB(B0, 0, 0); PG8_SCHED; PG8_LDA(At, 0, 0); PG8_STAGE(PG8_SA(1, 1), a1 + hstep, voffA);
            PG8_WAIT_L(8); PG8_BAR; PG8_WAIT_L(0); PG8_MMA(0, 0, At, B0); PG8_BAR; PG8_SCHED;
            PG8_LDB(B1, 0, 1); PG8_STAGE(PG8_SB(0, 0), b2, voffB);
            PG8_BAR; PG8_WAIT_L(0); PG8_MMA(0, 1, At, B1); PG8_BAR;
            PG8_LDA(At, 0, 1); PG8_STAGE(PG8_SA(0, 0), a2, voffA);
            PG8_BAR; PG8_WAIT_L(0); PG8_MMA(1, 0, At, B0); PG8_BAR; PG8_SCHED;
            PG8_STAGE(PG8_SB(0, 1), b2 + hstep, voffB);
            PG8_WAIT_V(6); PG8_BAR; PG8_MMA(1, 1, At, B1); PG8_BAR;
            PG8_LDB(B0, 1, 0); PG8_SCHED; PG8_LDA(At, 1, 0); PG8_STAGE(PG8_SA(0, 1), a2 + hstep, voffA);
            PG8_WAIT_L(8); PG8_BAR; PG8_WAIT_L(0); PG8_MMA(0, 0, At, B0); PG8_BAR; PG8_SCHED;
            PG8_LDB(B1, 1, 1); PG8_STAGE(PG8_SB(1, 0), b3, voffB);
            PG8_BAR; PG8_WAIT_L(0); PG8_MMA(0, 1, At, B1); PG8_BAR;
            PG8_LDA(At, 1, 1); PG8_STAGE(PG8_SA(1, 0), a3, voffA);
            PG8_BAR; PG8_WAIT_L(0); PG8_MMA(1, 0, At, B0); PG8_BAR; PG8_SCHED;
            PG8_STAGE(PG8_SB(1, 1), b3 + hstep, voffB);
            PG8_WAIT_V(6); PG8_BAR; PG8_MMA(1, 1, At, B1); PG8_BAR;
            }
        }
        if constexpr (ALIGN_EPI) { if (wr == 0) PG8_BAR; }
        if constexpr (!Epi::AFTER_DRAIN) { E(acc, cur, wr, wc, fr, fq); S.done(cur); }
        if (!has_next) break;
#pragma unroll
        for (int a = 0; a < 2; ++a)
#pragma unroll
            for (int b = 0; b < 2; ++b)
#pragma unroll
                for (int m = 0; m < 4; ++m)
#pragma unroll
                    for (int n = 0; n < 2; ++n) acc[a][b][m][n] = (f32x4){0.f, 0.f, 0.f, 0.f};
        cur = nxt; cA = nA; cB = nB; ++ui;
        if constexpr (ALIGN_EPI) { if (wr == 1) PG8_BAR; }
    }
    PG8_WAIT_V(0);
    if constexpr (!ALIGN_EPI) { if (wr == 0) PG8_BAR; }
    PG8_BAR;
    if constexpr (Epi::AFTER_DRAIN) { E.fused(acc, cur, wr, wc, fr, fq, lds, wid, lane); S.done(cur); }
#undef PG8_SA
#undef PG8_SB
#undef PG8_STAGE
#undef PG8_LDA
#undef PG8_LDB
#undef PG8_MMA
#undef PG8_WAIT_V
#undef PG8_WAIT_L
#undef PG8_BAR
#undef PG8_SCHED
}
}

constexpr int NWAVES = 8;
constexpr int T = 16384, D = 2048, DIN = 8320, NPROJ = 8448;
constexpr int RW_H = 16, RW_N = 64, MB_H = 8, MB_D = 128, MB_BLK = 256, MB_NB = 64, LORA = 64;
constexpr float RMS_EPS = 1e-6f, LNX_EPS = 64e-5f;

constexpr size_t MiB = 1u << 20;
constexpr size_t WS_CTL = 0, CTL_ZERO_BYTES = 1 * MiB;
constexpr size_t WS_KMEAN = 1 * MiB;
constexpr size_t WS_KMEANB = WS_KMEAN + 256 * 1024;
constexpr size_t WS_BSC = 2 * MiB;
constexpr size_t WS_W2T = 4 * MiB;
constexpr size_t WS_ROPE = 12 * MiB;
constexpr size_t WS_W1T = 16 * MiB;
constexpr size_t WS_LIST = 16 * MiB;
constexpr size_t WS_XN = 52 * MiB;
constexpr size_t WS_Y = 52 * MiB;
constexpr size_t WS_PROJ = 116 * MiB;
constexpr size_t GRP = 32 * MiB;
constexpr size_t WS_R = WS_PROJ, WS_K = WS_PROJ + GRP, WS_V = WS_PROJ + 2 * GRP, WS_GR = WS_PROJ + 3 * GRP, WS_GM = WS_PROJ + 4 * GRP,
                 WS_Q = WS_PROJ + 5 * GRP, WS_KM = WS_PROJ + 6 * GRP, WS_VM = WS_PROJ + 7 * GRP;
constexpr size_t WS_WDAD = 372 * MiB;
constexpr size_t WS_PARTO = 376 * MiB;
constexpr size_t WS_PARTML = 504 * MiB;
constexpr size_t WS_ROWSS = 508 * MiB;
constexpr size_t WS_MIXED = WS_Q;
constexpr size_t WS_END = 510 * MiB;
constexpr int CW_BAR = 4096;
constexpr int CW_CNT = 16384;

constexpr int LDS_BYTES = 155648;
constexpr int MISC_OFF = 147456;

#define GAS __attribute__((address_space(1)))
#define LAS __attribute__((address_space(3)))
typedef unsigned short bf16;
typedef unsigned v4u __attribute__((ext_vector_type(4)));
typedef unsigned v2u __attribute__((ext_vector_type(2)));
typedef float f32x4 __attribute__((ext_vector_type(4)));
typedef float f32x2 __attribute__((ext_vector_type(2)));
typedef short bf16x8 __attribute__((ext_vector_type(8)));
typedef short s16x4 __attribute__((ext_vector_type(4)));
typedef GAS unsigned gu32;
#define RLX_AGENT __ATOMIC_RELAXED, __HIP_MEMORY_SCOPE_AGENT
#define LDS_WAIT() asm volatile("s_waitcnt lgkmcnt(0)" ::: "memory")
#define VM_WAIT() asm volatile("s_waitcnt vmcnt(0)" ::: "memory")
typedef __bf16 hwbf2 __attribute__((ext_vector_type(2)));
__device__ __forceinline__ unsigned f2bf(float f) { return (unsigned)__builtin_bit_cast(unsigned short, (__bf16)f); }
__device__ __forceinline__ unsigned pk2(float lo, float hi) { return __builtin_bit_cast(unsigned, __builtin_convertvector((f32x2){lo, hi}, hwbf2)); }
__device__ __forceinline__ float bflo(unsigned w) { return __builtin_bit_cast(float, w << 16); }
__device__ __forceinline__ float bfhi(unsigned w) { return __builtin_bit_cast(float, w & 0xffff0000u); }
__device__ __forceinline__ float bf2f(bf16 b) { return __builtin_bit_cast(float, (unsigned)b << 16); }
__device__ __forceinline__ float sigmoidf_(float x) { return __builtin_amdgcn_rcpf(1.f + __expf(-x)); }

#define XB_TMO      128
#define XB_XCNT(j)  (256  + 64 * (j))
#define XB_XSUB(j)  (1280 + 64 * (j))
#define XB_XGEN(j)  (2304 + 64 * (j))
#define XB_TOP      3328
#define XB_TOPGEN   3392
#define XCD_BAR_WORDS 3456
#define XB_SPIN_CAP (1u << 22)

__device__ __forceinline__ unsigned xb_ld(unsigned* p)              { return __hip_atomic_load(p, __ATOMIC_RELAXED, __HIP_MEMORY_SCOPE_AGENT); }
__device__ __forceinline__ unsigned xb_add(unsigned* p, unsigned v) { return __hip_atomic_fetch_add(p, v, __ATOMIC_RELAXED, __HIP_MEMORY_SCOPE_AGENT); }
__device__ __forceinline__ unsigned xb_xcc_id() { return (unsigned)__builtin_amdgcn_s_getreg((3 << 11) | 20) & 0xFu; }
#define XB_SPIN(cond, bar) do { unsigned _sp = 0; while (cond) { __builtin_amdgcn_s_sleep(1); \
    if ((++_sp & 255u) == 0u) { if (xb_ld(&(bar)[XB_TMO])) break; if (_sp > XB_SPIN_CAP) { atomicAdd(&(bar)[XB_TMO], 1u); break; } } } } while (0)

struct XcdBarrier { unsigned* bar; unsigned x; volatile LAS unsigned* st; };

__device__ __forceinline__ XcdBarrier xcd_barrier_post(unsigned* bar, volatile LAS unsigned* st) {
    XcdBarrier b; b.bar = bar; b.x = xb_xcc_id(); b.st = st;
    if (threadIdx.x == 0) (void)xb_add(&bar[XB_XCNT(b.x)], 1u);
    return b;
}
__device__ __forceinline__ void xcd_barrier_complete(unsigned* bar, unsigned x, unsigned& nloc, unsigned& nx) {
    const unsigned G = gridDim.x * gridDim.y * gridDim.z;
    unsigned sum, cnt, mine, sp = 0u;
    for (;;) {
        sum = 0u; cnt = 0u; mine = 0u;
#pragma unroll
        for (unsigned j = 0; j < 16; ++j) { const unsigned c = xb_ld(&bar[XB_XCNT(j)]); sum += c; cnt += (c > 0u) ? 1u : 0u; mine = (j == x) ? c : mine; }
        if (sum == G) break;
        __builtin_amdgcn_s_sleep(1);
        if ((++sp & 255u) == 0u) { if (xb_ld(&bar[XB_TMO])) break; if (sp > XB_SPIN_CAP) { atomicAdd(&bar[XB_TMO], 1u); break; } }
    }
    nloc = mine > 0u ? mine : 1u; nx = cnt > 0u ? cnt : 1u;
}
__device__ __forceinline__ void xcd_barrier(const XcdBarrier& b) {
    asm volatile("s_waitcnt vmcnt(0)" ::: "memory");
    __syncthreads();
    if (threadIdx.x == 0) {
        unsigned* bar = b.bar;
        __builtin_amdgcn_s_waitcnt(0);
        unsigned nloc = b.st[0], nx = b.st[1];
        if (nloc == 0u) { xcd_barrier_complete(bar, b.x, nloc, nx); b.st[0] = nloc; b.st[1] = nx; }
        const unsigned old = xb_add(&bar[XB_XSUB(b.x)], 1u);
        const unsigned gen = old / nloc;
        if (old + 1u == (gen + 1u) * nloc) {
            __builtin_amdgcn_fence(__ATOMIC_RELEASE, "agent");
            asm volatile("s_waitcnt vmcnt(0)" ::: "memory");
            const unsigned og = xb_add(&bar[XB_TOP], 1u);
            const unsigned tg = og / nx;
            if (og + 1u == (tg + 1u) * nx) xb_add(&bar[XB_TOPGEN], 1u);
            else XB_SPIN(xb_ld(&bar[XB_TOPGEN]) == tg, bar);
            __builtin_amdgcn_fence(__ATOMIC_ACQUIRE, "agent");
            xb_add(&bar[XB_XGEN(b.x)], 1u);
            asm volatile("s_waitcnt vmcnt(0)" ::: "memory");
        } else {
            XB_SPIN(xb_ld(&bar[XB_XGEN(b.x)]) == gen, bar);
            __builtin_amdgcn_fence(__ATOMIC_ACQUIRE, "agent");
            asm volatile("s_waitcnt vmcnt(0)" ::: "memory");
        }
    }
    __syncthreads();
}

struct Frame {
    LAS unsigned char* lds;
    volatile LAS unsigned* MISC;
    gu32* ctl;
    int tid, lane, wave;
    int G, bid;
    unsigned char* ws;
    const float *x, *norm_w, *w_in, *mu_rkv, *mu_lora, *w_decay_up, *w_decay_bias, *w_iclr_up, *w_iclr_bias, *k_k, *k_a, *r_k, *lnx_w, *lnx_b, *w_out, *final_norm_w;
    float* out;
};

__device__ __forceinline__ float wave_sum(float v) {
#pragma unroll
    for (int o = 1; o < 64; o <<= 1) v += __shfl_xor(v, o);
    return v;
}
__device__ __forceinline__ float wave_max(float v) {
#pragma unroll
    for (int o = 1; o < 64; o <<= 1) v = fmaxf(v, __shfl_xor(v, o));
    return v;
}

__device__ __forceinline__ int w1_src_col(int n) {
    if (n < 8192) {
        const int g = n >> 10, w = n & 1023;
        if (g == 5 || g == 6) {
            const int base = (g == 5) ? 4224 : 5248, hh = w >> 7, p = w & 127; int d = p;
            if (p < 32) { const int a = p >> 3, b = p & 7; d = (b < 4) ? (4 * a + b) : (16 + 4 * a + (b - 4)); }
            return base + hh * 128 + d;
        }
        const int base = (g == 0) ? 0 : (g == 1) ? 1024 : (g == 2) ? 2048 : (g == 3) ? 3200 : (g == 4) ? 7296 : 6272;
        return base + w;
    }
    if (n < 8320) return 3072 + (n - 8192);
    return -1;
}
template <bool MAP>
__device__ __forceinline__ void p0_transpose_item(const float* W, const float* rowscale, int K, int N, bf16* WT, int nblk, LAS float* scr, int item, int lane) {
    const int kb = item / nblk, nb = item % nblk, k0 = 64 * kb, n0 = 64 * nb, kq = lane >> 4, nq = lane & 15;
    const int nd = n0 + 4 * nq; const int src = MAP ? w1_src_col(nd) : nd;
    f32x4 v[16];
#pragma unroll
    for (int i = 0; i < 16; ++i) { const int k = k0 + 4 * i + kq; v[i] = (src >= 0) ? *(const GAS f32x4*)(W + (size_t)k * N + src) : (f32x4){0.f, 0.f, 0.f, 0.f}; if (MAP) v[i] = v[i] * rowscale[k]; }
#pragma unroll
    for (int i = 0; i < 16; ++i) { LAS float* d = scr + (4 * i + kq) * 65 + 4 * nq; d[0] = v[i].x; d[1] = v[i].y; d[2] = v[i].z; d[3] = v[i].w; }
    LDS_WAIT(); asm volatile("" ::: "memory");
    const int c = lane & 7;
#pragma unroll
    for (int j = 0; j < 8; ++j) { const int n = (lane >> 3) + 8 * j; const LAS float* sp = scr + (8 * c) * 65 + n;
        v4u o; o.x = pk2(sp[0 * 65], sp[1 * 65]); o.y = pk2(sp[2 * 65], sp[3 * 65]); o.z = pk2(sp[4 * 65], sp[5 * 65]); o.w = pk2(sp[6 * 65], sp[7 * 65]);
        *(GAS v4u*)(WT + (size_t)(n0 + n) * K + k0 + 8 * c) = o; }
    LDS_WAIT(); asm volatile("" ::: "memory");
}
__device__ __forceinline__ void rms_row_to_bf16(const float* xrow, bf16* orow, int lane) {
    const GAS f32x4* xr = (const GAS f32x4*)xrow + lane;
    f32x4 v[8]; float s = 0.f;
#pragma unroll
    for (int j = 0; j < 8; ++j) { v[j] = xr[64 * j]; s += (v[j].x * v[j].x + v[j].y * v[j].y) + (v[j].z * v[j].z + v[j].w * v[j].w); }
    const float rs = 1.f / sqrtf(wave_sum(s) * (1.f / D) + RMS_EPS);
    GAS unsigned long long* o8 = (GAS unsigned long long*)orow + lane;
#pragma unroll
    for (int j = 0; j < 8; ++j) o8[64 * j] = (unsigned long long)pk2(v[j].x * rs, v[j].y * rs) | ((unsigned long long)pk2(v[j].z * rs, v[j].w * rs) << 32);
}
__device__ __forceinline__ void p0_prologue(Frame& F) {
    LAS float* scr = (LAS float*)(F.lds + F.wave * 17408);
    const int gw = F.bid * NWAVES + F.wave, NGW = F.G * NWAVES;
    constexpr int I_1 = (D / 64) * (NPROJ / 64), I_2 = (D / 64) * (D / 64);
#pragma unroll 1
    for (int pass = 0; pass < 2; ++pass) {
        if ((pass == 0) == ((F.wave & 1) == 0)) {
            for (int it = gw; it < I_1 + I_2; it += NGW) {
                if (it < I_1) p0_transpose_item<true>(F.w_in, F.norm_w, D, DIN, (bf16*)(F.ws + WS_W1T), NPROJ / 64, scr, it, F.lane);
                else p0_transpose_item<false>(F.w_out, nullptr, D, D, (bf16*)(F.ws + WS_W2T), D / 64, scr, it - I_1, F.lane);
            }
        } else {
            for (int m = gw; m < T; m += NGW) rms_row_to_bf16(F.x + (size_t)m * D, (bf16*)(F.ws + WS_XN) + (size_t)m * D, F.lane);
        }
    }
    { bf16* wdt = (bf16*)(F.ws + 1 * MiB + 512 * 1024); bf16* wit = (bf16*)(F.ws + 1 * MiB + 640 * 1024);
      for (int e = F.bid * 512 + F.tid; e < 1024 * 64; e += F.G * 512) { const int c = e >> 6, l = e & 63; wdt[e] = (bf16)f2bf(F.w_decay_up[(size_t)l * 1024 + c]); wit[e] = (bf16)f2bf(F.w_iclr_up[(size_t)l * 1024 + c]); } }
    { float* rc = (float*)(F.ws + WS_ROPE); float* rsn = rc + (size_t)T * 16;
      for (int e = F.bid * 512 + F.tid; e < T * 16; e += F.G * 512) { const int t = e >> 4, i = e & 15;
          const double invf = exp2(-(double)i * (18.931568569324174 / 16.0));
          const double ang = (double)t * invf; const double n = rint(ang * 0.15915494309189535);
          double r = fma(-n, 6.283185307179586, ang); r = fma(-n, 2.4492935982947064e-16, r);
          const float rf = (float)r; rc[e] = cosf(rf); rsn[e] = sinf(rf); } }
}

__device__ __forceinline__ f32x4 mfma16(bf16x8 a, bf16x8 b, f32x4 c) { return __builtin_amdgcn_mfma_f32_16x16x32_bf16(a, b, c, 0, 0, 0); }
__device__ __forceinline__ int list_off(int h, int j) { return h * 516096 + 256 * (63 * j - (j * (j - 1)) / 2); }

__device__ __forceinline__ void p2_kmean(Frame& F) {
    const bf16* KM = (const bf16*)(F.ws + WS_KM); float* kmean = (float*)(F.ws + WS_KMEAN); bf16* kmeanb = (bf16*)(F.ws + WS_KMEANB);
    LAS float* red = (LAS float*)F.lds;
    const int dp = F.tid & 63, rg = F.tid >> 6;
    for (int u = F.bid; u < MB_NB * MB_H; u += F.G) { const int c = u >> 3, h = u & 7;
        float s0 = 0.f, s1 = 0.f;
        const unsigned* p = (const unsigned*)(KM + (size_t)(c * 256 + rg * 32) * 1024 + 128 * h) + dp;
#pragma unroll 8
        for (int r = 0; r < 32; ++r) { const unsigned w = p[(size_t)r * 512]; s0 += bflo(w); s1 += bfhi(w); }
        red[rg * 128 + 2 * dp] = s0; red[rg * 128 + 2 * dp + 1] = s1;
        __syncthreads();
        if (F.tid < 128) { float s = 0.f;
#pragma unroll
            for (int g = 0; g < 8; ++g) s += red[g * 128 + F.tid];
            s *= (1.f / 256.f); kmean[(size_t)(h * 64 + c) * 128 + F.tid] = s; kmeanb[(size_t)(h * 64 + c) * 128 + F.tid] = (bf16)f2bf(s); }
        __syncthreads();
    }
}

__device__ __forceinline__ void top3_insert(float v, int i, float& v1, int& i1, float& v2, int& i2, float& v3, int& i3) {
    const bool b1 = (v > v1) || (v == v1 && i < i1), b2 = (v > v2) || (v == v2 && i < i2), b3 = (v > v3) || (v == v3 && i < i3);
    const float n3 = b2 ? v2 : (b3 ? v : v3), n2 = b1 ? v1 : (b2 ? v : v2), n1 = b1 ? v : v1;
    const int m3 = b2 ? i2 : (b3 ? i : i3), m2 = b1 ? i1 : (b2 ? i : i2), m1 = b1 ? i : i1;
    v1 = n1; v2 = n2; v3 = n3; i1 = m1; i2 = m2; i3 = m3;
}
__device__ __forceinline__ void p3_gate(Frame& F) {
    const bf16* Q = (const bf16*)(F.ws + WS_Q); const bf16* kmb = (const bf16*)(F.ws + WS_KMEANB);
    unsigned* cnt = (unsigned*)(F.ctl + CW_CNT); int* list = (int*)(F.ws + WS_LIST);
    const int gw = F.bid * NWAVES + F.wave, NGW = F.G * NWAVES, lane = F.lane, qi = lane & 15, g = lane >> 4;
    for (int u = gw; u < (T / 16) * MB_H; u += NGW) { const int qt = u >> 3, h = u & 7, cur = qt >> 4;
        if (cur == 0) continue;
        const int t = qt * 16 + qi;
        bf16x8 qf[4];
#pragma unroll
        for (int ks = 0; ks < 4; ++ks) qf[ks] = *(const bf16x8*)(Q + (size_t)t * 1024 + 128 * h + 32 * ks + 8 * g);
        float v1 = -INFINITY, v2 = -INFINITY, v3 = -INFINITY; int i1 = 1 << 20, i2 = 1 << 20, i3 = 1 << 20;
        const int njt = ((cur - 1) >> 4) + 1;
#pragma unroll
        for (int jt = 0; jt < 4; ++jt) { if (jt < njt) {
            f32x4 acc = (f32x4){0.f, 0.f, 0.f, 0.f};
#pragma unroll
            for (int ks = 0; ks < 4; ++ks) { const bf16x8 a = *(const bf16x8*)(kmb + (size_t)(h * 64 + jt * 16 + qi) * 128 + 32 * ks + 8 * g); acc = mfma16(a, qf[ks], acc); }
#pragma unroll
            for (int r = 0; r < 4; ++r) { const int j = jt * 16 + 4 * g + r; const float v = (j < cur) ? acc[r] : -INFINITY; top3_insert(v, j, v1, i1, v2, i2, v3, i3); }
        } }
#pragma unroll
        for (int o = 16; o <= 32; o <<= 1) {
            const float a1 = __shfl_xor(v1, o), a2 = __shfl_xor(v2, o), a3 = __shfl_xor(v3, o); const int b1 = __shfl_xor(i1, o), b2 = __shfl_xor(i2, o), b3 = __shfl_xor(i3, o);
            top3_insert(a1, b1, v1, i1, v2, i2, v3, i3); top3_insert(a2, b2, v1, i1, v2, i2, v3, i3); top3_insert(a3, b3, v1, i1, v2, i2, v3, i3);
        }
        const int vc = cur < 3 ? cur : 3;
        if (g == 0) {
            if (vc > 0) { const unsigned pos = atomicAdd(&cnt[h * 64 + i1], 1u); list[list_off(h, i1) + pos] = (t << 2) | 0; }
            if (vc > 1) { const unsigned pos = atomicAdd(&cnt[h * 64 + i2], 1u); list[list_off(h, i2) + pos] = (t << 2) | 1; }
            if (vc > 2) { const unsigned pos = atomicAdd(&cnt[h * 64 + i3], 1u); list[list_off(h, i3) + pos] = (t << 2) | 2; }
        }
    }
}

constexpr int KV_STRIDE = 288;
constexpr int KLDS_OFF = 0, VLDS_OFF = 256 * KV_STRIDE, PFX_OFF = MISC_OFF + 1024;
__device__ __forceinline__ void tr_read2(s16x4& r0, s16x4& r1, unsigned a0, unsigned a1) {
    asm volatile("ds_read_b64_tr_b16 %0, %2\n\tds_read_b64_tr_b16 %1, %3\n\ts_waitcnt lgkmcnt(0)" : "=&v"(r0), "=&v"(r1) : "v"(a0), "v"(a1) : "memory"); }

template <int B0, int B1> __device__ __forceinline__ void tr_read16(s16x4 (&r)[16], unsigned base) {
    asm volatile(
        "ds_read_b64_tr_b16 %0, %16 offset:%17\n\tds_read_b64_tr_b16 %1, %16 offset:%18\n\tds_read_b64_tr_b16 %2, %16 offset:%19\n\tds_read_b64_tr_b16 %3, %16 offset:%20\n\t"
        "ds_read_b64_tr_b16 %4, %16 offset:%21\n\tds_read_b64_tr_b16 %5, %16 offset:%22\n\tds_read_b64_tr_b16 %6, %16 offset:%23\n\tds_read_b64_tr_b16 %7, %16 offset:%24\n\t"
        "ds_read_b64_tr_b16 %8, %16 offset:%25\n\tds_read_b64_tr_b16 %9, %16 offset:%26\n\tds_read_b64_tr_b16 %10, %16 offset:%27\n\tds_read_b64_tr_b16 %11, %16 offset:%28\n\t"
        "ds_read_b64_tr_b16 %12, %16 offset:%29\n\tds_read_b64_tr_b16 %13, %16 offset:%30\n\tds_read_b64_tr_b16 %14, %16 offset:%31\n\tds_read_b64_tr_b16 %15, %16 offset:%32\n\t"
        "s_waitcnt lgkmcnt(0)"
        : "=&v"(r[0]), "=&v"(r[1]), "=&v"(r[2]), "=&v"(r[3]), "=&v"(r[4]), "=&v"(r[5]), "=&v"(r[6]), "=&v"(r[7]), "=&v"(r[8]), "=&v"(r[9]), "=&v"(r[10]), "=&v"(r[11]), "=&v"(r[12]), "=&v"(r[13]), "=&v"(r[14]), "=&v"(r[15])
        : "v"(base), "i"(B0), "i"(B0 + 32), "i"(B0 + 64), "i"(B0 + 96), "i"(B0 + 128), "i"(B0 + 160), "i"(B0 + 192), "i"(B0 + 224),
          "i"(B1), "i"(B1 + 32), "i"(B1 + 64), "i"(B1 + 96), "i"(B1 + 128), "i"(B1 + 160), "i"(B1 + 192), "i"(B1 + 224)
        : "memory");
}
template <int S> __device__ __forceinline__ void pv_step(const f32x4& p0, const f32x4& p1, f32x4 (&o)[8], unsigned vb) {
    const v4u w = (v4u){pk2(p0[0], p0[1]), pk2(p0[2], p0[3]), pk2(p1[0], p1[1]), pk2(p1[2], p1[3])}; const bf16x8 pf = __builtin_bit_cast(bf16x8, w);
    s16x4 r[16]; tr_read16<32 * S * KV_STRIDE, (32 * S + 16) * KV_STRIDE>(r, vb);
#pragma unroll
    for (int dt = 0; dt < 8; ++dt) { const bf16x8 a = (bf16x8){r[dt][0], r[dt][1], r[dt][2], r[dt][3], r[8 + dt][0], r[8 + dt][1], r[8 + dt][2], r[8 + dt][3]}; o[dt] = mfma16(a, pf, o[dt]); }
}

__device__ __forceinline__ void p4_attn_items(Frame& F) {
    const bf16* Q = (const bf16*)(F.ws + WS_Q); const bf16* KM = (const bf16*)(F.ws + WS_KM); const bf16* VM = (const bf16*)(F.ws + WS_VM);
    const unsigned* cnt = (const unsigned*)(F.ctl + CW_CNT); const int* list = (const int*)(F.ws + WS_LIST);
    bf16* parto = (bf16*)(F.ws + WS_PARTO); float* partml = (float*)(F.ws + WS_PARTML);
    LAS int* pfx = (LAS int*)(F.lds + PFX_OFF);
    const int lane = F.lane, qi = lane & 15, g = lane >> 4, wv = F.wave;
    { LAS int* tmp = (LAS int*)(F.lds + PFX_OFF + 2560);
      const int c = (int)__hip_atomic_load(cnt + F.tid, RLX_AGENT); int val = ((c + 127) >> 7) + 2;
      __syncthreads();
      for (int d = 1; d < 512; d <<= 1) { tmp[F.tid] = val; __syncthreads(); if (F.tid >= d) val += tmp[F.tid - d]; __syncthreads(); }
      pfx[1 + F.tid] = val; if (F.tid == 0) pfx[0] = 0; }
    __syncthreads();
#define PFX(i) __builtin_amdgcn_readfirstlane(pfx[i])
    const int total = PFX(512);
    const int per = (total + F.G - 1) / F.G, lo = F.bid * per, hi = (lo + per < total) ? lo + per : total;
    if (lo >= hi) return;
    int u = 0; { int a = 0, b = 512; while (b - a > 1) { const int mid = (a + b) >> 1; if (PFX(mid) <= lo) a = mid; else b = mid; } u = a; }
    int loaded = -1;
    const float scale = 0.08838834764831845f;
#define P4_ENTRY(IT, UU, EN) do { const int it_ = (IT) < hi ? (IT) : hi - 1; while (it_ >= PFX(UU + 1)) ++UU; const int h_ = UU >> 6, j_ = UU & 63, tl_ = it_ - PFX(UU), ns_ = PFX(UU + 1) - PFX(UU) - 2; \
        if (tl_ >= ns_) EN = ((256 * j_ + 128 * (tl_ - ns_) + 16 * wv + qi) << 2) | 3; \
        else { const int n_ = (int)__hip_atomic_load(cnt + UU, RLX_AGENT); int e_ = tl_ * 128 + 16 * wv + qi; const bool ok_ = e_ < n_; if (!ok_) e_ = n_ - 1; const int en_ = list[list_off(h_, j_) + e_]; EN = ok_ ? en_ : (en_ | (int)0x80000000); } } while (0)
#define P4_QLOAD(QF, EN, UU) do { const int t_ = ((EN) & 0x7fffffff) >> 2; _Pragma("unroll") for (int ks = 0; ks < 4; ++ks) QF[ks] = *(const bf16x8*)(Q + (size_t)t_ * 1024 + 128 * ((UU) >> 6) + 32 * ks + 8 * g); } while (0)
    int u1 = u, u2 = u, en0, en1, en2 = 0; bf16x8 qf[4], qn[4];
    P4_ENTRY(lo, u, en0); u1 = u; P4_ENTRY(lo + 1, u1, en1); u2 = u1;
    P4_QLOAD(qf, en0, u);
    for (int it = lo; it < hi; ++it) {
        P4_QLOAD(qn, en1, u1);
        P4_ENTRY(it + 2, u2, en2);
        const int h = u >> 6, j = u & 63, tl = it - PFX(u), nsel = PFX(u + 1) - PFX(u) - 2;
        if (u != loaded) {
            __syncthreads();
#pragma unroll
            for (int i = 0; i < 8; ++i) { const int pz = F.tid + 512 * i, row = pz >> 4, cc = pz & 15;
                const v4u kv = *(const GAS v4u*)(KM + (size_t)(256 * j + row) * 1024 + 128 * h + 8 * cc); const v4u vv = *(const GAS v4u*)(VM + (size_t)(256 * j + row) * 1024 + 128 * h + 8 * cc);
                *(LAS v4u*)(F.lds + KLDS_OFF + row * KV_STRIDE + 16 * cc) = kv; *(LAS v4u*)(F.lds + VLDS_OFF + row * KV_STRIDE + 16 * cc) = vv; }
            __syncthreads();
            loaded = u;
        }
        const bool own = tl >= nsel; const int hf = tl - nsel;
        const int t = (en0 & 0x7fffffff) >> 2, slot = en0 & 3; const bool valid = en0 >= 0;
        const int nkt = own ? (8 * hf + wv + 1) : 16;
        f32x4 acc[16];
#pragma unroll
        for (int kt = 0; kt < 16; ++kt) { acc[kt] = (f32x4){0.f, 0.f, 0.f, 0.f};
            if (kt < nkt) {
#pragma unroll
                for (int ks = 0; ks < 4; ++ks) { const bf16x8 a = *(const LAS bf16x8*)(F.lds + KLDS_OFF + (16 * kt + qi) * KV_STRIDE + 64 * ks + 16 * g); acc[kt] = mfma16(a, qf[ks], acc[kt]); } } }
        const int tq = t - 256 * j;
        float m = -INFINITY;
#pragma unroll
        for (int kt = 0; kt < 16; ++kt)
#pragma unroll
            for (int r = 0; r < 4; ++r) { float s = acc[kt][r] * scale; const int key = 16 * kt + 4 * g + r; if (kt >= nkt || (own && key > tq)) s = -INFINITY; acc[kt][r] = s; m = fmaxf(m, s); }
        m = fmaxf(m, __shfl_xor(m, 16)); m = fmaxf(m, __shfl_xor(m, 32));
        float l = 0.f;
#pragma unroll
        for (int kt = 0; kt < 16; ++kt)
#pragma unroll
            for (int r = 0; r < 4; ++r) { const float p = __expf(acc[kt][r] - m); acc[kt][r] = p; l += p; }
        l += __shfl_xor(l, 16); l += __shfl_xor(l, 32);
        f32x4 o[8];
#pragma unroll
        for (int dt = 0; dt < 8; ++dt) o[dt] = (f32x4){0.f, 0.f, 0.f, 0.f};
        const unsigned vb0 = (unsigned)(VLDS_OFF + (4 * g + (qi >> 2)) * KV_STRIDE + 8 * (qi & 3)), vb1 = vb0 + 128u * KV_STRIDE;
        if (0 < nkt) pv_step<0>(acc[0], acc[1], o, vb0);
        if (2 < nkt) pv_step<1>(acc[2], acc[3], o, vb0);
        if (4 < nkt) pv_step<2>(acc[4], acc[5], o, vb0);
        if (6 < nkt) pv_step<3>(acc[6], acc[7], o, vb0);
        if (8 < nkt) pv_step<0>(acc[8], acc[9], o, vb1);
        if (10 < nkt) pv_step<1>(acc[10], acc[11], o, vb1);
        if (12 < nkt) pv_step<2>(acc[12], acc[13], o, vb1);
        if (14 < nkt) pv_step<3>(acc[14], acc[15], o, vb1);
        if (valid) { const float il = 1.f / l; const size_t pb = ((size_t)t * 8 + h) * 4 + slot;
#pragma unroll
            for (int dt = 0; dt < 8; ++dt) { v2u w; w.x = pk2(o[dt][0] * il, o[dt][1] * il); w.y = pk2(o[dt][2] * il, o[dt][3] * il); *(GAS v2u*)(parto + pb * 128 + 16 * dt + 4 * g) = w; }
            if (g == 0) { f32x2 ml; ml.x = m; ml.y = l; *(GAS f32x2*)(partml + pb * 2) = ml; } }
        en0 = en1; en1 = en2; u = u1; u1 = u2;
#pragma unroll
        for (int ks = 0; ks < 4; ++ks) qf[ks] = qn[ks];
    }
#undef P4_ENTRY
#undef P4_QLOAD
#undef PFX
}

__device__ __forceinline__ void p5_combine(Frame& F) {
    const bf16* parto = (const bf16*)(F.ws + WS_PARTO); const float* partml = (const float*)(F.ws + WS_PARTML); const bf16* GM = (const bf16*)(F.ws + WS_GM);
    bf16* mixed = (bf16*)(F.ws + WS_MIXED);
    const int gw = F.bid * NWAVES + F.wave, NGW = F.G * NWAVES, sub = F.lane >> 4, d0 = 8 * (F.lane & 15);
    for (int pq = gw; pq < T * MB_H / 4; pq += NGW) { const int pr = pq * 4 + sub, t = pr >> 3, h = pr & 7, cur = t >> 8, vc = cur < 3 ? cur : 3;
        float mm[4], ll[4]; float M = -INFINITY;
#pragma unroll
        for (int s = 0; s < 4; ++s) { const bool on = (s == 3) || (s < vc); f32x2 ml = (f32x2){-INFINITY, 0.f}; if (on) ml = *(const GAS f32x2*)(partml + ((size_t)pr * 4 + s) * 2); mm[s] = ml.x; ll[s] = ml.y; M = fmaxf(M, ml.x); }
        float acc[8]; float W = 0.f;
#pragma unroll
        for (int e = 0; e < 8; ++e) acc[e] = 0.f;
#pragma unroll
        for (int s = 0; s < 4; ++s) { const bool on = (s == 3) || (s < vc); if (on) { const float w = __expf(mm[s] - M) * ll[s]; W += w;
            const v4u ov = *(const GAS v4u*)(parto + ((size_t)pr * 4 + s) * 128 + d0);
            acc[0] += w * bflo(ov.x); acc[1] += w * bfhi(ov.x); acc[2] += w * bflo(ov.y); acc[3] += w * bfhi(ov.y); acc[4] += w * bflo(ov.z); acc[5] += w * bfhi(ov.z); acc[6] += w * bflo(ov.w); acc[7] += w * bfhi(ov.w); } }
        const float iw = 1.f / W;
        const v4u gv = *(const GAS v4u*)(GM + (size_t)t * 1024 + 128 * h + d0);
        const float gg[8] = {bflo(gv.x), bfhi(gv.x), bflo(gv.y), bfhi(gv.y), bflo(gv.z), bfhi(gv.z), bflo(gv.w), bfhi(gv.w)};
        float r[8];
#pragma unroll
        for (int e = 0; e < 8; ++e) r[e] = acc[e] * iw * gg[e] * sigmoidf_(gg[e]);
        v4u w; w.x = pk2(r[0], r[1]); w.y = pk2(r[2], r[3]); w.z = pk2(r[4], r[5]); w.w = pk2(r[6], r[7]);
        *(GAS v4u*)(mixed + (size_t)t * 2048 + 1024 + 128 * h + d0) = w;
    }
}

constexpr size_t WS_SR = 52 * MiB;
constexpr size_t WS_SA = 16 * MiB;
constexpr size_t WS_SK = 376 * MiB;
constexpr size_t WS_SV = 440 * MiB;
constexpr size_t WS_SB = WS_GM;
constexpr size_t WS_SW = WS_VM;
constexpr size_t WS_YS = WS_R;

__device__ __forceinline__ void p6_rwkv_prep(Frame& F) {
    const bf16* R = (const bf16*)(F.ws + WS_R); const bf16* K = (const bf16*)(F.ws + WS_K); const bf16* V = (const bf16*)(F.ws + WS_V); const bf16* WDAD = (const bf16*)(F.ws + WS_WDAD);
    float* SR = (float*)(F.ws + WS_SR); float* SK = (float*)(F.ws + WS_SK); float* SV = (float*)(F.ws + WS_SV);
    bf16* SA = (bf16*)(F.ws + WS_SA); bf16* SB = (bf16*)(F.ws + WS_SB); bf16* SW = (bf16*)(F.ws + WS_SW); float* BSC = (float*)(F.ws + WS_BSC);
    LAS float* WD = (LAS float*)(F.lds);
    LAS float* WI = (LAS float*)(F.lds + 16384);
    LAS float* Rs = (LAS float*)(F.lds + 32768);
    LAS float* Ks = (LAS float*)(F.lds + 49152);
    LAS float* TW = (LAS float*)(F.lds + 65536);
    LAS float* AD = (LAS float*)(F.lds + 81920);
    constexpr int NU = RW_H * (T / 64);
    const int upw = (NU + F.G - 1) / F.G;
    const int c = F.tid & 63, tg = F.tid >> 6;
    int hl_ = -1; float kkc = 0.f, kac = 0.f, rkc = 0.f, wb = 0.f, ib = 0.f;
    for (int ui = 0; ui < upw; ++ui) { const int u = F.bid * upw + ui; if (u >= NU) break; const int h = u / (T / 64), chunk = u % (T / 64), t0 = chunk * 64, ch = 64 * h + c;
        __syncthreads();
        if (h != hl_) { hl_ = h;
            for (int e = F.tid; e < 64 * 64; e += 512) { const int l = e >> 6, cc = e & 63; WD[e] = F.w_decay_up[(size_t)l * 1024 + 64 * h + cc]; WI[e] = F.w_iclr_up[(size_t)l * 1024 + 64 * h + cc]; }
            kkc = F.k_k[ch]; kac = F.k_a[ch]; rkc = F.r_k[ch]; wb = F.w_decay_bias[ch]; ib = F.w_iclr_bias[ch]; }
        { const int row = F.tid >> 3, cv = F.tid & 7, t = t0 + row; const size_t o = (size_t)t * 1024 + 64 * h + 8 * cv;
          const v4u z = (v4u){0u, 0u, 0u, 0u};
          const v4u rc = *(const GAS v4u*)(R + o), kc = *(const GAS v4u*)(K + o), vc = *(const GAS v4u*)(V + o);
          const v4u rp = t > 0 ? *(const GAS v4u*)(R + o - 1024) : z, kp = t > 0 ? *(const GAS v4u*)(K + o - 1024) : z, vp = t > 0 ? *(const GAS v4u*)(V + o - 1024) : z;
          const unsigned rcw[4] = {rc.x, rc.y, rc.z, rc.w}, rpw[4] = {rp.x, rp.y, rp.z, rp.w}, kcw[4] = {kc.x, kc.y, kc.z, kc.w}, kpw[4] = {kp.x, kp.y, kp.z, kp.w}, vcw[4] = {vc.x, vc.y, vc.z, vc.w}, vpw[4] = {vp.x, vp.y, vp.z, vp.w};
          float vs[8];
#pragma unroll
          for (int q = 0; q < 4; ++q) {
#pragma unroll
              for (int hl = 0; hl < 2; ++hl) { const int cc = 8 * cv + 2 * q + hl, chn = 64 * h + cc;
                  const float r0 = hl ? bfhi(rcw[q]) : bflo(rcw[q]), r1 = hl ? bfhi(rpw[q]) : bflo(rpw[q]);
                  const float k0 = hl ? bfhi(kcw[q]) : bflo(kcw[q]), k1 = hl ? bfhi(kpw[q]) : bflo(kpw[q]);
                  const float v0 = hl ? bfhi(vcw[q]) : bflo(vcw[q]), v1 = hl ? bfhi(vpw[q]) : bflo(vpw[q]);
                  Rs[row * 64 + cc] = r0 + F.mu_rkv[chn] * (r1 - r0); Ks[row * 64 + cc] = k0 + F.mu_rkv[1024 + chn] * (k1 - k0); vs[2 * q + hl] = v0 + F.mu_rkv[2048 + chn] * (v1 - v0); } }
          *(GAS f32x4*)(SV + o) = (f32x4){vs[0], vs[1], vs[2], vs[3]}; *(GAS f32x4*)(SV + o + 4) = (f32x4){vs[4], vs[5], vs[6], vs[7]};
#pragma unroll
          for (int part = 0; part < 2; ++part) { const int lv = 8 * cv + 64 * part;
              const v4u wc4 = *(const GAS v4u*)(WDAD + (size_t)t * 128 + lv); const v4u wp4 = t > 0 ? *(const GAS v4u*)(WDAD + (size_t)(t - 1) * 128 + lv) : z;
              const unsigned cw[4] = {wc4.x, wc4.y, wc4.z, wc4.w}, pw[4] = {wp4.x, wp4.y, wp4.z, wp4.w};
#pragma unroll
              for (int q = 0; q < 4; ++q)
#pragma unroll
                  for (int hl = 0; hl < 2; ++hl) { const int l = 8 * cv + 2 * q + hl; const float x0 = hl ? bfhi(cw[q]) : bflo(cw[q]), x1 = hl ? bfhi(pw[q]) : bflo(pw[q]);
                      const float xs = x0 + F.mu_lora[64 * part + l] * (x1 - x0);
                      if (part == 0) TW[row * 64 + l] = tanhf(xs); else AD[row * 64 + l] = xs; } } }
        __syncthreads();
        float aw[8], ai[8];
#pragma unroll
        for (int r = 0; r < 8; ++r) { aw[r] = 0.f; ai[r] = 0.f; }
        for (int l4 = 0; l4 < 16; ++l4) {
            const float wd0 = WD[(4 * l4 + 0) * 64 + c], wd1 = WD[(4 * l4 + 1) * 64 + c], wd2 = WD[(4 * l4 + 2) * 64 + c], wd3 = WD[(4 * l4 + 3) * 64 + c];
            const float wi0 = WI[(4 * l4 + 0) * 64 + c], wi1 = WI[(4 * l4 + 1) * 64 + c], wi2 = WI[(4 * l4 + 2) * 64 + c], wi3 = WI[(4 * l4 + 3) * 64 + c];
#pragma unroll
            for (int r = 0; r < 8; ++r) { const f32x4 tw = *(const LAS f32x4*)(TW + (8 * tg + r) * 64 + 4 * l4); const f32x4 ad = *(const LAS f32x4*)(AD + (8 * tg + r) * 64 + 4 * l4);
                aw[r] += tw.x * wd0 + tw.y * wd1 + tw.z * wd2 + tw.w * wd3; ai[r] += ad.x * wi0 + ad.y * wi1 + ad.z * wi2 + ad.w * wi3; }
        }
#pragma unroll
        for (int r = 0; r < 8; ++r) { const int row = 8 * tg + r, t = t0 + row; const size_t o = (size_t)t * 1024 + ch;
            const float lw = -0.6065306597126334f * sigmoidf_(wb + aw[r]);
            const float ic = sigmoidf_(ib + ai[r]);
            const float kr = Ks[row * 64 + c], rr = Rs[row * 64 + c];
            const float kk = kr * kkc; const float nrm = sqrtf(wave_sum(kk * kk)); const float kkn = kk / fmaxf(nrm, 1e-12f);
            const float kp = kr * (1.f + (ic - 1.f) * kac);
            const float bs = wave_sum(rr * kp * rkc);
            SR[o] = rr; SK[o] = kp; SA[o] = (bf16)f2bf(-kkn); SB[o] = (bf16)f2bf(kkn * ic); SW[o] = (bf16)f2bf(lw);
            if (c == 0) BSC[(size_t)t * 16 + h] = bs; }
    }
}

__device__ __forceinline__ float dpp_add16(float x) {
    x += __builtin_bit_cast(float, __builtin_amdgcn_update_dpp(0, __builtin_bit_cast(int, x), 0xB1, 0xf, 0xf, false));
    x += __builtin_bit_cast(float, __builtin_amdgcn_update_dpp(0, __builtin_bit_cast(int, x), 0x4E, 0xf, 0xf, false));
    x += __builtin_bit_cast(float, __builtin_amdgcn_update_dpp(0, __builtin_bit_cast(int, x), 0x141, 0xf, 0xf, false));
    x += __builtin_bit_cast(float, __builtin_amdgcn_update_dpp(0, __builtin_bit_cast(int, x), 0x140, 0xf, 0xf, false));
    return x;
}
constexpr int SC_CH = 64;
__device__ __forceinline__ void p7_rwkv_scan(Frame& F) {
    if (F.bid >= 32) return;
    const float* SR = (const float*)(F.ws + WS_SR); const float* SK = (const float*)(F.ws + WS_SK); const float* SV = (const float*)(F.ws + WS_SV);
    const bf16* SA = (const bf16*)(F.ws + WS_SA); const bf16* SB = (const bf16*)(F.ws + WS_SB); const bf16* SW = (const bf16*)(F.ws + WS_SW); float* Y = (float*)(F.ws + WS_YS);
    const int h = F.bid >> 1, i0 = 32 * (F.bid & 1);
    LAS float* Lr = (LAS float*)(F.lds);
    LAS float* Lk = (LAS float*)(F.lds + 16384);
    LAS float* La = (LAS float*)(F.lds + 32768);
    LAS float* Lb = (LAS float*)(F.lds + 49152);
    LAS float* Lw = (LAS float*)(F.lds + 65536);
    LAS float* Lv = (LAS float*)(F.lds + 81920);
    const int jg = F.lane & 15, rl = 4 * F.wave + (F.lane >> 4);
    f32x4 st = (f32x4){0.f, 0.f, 0.f, 0.f};
    const int srow = F.tid >> 3, scv = F.tid & 7;
    for (int t0 = 0; t0 < T; t0 += SC_CH) {
        __syncthreads();
        { const size_t o = (size_t)(t0 + srow) * 1024 + 64 * h + 8 * scv;
          const f32x4 r0 = *(const GAS f32x4*)(SR + o), r1 = *(const GAS f32x4*)(SR + o + 4), k0 = *(const GAS f32x4*)(SK + o), k1 = *(const GAS f32x4*)(SK + o + 4);
          const v4u a4 = *(const GAS v4u*)(SA + o), b4 = *(const GAS v4u*)(SB + o), w4 = *(const GAS v4u*)(SW + o);
          const f32x4 vv = *(const GAS f32x4*)(SV + (size_t)(t0 + srow) * 1024 + 64 * h + i0 + 4 * scv);
          LAS float* d = Lr + srow * 64 + 8 * scv; *(LAS f32x4*)d = r0; *(LAS f32x4*)(d + 4) = r1;
          d = Lk + srow * 64 + 8 * scv; *(LAS f32x4*)d = k0; *(LAS f32x4*)(d + 4) = k1;
          d = La + srow * 64 + 8 * scv; *(LAS f32x4*)d = (f32x4){bflo(a4.x), bfhi(a4.x), bflo(a4.y), bfhi(a4.y)}; *(LAS f32x4*)(d + 4) = (f32x4){bflo(a4.z), bfhi(a4.z), bflo(a4.w), bfhi(a4.w)};
          d = Lb + srow * 64 + 8 * scv; *(LAS f32x4*)d = (f32x4){bflo(b4.x), bfhi(b4.x), bflo(b4.y), bfhi(b4.y)}; *(LAS f32x4*)(d + 4) = (f32x4){bflo(b4.z), bfhi(b4.z), bflo(b4.w), bfhi(b4.w)};
          d = Lw + srow * 64 + 8 * scv; *(LAS f32x4*)d = (f32x4){__expf(bflo(w4.x)), __expf(bfhi(w4.x)), __expf(bflo(w4.y)), __expf(bfhi(w4.y))}; *(LAS f32x4*)(d + 4) = (f32x4){__expf(bflo(w4.z)), __expf(bfhi(w4.z)), __expf(bflo(w4.w)), __expf(bfhi(w4.w))};
          *(LAS f32x4*)(Lv + srow * 32 + 4 * scv) = vv; }
        __syncthreads();
#pragma unroll 2
        for (int s = 0; s < SC_CH; ++s) {
            const f32x4 a = *(const LAS f32x4*)(La + s * 64 + 4 * jg), b = *(const LAS f32x4*)(Lb + s * 64 + 4 * jg), w = *(const LAS f32x4*)(Lw + s * 64 + 4 * jg);
            const f32x4 k = *(const LAS f32x4*)(Lk + s * 64 + 4 * jg), r = *(const LAS f32x4*)(Lr + s * 64 + 4 * jg); const float vi = Lv[s * 32 + rl];
            const float sa = dpp_add16((st.x * a.x + st.y * a.y) + (st.z * a.z + st.w * a.w));
            st = st * w + (b * sa + k * vi);
            const float y = dpp_add16((st.x * r.x + st.y * r.y) + (st.z * r.z + st.w * r.w));
            if (jg == 0) Y[(size_t)(t0 + s) * 1024 + 64 * h + i0 + rl] = y;
        }
    }
}

__device__ __forceinline__ void p8_rwkv_final(Frame& F) {
    const float* Y = (const float*)(F.ws + WS_YS); const float* SV = (const float*)(F.ws + WS_SV); const float* BSC = (const float*)(F.ws + WS_BSC); const bf16* GR = (const bf16*)(F.ws + WS_GR);
    bf16* mixed = (bf16*)(F.ws + WS_MIXED);
    const int gw = F.bid * NWAVES + F.wave, NGW = F.G * NWAVES, c0 = 16 * F.lane, hd = F.lane >> 2;
    for (int t = gw; t < T; t += NGW) {
        float y[16]; float s = 0.f;
#pragma unroll
        for (int q = 0; q < 4; ++q) { const f32x4 v = *(const GAS f32x4*)(Y + (size_t)t * 1024 + c0 + 4 * q); y[4 * q] = v.x; y[4 * q + 1] = v.y; y[4 * q + 2] = v.z; y[4 * q + 3] = v.w; s += (v.x + v.y) + (v.z + v.w); }
        s += __shfl_xor(s, 1); s += __shfl_xor(s, 2);
        const float mean = s * (1.f / 64.f); float q2 = 0.f;
#pragma unroll
        for (int e = 0; e < 16; ++e) { y[e] -= mean; q2 += y[e] * y[e]; }
        q2 += __shfl_xor(q2, 1); q2 += __shfl_xor(q2, 2);
        const float rstd = 1.f / sqrtf(q2 * (1.f / 64.f) + LNX_EPS);
        const float bs = BSC[(size_t)t * 16 + hd];
        const v4u g0 = *(const GAS v4u*)(GR + (size_t)t * 1024 + c0), g1 = *(const GAS v4u*)(GR + (size_t)t * 1024 + c0 + 8);
        const float gg[16] = {bflo(g0.x), bfhi(g0.x), bflo(g0.y), bfhi(g0.y), bflo(g0.z), bfhi(g0.z), bflo(g0.w), bfhi(g0.w), bflo(g1.x), bfhi(g1.x), bflo(g1.y), bfhi(g1.y), bflo(g1.z), bfhi(g1.z), bflo(g1.w), bfhi(g1.w)};
        float r[16];
#pragma unroll
        for (int q = 0; q < 4; ++q) { const f32x4 v = *(const GAS f32x4*)(SV + (size_t)t * 1024 + c0 + 4 * q); const f32x4 lw = *(const GAS f32x4*)(F.lnx_w + c0 + 4 * q), lb = *(const GAS f32x4*)(F.lnx_b + c0 + 4 * q);
            const float vv[4] = {v.x, v.y, v.z, v.w}, lww[4] = {lw.x, lw.y, lw.z, lw.w}, lbb[4] = {lb.x, lb.y, lb.z, lb.w};
#pragma unroll
            for (int e = 0; e < 4; ++e) { const int i = 4 * q + e; const float o = y[i] * rstd * lww[e] + lbb[e] + bs * vv[e]; r[i] = o * gg[i] * sigmoidf_(gg[i]); } }
        v4u w0, w1; w0.x = pk2(r[0], r[1]); w0.y = pk2(r[2], r[3]); w0.z = pk2(r[4], r[5]); w0.w = pk2(r[6], r[7]); w1.x = pk2(r[8], r[9]); w1.y = pk2(r[10], r[11]); w1.z = pk2(r[12], r[13]); w1.w = pk2(r[14], r[15]);
        *(GAS v4u*)(mixed + (size_t)t * 2048 + c0) = w0; *(GAS v4u*)(mixed + (size_t)t * 2048 + c0 + 8) = w1;
    }
}

constexpr size_t WS_WDT = 1 * MiB + 512 * 1024;
constexpr size_t WS_WIT = 1 * MiB + 640 * 1024;
constexpr size_t WS_PB = 16 * MiB;
constexpr size_t WS_QC = 52 * MiB;
constexpr size_t WS_HT = 84 * MiB;
constexpr size_t WS_GT = 376 * MiB;
constexpr size_t WS_Y0T = 440 * MiB;
constexpr int IMS = 144;
constexpr int L_AT = 0, L_RT = 9216, L_BT = 18432, L_KT = 27648, L_BHT = 36864, L_KHT = 46080, L_VT = 55296, L_XT = 64512;
constexpr int L_RA = 82944;
constexpr int L_TW = L_RA, L_AD = L_RA + 9216, L_WP = L_RA + 18432, L_AP = L_WP + 16640;
constexpr int L_LAB = L_RA, L_LAK = L_RA + 17408, L_MRB = L_LAK + 9216, L_MRK = L_MRB + 9216, L_TII = L_MRK + 9216;
constexpr int L_CUMP = 134656, L_GC = L_CUMP + 2048;

__device__ __forceinline__ f32x4 mfma4f(float a, float b, f32x4 c) { return __builtin_amdgcn_mfma_f32_16x16x4f32(a, b, c, 0, 0, 0); }
__device__ __forceinline__ bf16x8 lds_frag(LAS unsigned char* img, int row, int ks, int g) { return *(const LAS bf16x8*)(img + row * IMS + 64 * ks + 16 * g); }

__device__ __forceinline__ float wave_sum_dpp(float x) {
    x = dpp_add16(x);
    x += __builtin_bit_cast(float, __builtin_amdgcn_update_dpp(0, __builtin_bit_cast(int, x), 0x142, 0xa, 0xf, false));
    x += __builtin_bit_cast(float, __builtin_amdgcn_update_dpp(0, __builtin_bit_cast(int, x), 0x143, 0xc, 0xf, false));
    return __builtin_bit_cast(float, __builtin_amdgcn_readlane(__builtin_bit_cast(int, x), 63));
}
struct R1In { v4u wd0, wd1, wp0, wp1, rc, rp, kc, kp, vc, vp; };
__device__ __forceinline__ void r1_load(Frame& F, int h, int chunk, R1In& in) {
    const bf16* R = (const bf16*)(F.ws + WS_R); const bf16* K = (const bf16*)(F.ws + WS_K); const bf16* V = (const bf16*)(F.ws + WS_V); const bf16* WDAD = (const bf16*)(F.ws + WS_WDAD);
    const int row = F.tid >> 3, cv = F.tid & 7, t = chunk * 64 + row; const size_t o = (size_t)t * 1024 + 64 * h + 8 * cv; const v4u z4 = (v4u){0u, 0u, 0u, 0u};
    in.wd0 = *(const GAS v4u*)(WDAD + (size_t)t * 128 + 8 * cv); in.wd1 = *(const GAS v4u*)(WDAD + (size_t)t * 128 + 64 + 8 * cv);
    in.rc = *(const GAS v4u*)(R + o); in.kc = *(const GAS v4u*)(K + o); in.vc = *(const GAS v4u*)(V + o);
    if (t > 0) { in.wp0 = *(const GAS v4u*)(WDAD + (size_t)(t - 1) * 128 + 8 * cv); in.wp1 = *(const GAS v4u*)(WDAD + (size_t)(t - 1) * 128 + 64 + 8 * cv);
        in.rp = *(const GAS v4u*)(R + o - 1024); in.kp = *(const GAS v4u*)(K + o - 1024); in.vp = *(const GAS v4u*)(V + o - 1024); }
    else { in.wp0 = z4; in.wp1 = z4; in.rp = z4; in.kp = z4; in.vp = z4; }
}
constexpr int L_RS = L_AT, L_KS = L_BT, L_VS = L_BHT;

__device__ __forceinline__ void r1_unit(Frame& F, int h, int chunk, R1In& in, const bf16x8 (&wfr)[2][2][2], int un) {
    float* BSC = (float*)(F.ws + WS_BSC);
    LAS unsigned char* L = F.lds;
    int tid = F.tid; asm volatile("" : "+v"(tid));
    const int t0 = chunk * 64, u = h * 256 + chunk, lane = tid & 63, wv = __builtin_amdgcn_readfirstlane(tid >> 6), fr = lane & 15, g = lane >> 4;
    __syncthreads();
    { const int row = tid >> 3, cv = tid & 7;
#pragma unroll
      for (int part = 0; part < 2; ++part) { const v4u wc4 = part ? in.wd1 : in.wd0, wp4 = part ? in.wp1 : in.wp0;
          const unsigned cw[4] = {wc4.x, wc4.y, wc4.z, wc4.w}, pw[4] = {wp4.x, wp4.y, wp4.z, wp4.w}; unsigned ow[4];
#pragma unroll
          for (int q = 0; q < 4; ++q) { float xs[2];
#pragma unroll
              for (int hl = 0; hl < 2; ++hl) { const int l = 8 * cv + 2 * q + hl; const float x0 = hl ? bfhi(cw[q]) : bflo(cw[q]), x1 = hl ? bfhi(pw[q]) : bflo(pw[q]);
                  xs[hl] = x0 + F.mu_lora[64 * part + l] * (x1 - x0); if (part == 0) { const float e2 = __expf(2.f * xs[hl]); xs[hl] = 1.f - 2.f / (e2 + 1.f); } }
              ow[q] = pk2(xs[0], xs[1]); }
          *(LAS v4u*)(L + (part == 0 ? L_TW : L_AD) + row * IMS + 16 * cv) = (v4u){ow[0], ow[1], ow[2], ow[3]}; }
      const unsigned rcw[4] = {in.rc.x, in.rc.y, in.rc.z, in.rc.w}, rpw[4] = {in.rp.x, in.rp.y, in.rp.z, in.rp.w}, kcw[4] = {in.kc.x, in.kc.y, in.kc.z, in.kc.w}, kpw[4] = {in.kp.x, in.kp.y, in.kp.z, in.kp.w},
                     vcw[4] = {in.vc.x, in.vc.y, in.vc.z, in.vc.w}, vpw[4] = {in.vp.x, in.vp.y, in.vp.z, in.vp.w};
#pragma unroll
      for (int q = 0; q < 4; ++q)
#pragma unroll
          for (int hl = 0; hl < 2; ++hl) { const int cc = 8 * cv + 2 * q + hl, chn = 64 * h + cc;
              const float r0 = hl ? bfhi(rcw[q]) : bflo(rcw[q]), r1 = hl ? bfhi(rpw[q]) : bflo(rpw[q]), k0 = hl ? bfhi(kcw[q]) : bflo(kcw[q]), k1 = hl ? bfhi(kpw[q]) : bflo(kpw[q]);
              const float v0 = hl ? bfhi(vcw[q]) : bflo(vcw[q]), v1 = hl ? bfhi(vpw[q]) : bflo(vpw[q]);
              ((LAS float*)(L + L_RS))[row * 65 + cc] = r0 + F.mu_rkv[chn] * (r1 - r0); ((LAS float*)(L + L_KS))[row * 65 + cc] = k0 + F.mu_rkv[1024 + chn] * (k1 - k0);
              ((LAS float*)(L + L_VS))[row * 65 + cc] = v0 + F.mu_rkv[2048 + chn] * (v1 - v0); } }
    if (un >= 0) r1_load(F, un >> 8, un & 255, in);
    __syncthreads();
    { const int tr = wv >> 1;
#pragma unroll
      for (int prod = 0; prod < 2; ++prod) { LAS unsigned char* aimg = L + (prod == 0 ? L_TW : L_AD); LAS float* o = (LAS float*)(L + (prod == 0 ? L_WP : L_AP));
#pragma unroll
          for (int cc = 0; cc < 2; ++cc) { const int ct = (wv & 1) * 2 + cc; f32x4 acc = (f32x4){0.f, 0.f, 0.f, 0.f};
#pragma unroll
              for (int ks = 0; ks < 2; ++ks) acc = mfma16(lds_frag(aimg, 16 * tr + fr, ks, g), wfr[prod][cc][ks], acc);
#pragma unroll
              for (int r = 0; r < 4; ++r) o[(16 * tr + 4 * g + r) * 65 + 16 * ct + fr] = acc[r]; } } }
    __syncthreads();
    { const int c = tid & 63, tg = tid >> 6, ch = 64 * h + c;
      const float kkc = F.k_k[ch], kac = F.k_a[ch], rkc = F.r_k[ch], wb = F.w_decay_bias[ch], ib = F.w_iclr_bias[ch];
      const LAS float* WP = (const LAS float*)(L + L_WP); const LAS float* AP = (const LAS float*)(L + L_AP); LAS float* CUMP = (LAS float*)(L + L_CUMP);
      float rr[8], kr[8], vv[8], lw[8], ic[8];
      float ps = 0.f;
#pragma unroll
      for (int r = 0; r < 8; ++r) { const int row = 8 * tg + r; rr[r] = ((const LAS float*)(L + L_RS))[row * 65 + c]; kr[r] = ((const LAS float*)(L + L_KS))[row * 65 + c]; vv[r] = ((const LAS float*)(L + L_VS))[row * 65 + c];
          lw[r] = -0.6065306597126334f * sigmoidf_(wb + WP[row * 65 + c]); ic[r] = sigmoidf_(ib + AP[row * 65 + c]); ps += lw[r]; }
      CUMP[tg * 64 + c] = ps;
      __syncthreads();
      float off = 0.f, tot = 0.f;
#pragma unroll
      for (int q = 0; q < 8; ++q) { const float p = CUMP[q * 64 + c]; tot += p; if (q < tg) off += p; }
      if (tg == 0) ((LAS float*)(L + L_GC))[c] = __expf(tot);
      float av[8], rv[8], bv[8], kv[8], bhv[8], khv[8]; float cum = off;
#pragma unroll
      for (int r = 0; r < 8; ++r) { const int t = t0 + 8 * tg + r;
          const float gprev = __expf(cum); cum += lw[r]; const float gam = __expf(cum), ig = __expf(-cum), gh = __expf(tot - cum);
          const float kk = kr[r] * kkc; const float kkn = kk * __builtin_amdgcn_rsqf(fmaxf(wave_sum_dpp(kk * kk), 1e-24f));
          const float kpm = kr[r] * (1.f + (ic[r] - 1.f) * kac); const float bs = wave_sum_dpp(rr[r] * kpm * rkc);
          if (c == 0) BSC[(size_t)t * 16 + h] = bs;
          const float bq = kkn * ic[r];
          av[r] = -kkn * gprev; rv[r] = rr[r] * gam; bv[r] = bq * ig; kv[r] = kpm * ig; bhv[r] = bq * gh; khv[r] = kpm * gh; }
#define R1_PUT(OFF, A) *(LAS v4u*)(L + (OFF) + c * IMS + 16 * tg) = (v4u){pk2(A[0], A[1]), pk2(A[2], A[3]), pk2(A[4], A[5]), pk2(A[6], A[7])}
      R1_PUT(L_AT, av); R1_PUT(L_RT, rv); R1_PUT(L_BT, bv); R1_PUT(L_KT, kv); R1_PUT(L_BHT, bhv); R1_PUT(L_KHT, khv); R1_PUT(L_VT, vv);
#undef R1_PUT
    }
    __syncthreads();
    { const int prod = wv >> 1; const unsigned ximg = (unsigned)((prod < 2) ? L_AT : L_RT), yimg = (unsigned)((prod & 1) ? L_KT : L_BT);
      const unsigned trb = (unsigned)((8 * g + (fr >> 2)) * IMS + 8 * (fr & 3));
#pragma unroll
      for (int q = 0; q < 8; ++q) { const int tl = 8 * (wv & 1) + q, ti = tl >> 2, si = tl & 3; f32x4 acc = (f32x4){0.f, 0.f, 0.f, 0.f};
          if (si <= ti) {
#pragma unroll
              for (int ks = 0; ks < 2; ++ks) { s16x4 y0, y1, x0, x1;
                  tr_read2(y0, y1, yimg + trb + (unsigned)(32 * ks * IMS + 32 * si), yimg + trb + (unsigned)((32 * ks + 4) * IMS + 32 * si));
                  tr_read2(x0, x1, ximg + trb + (unsigned)(32 * ks * IMS + 32 * ti), ximg + trb + (unsigned)((32 * ks + 4) * IMS + 32 * ti));
                  acc = mfma16((bf16x8){y0[0], y0[1], y0[2], y0[3], y1[0], y1[1], y1[2], y1[3]}, (bf16x8){x0[0], x0[1], x0[2], x0[3], x1[0], x1[1], x1[2], x1[3]}, acc); } }
          const int t = 16 * ti + fr, s0 = 16 * si + 4 * g;
#pragma unroll
          for (int r = 0; r < 4; ++r) { const bool keep = (prod < 2) ? (s0 + r < t) : (s0 + r <= t); acc[r] = keep ? acc[r] : 0.f; }
          if (prod == 0) *(LAS f32x4*)(L + L_LAB + (t * 68 + s0) * 4) = acc;
          else *(LAS v2u*)(L + (prod == 1 ? L_LAK : prod == 2 ? L_MRB : L_MRK) + t * IMS + 2 * s0) = (v2u){pk2(acc[0], acc[1]), pk2(acc[2], acc[3])}; } }
    __syncthreads();
    f32x4 x[4];
    if (wv < 4) {
#pragma unroll
        for (int bi = 0; bi < 4; ++bi) { const v2u w = *(const LAS v2u*)(L + L_AT + (16 * wv + fr) * IMS + 2 * (16 * bi + 4 * g)); x[bi] = (f32x4){bflo(w.x), bfhi(w.x), bflo(w.y), bfhi(w.y)}; }
    } else {
#pragma unroll
        for (int bi = 0; bi < 4; ++bi) { x[bi] = (f32x4){0.f, 0.f, 0.f, 0.f};
#pragma unroll
            for (int ks = 0; ks < 2; ++ks) x[bi] = mfma16(lds_frag(L + L_LAK, 16 * bi + fr, ks, g), lds_frag(L + L_VT, 16 * (wv - 4) + fr, ks, g), x[bi]); }
    }
    if (wv == 0) { const int bi = g, c = fr; const LAS float* Lb = (const LAS float*)(L + L_LAB) + (16 * bi) * 68 + 16 * bi; LAS float* Tb = (LAS float*)(L + L_TII) + bi * 320;
        float xc[16];
#pragma unroll
        for (int r = 0; r < 16; ++r) { float s0 = (r == c) ? 1.f : 0.f, s1 = 0.f, s2 = 0.f, s3 = 0.f;
#pragma unroll
            for (int q = 0; q < r; ++q) { const float p = Lb[r * 68 + q] * xc[q]; if ((q & 3) == 0) s0 += p; else if ((q & 3) == 1) s1 += p; else if ((q & 3) == 2) s2 += p; else s3 += p; }
            const float s = (s0 + s1) + (s2 + s3); xc[r] = s; Tb[r * 20 + c] = s; } }
    __syncthreads();
    { const LAS float* Lab = (const LAS float*)(L + L_LAB); const LAS float* Tii = (const LAS float*)(L + L_TII);
#pragma unroll
      for (int bi = 0; bi < 4; ++bi) { f32x4 acc = x[bi];
#pragma unroll
          for (int bj = 0; bj < 4; ++bj) { if (bj < bi) { const f32x4 a = *(const LAS f32x4*)(Lab + (16 * bi + fr) * 68 + 16 * bj + 4 * g);
#pragma unroll
              for (int kk = 0; kk < 4; ++kk) acc = mfma4f(a[kk], x[bj][kk], acc); } }
          const f32x4 tq = *(const LAS f32x4*)(Tii + bi * 320 + fr * 20 + 4 * g); f32x4 xo = (f32x4){0.f, 0.f, 0.f, 0.f};
#pragma unroll
          for (int kk = 0; kk < 4; ++kk) xo = mfma4f(tq[kk], acc[kk], xo);
          x[bi] = xo;
          *(LAS v2u*)(L + L_XT + (16 * wv + fr) * IMS + 2 * (16 * bi + 4 * g)) = (v2u){pk2(xo[0], xo[1]), pk2(xo[2], xo[3])}; } }
    __syncthreads();
    { bf16* PB = (bf16*)(F.ws + WS_PB) + (size_t)u * 4096; bf16* QC = (bf16*)(F.ws + WS_QC) + (size_t)u * 4096; float* GT = (float*)(F.ws + WS_GT) + (size_t)u * 4096; bf16* Y0 = (bf16*)(F.ws + WS_Y0T) + (size_t)u * 4096;
      const LAS float* GC = (const LAS float*)(L + L_GC);
#pragma unroll
      for (int q = 0; q < 2; ++q) { const int tl = 2 * wv + q, ra = tl >> 2, cb = tl & 3;
          { f32x4 acc = (f32x4){0.f, 0.f, 0.f, 0.f};
#pragma unroll
            for (int ks = 0; ks < 2; ++ks) acc = mfma16(lds_frag(L + L_XT, 16 * ra + fr, ks, g), lds_frag(L + L_MRB, 16 * cb + fr, ks, g), acc);
            const int t = 16 * cb + fr, j0 = 16 * ra + 4 * g;
#pragma unroll
            for (int r = 0; r < 4; ++r) acc[r] += bf2f(*(const LAS bf16*)(L + L_RT + (j0 + r) * IMS + 2 * t));
            *(GAS v2u*)(QC + (size_t)t * 64 + j0) = (v2u){pk2(acc[0], acc[1]), pk2(acc[2], acc[3])}; }
          { f32x4 acc = (f32x4){0.f, 0.f, 0.f, 0.f};
#pragma unroll
            for (int ks = 0; ks < 2; ++ks) { acc = mfma16(lds_frag(L + L_XT, 64 + 16 * ra + fr, ks, g), lds_frag(L + L_MRB, 16 * cb + fr, ks, g), acc); acc = mfma16(lds_frag(L + L_VT, 16 * ra + fr, ks, g), lds_frag(L + L_MRK, 16 * cb + fr, ks, g), acc); }
            *(GAS v2u*)(Y0 + (size_t)(16 * cb + fr) * 64 + 16 * ra + 4 * g) = (v2u){pk2(acc[0], acc[1]), pk2(acc[2], acc[3])}; }
          { f32x4 acc = (f32x4){0.f, 0.f, 0.f, 0.f};
#pragma unroll
            for (int ks = 0; ks < 2; ++ks) acc = mfma16(lds_frag(L + L_XT, 16 * ra + fr, ks, g), lds_frag(L + L_BHT, 16 * cb + fr, ks, g), acc);
            const int jp = 16 * cb + fr;
#pragma unroll
            for (int r = 0; r < 4; ++r) if (16 * ra + 4 * g + r == jp) acc[r] += GC[jp];
            *(GAS v2u*)(PB + (size_t)jp * 64 + 32 * (ra >> 1) + 8 * g + 4 * (ra & 1)) = (v2u){pk2(acc[0], acc[1]), pk2(acc[2], acc[3])}; }
          { f32x4 acc = (f32x4){0.f, 0.f, 0.f, 0.f};
#pragma unroll
            for (int ks = 0; ks < 2; ++ks) { acc = mfma16(lds_frag(L + L_BHT, 16 * ra + fr, ks, g), lds_frag(L + L_XT, 64 + 16 * cb + fr, ks, g), acc); acc = mfma16(lds_frag(L + L_KHT, 16 * ra + fr, ks, g), lds_frag(L + L_VT, 16 * cb + fr, ks, g), acc); }
            *(GAS f32x4*)(GT + (size_t)(16 * cb + fr) * 64 + 16 * ra + 4 * g) = acc; } } }
}

__device__ __forceinline__ void r1_chunk_local(Frame& F) {
    constexpr int NU = RW_H * (T / 64);
    const int upw = (NU + F.G - 1) / F.G;
    const int u0 = F.bid * upw; if (u0 >= NU) return;
    const bf16* WDT = (const bf16*)(F.ws + WS_WDT); const bf16* WIT = (const bf16*)(F.ws + WS_WIT);
    const int fr = F.lane & 15, g = F.lane >> 4;
    R1In in; r1_load(F, u0 >> 8, u0 & 255, in);
    bf16x8 wfr[2][2][2]; int hw = -1;
    for (int ui = 0; ui < upw; ++ui) { const int u = u0 + ui; if (u >= NU) break; const int h = u >> 8;
        if (h != hw) { hw = h;
#pragma unroll
            for (int prod = 0; prod < 2; ++prod)
#pragma unroll
                for (int cc = 0; cc < 2; ++cc)
#pragma unroll
                    for (int ks = 0; ks < 2; ++ks) wfr[prod][cc][ks] = *(const bf16x8*)((prod ? WIT : WDT) + (size_t)(64 * h + 16 * ((F.wave & 1) * 2 + cc) + fr) * 64 + 32 * ks + 8 * g); }
        r1_unit(F, h, u & 255, in, wfr, (ui + 1 < upw && u + 1 < NU) ? u + 1 : -1); }
}

constexpr int R2_SLOT = 12288, R2_D = 8, R2_NS = 10;
__device__ __forceinline__ void r2_recurrence(Frame& F) {
    if (F.bid >= 64) return;
    const int h = 2 * (F.bid & 7) + (F.bid >> 5), cg = (F.bid >> 3) & 3, lane = F.lane, fr = lane & 15, g = lane >> 4, wv = F.wave;
    const bf16* PB = (const bf16*)(F.ws + WS_PB) + (size_t)h * 256 * 4096; const float* GT = (const float*)(F.ws + WS_GT) + (size_t)h * 256 * 4096 + (size_t)(16 * cg) * 64;
    bf16* HT = (bf16*)(F.ws + WS_HT) + (size_t)h * 256 * 4096 + (size_t)(16 * cg) * 64;
    LAS unsigned char* L = F.lds;
#define R2_BAR() do { asm volatile("" ::: "memory"); __builtin_amdgcn_s_barrier(); asm volatile("" ::: "memory"); } while (0)
    __syncthreads();
    if (wv == 0) {
#define R2_FRAGS(step, PF, GF) do { const LAS unsigned char* sl_ = L + ((step) % R2_NS) * R2_SLOT; _Pragma("unroll") for (int rt = 0; rt < 4; ++rt) { GF[rt] = *(const LAS f32x4*)(sl_ + 8192 + (fr * 64 + 16 * rt + 4 * g) * 4); \
        _Pragma("unroll") for (int ks = 0; ks < 2; ++ks) PF[rt][ks] = *(const LAS bf16x8*)(sl_ + ((16 * rt + fr) * 64 + 32 * ks + 8 * g) * 2); } } while (0)
#define R2_STEP(PF, GF) do { \
        _Pragma("unroll") for (int rt = 0; rt < 4; ++rt) *(GAS v2u*)(HT + (size_t)c * 4096 + (size_t)fr * 64 + 16 * rt + 4 * g) = (v2u){pk2(hs[rt][0], hs[rt][1]), pk2(hs[rt][2], hs[rt][3])}; \
        bf16x8 bfr[2]; \
        _Pragma("unroll") for (int ks = 0; ks < 2; ++ks) { const v4u w = (v4u){pk2(hs[2 * ks][0], hs[2 * ks][1]), pk2(hs[2 * ks][2], hs[2 * ks][3]), pk2(hs[2 * ks + 1][0], hs[2 * ks + 1][1]), pk2(hs[2 * ks + 1][2], hs[2 * ks + 1][3])}; bfr[ks] = __builtin_bit_cast(bf16x8, w); } \
        _Pragma("unroll") for (int rt = 0; rt < 4; ++rt) { f32x4 acc = GF[rt]; _Pragma("unroll") for (int ks = 0; ks < 2; ++ks) acc = mfma16(PF[rt][ks], bfr[ks], acc); hs[rt] = acc; } } while (0)
        f32x4 hs[4], gfa[4], gfb[4]; bf16x8 pfa[4][2], pfb[4][2];
#pragma unroll
        for (int rt = 0; rt < 4; ++rt) hs[rt] = (f32x4){0.f, 0.f, 0.f, 0.f};
        R2_BAR();
        R2_FRAGS(0, pfa, gfa);
        for (int c = 0; c < 256; c += 2) {
            { R2_FRAGS(c + 1, pfb, gfb); R2_STEP(pfa, gfa); asm volatile("s_waitcnt lgkmcnt(0)" ::: "memory"); R2_BAR(); }
            { const int c1 = c + 1; const int cn = (c1 + 1 < 256) ? c1 + 1 : 255; R2_FRAGS(cn, pfa, gfa); { const int c = c1; R2_STEP(pfb, gfb); } asm volatile("s_waitcnt lgkmcnt(0)" ::: "memory"); R2_BAR(); }
        }
#undef R2_FRAGS
#undef R2_STEP
    } else if (wv <= 6) {
        const int p0 = 2 * (wv - 1);
#define R2_DMA(step) do { const int st_ = (step) < 256 ? (step) : 255; LAS unsigned char* sl_ = L + ((step) % R2_NS) * R2_SLOT; \
        _Pragma("unroll") for (int q_ = 0; q_ < 2; ++q_) { const int pc_ = p0 + q_; const char* src_ = (pc_ < 8) ? ((const char*)(PB + (size_t)st_ * 4096) + pc_ * 1024) : ((const char*)(GT + (size_t)st_ * 4096) + (pc_ - 8) * 1024); \
            __builtin_amdgcn_global_load_lds((const unsigned*)(src_ + lane * 16), (LAS unsigned*)(sl_ + pc_ * 1024), 16, 0, 0); } } while (0)
#pragma unroll
        for (int s0 = 0; s0 < R2_D; ++s0) R2_DMA(s0);
        asm volatile("s_waitcnt vmcnt(12)" ::: "memory");
        R2_BAR();
        for (int c = 0; c < 256; ++c) {
            R2_DMA(c + R2_D);
            asm volatile("s_waitcnt vmcnt(12)" ::: "memory");
            R2_BAR();
        }
        asm volatile("s_waitcnt vmcnt(0)" ::: "memory");
#undef R2_DMA
    } else {
        R2_BAR();
        for (int c = 0; c < 256; ++c) R2_BAR();
    }
    __syncthreads();
#undef R2_BAR
}

__device__ __forceinline__ void r3_output(Frame& F) {
    const bf16* QC = (const bf16*)(F.ws + WS_QC); const bf16* HT = (const bf16*)(F.ws + WS_HT); const bf16* Y0 = (const bf16*)(F.ws + WS_Y0T); const float* BSC = (const float*)(F.ws + WS_BSC);
    const bf16* V = (const bf16*)(F.ws + WS_V); const bf16* GR = (const bf16*)(F.ws + WS_GR); bf16* mixed = (bf16*)(F.ws + WS_MIXED);
    const int gw = F.bid * NWAVES + F.wave, NGW = F.G * NWAVES, lane = F.lane, fr = lane & 15, g = lane >> 4;
    for (int w = gw; w < 4096 * 4; w += NGW) { const int u = w >> 2, tt = w & 3, h = u >> 8, chunk = u & 255, t = chunk * 64 + 16 * tt + fr;
        bf16x8 qb[2];
#pragma unroll
        for (int ks = 0; ks < 2; ++ks) qb[ks] = *(const bf16x8*)(QC + (size_t)u * 4096 + (size_t)(16 * tt + fr) * 64 + 32 * ks + 8 * g);
        f32x4 y[4]; float s = 0.f;
#pragma unroll
        for (int it = 0; it < 4; ++it) { const v2u y0 = *(const GAS v2u*)(Y0 + (size_t)u * 4096 + (size_t)(16 * tt + fr) * 64 + 16 * it + 4 * g); y[it] = (f32x4){bflo(y0.x), bfhi(y0.x), bflo(y0.y), bfhi(y0.y)};
#pragma unroll
            for (int ks = 0; ks < 2; ++ks) y[it] = mfma16(*(const bf16x8*)(HT + (size_t)u * 4096 + (size_t)(16 * it + fr) * 64 + 32 * ks + 8 * g), qb[ks], y[it]);
            s += (y[it][0] + y[it][1]) + (y[it][2] + y[it][3]); }
        s += __shfl_xor(s, 16); s += __shfl_xor(s, 32);
        const float mean = s * (1.f / 64.f); float q2 = 0.f;
#pragma unroll
        for (int it = 0; it < 4; ++it)
#pragma unroll
            for (int r = 0; r < 4; ++r) { y[it][r] -= mean; q2 += y[it][r] * y[it][r]; }
        q2 += __shfl_xor(q2, 16); q2 += __shfl_xor(q2, 32);
        const float rstd = __builtin_amdgcn_rsqf(q2 * (1.f / 64.f) + LNX_EPS), bs = BSC[(size_t)t * 16 + h];
#pragma unroll
        for (int it = 0; it < 4; ++it) { const int ch = 64 * h + 16 * it + 4 * g; const size_t o = (size_t)t * 1024 + ch;
            const v2u vc = *(const GAS v2u*)(V + o), vp = t > 0 ? *(const GAS v2u*)(V + o - 1024) : (v2u){0u, 0u}, gg = *(const GAS v2u*)(GR + o);
            const f32x4 mu = *(const GAS f32x4*)(F.mu_rkv + 2048 + ch), lw = *(const GAS f32x4*)(F.lnx_w + ch), lb = *(const GAS f32x4*)(F.lnx_b + ch);
            const f32x4 vcf = (f32x4){bflo(vc.x), bfhi(vc.x), bflo(vc.y), bfhi(vc.y)}, vpf = (f32x4){bflo(vp.x), bfhi(vp.x), bflo(vp.y), bfhi(vp.y)}, gf = (f32x4){bflo(gg.x), bfhi(gg.x), bflo(gg.y), bfhi(gg.y)};
            const f32x4 vs = vcf + mu * (vpf - vcf); f32x4 o4 = y[it] * rstd * lw + lb + vs * bs;
#pragma unroll
            for (int r = 0; r < 4; ++r) o4[r] = o4[r] * gf[r] * sigmoidf_(gf[r]);
            *(GAS v2u*)(mixed + (size_t)t * 2048 + ch) = (v2u){pk2(o4[0], o4[1]), pk2(o4[2], o4[3])}; }
    }
}
#define PHASES_MID \
    p2_kmean(F); GRID_BAR(); \
    p3_gate(F); GRID_BAR(); \
    p4_attn_items(F); GRID_BAR(); \
    p5_combine(F); GRID_BAR(); \
    r1_chunk_local(F); GRID_BAR(); \
    r2_recurrence(F); GRID_BAR(); \
    r3_output(F); GRID_BAR();
#define HOST_EXTRA

__device__ __forceinline__ void p7_final_norm(Frame& F) {
    const int gw = F.bid * NWAVES + F.wave, NGW = F.G * NWAVES;
    const float* rowss = (const float*)(F.ws + WS_ROWSS);
    for (int m = gw; m < T; m += NGW) {
        const float p = (F.lane < 32) ? rowss[(size_t)m * 32 + F.lane] : 0.f;
        const float rs = 1.f / sqrtf(wave_sum(p) * (1.f / D) + RMS_EPS);
        GAS f32x4* o = (GAS f32x4*)(F.out + (size_t)m * D) + F.lane; const GAS f32x4* w = (const GAS f32x4*)F.final_norm_w + F.lane;
#pragma unroll
        for (int j = 0; j < 8; ++j) { const f32x4 h = o[64 * j]; o[64 * j] = h * rs * w[64 * j]; }
    }
}

struct Args { const float* in[16]; float* out; unsigned char* ws; };
__global__ void __launch_bounds__(NWAVES * 64, 2) hymba_fwd(Args args) {
    extern __shared__ __attribute__((aligned(16))) unsigned char lds[];
    Frame F;
    F.lds = (LAS unsigned char*)lds;
    F.MISC = (volatile LAS unsigned*)(F.lds + MISC_OFF);
    F.tid = threadIdx.x; F.lane = F.tid & 63; F.wave = __builtin_amdgcn_readfirstlane(F.tid >> 6);
    F.G = gridDim.x; F.bid = blockIdx.x;
    F.ws = args.ws; F.ctl = (gu32*)(args.ws + WS_CTL);
    F.x = args.in[0]; F.norm_w = args.in[1]; F.w_in = args.in[2]; F.mu_rkv = args.in[3]; F.mu_lora = args.in[4]; F.w_decay_up = args.in[5]; F.w_decay_bias = args.in[6];
    F.w_iclr_up = args.in[7]; F.w_iclr_bias = args.in[8]; F.k_k = args.in[9]; F.k_a = args.in[10]; F.r_k = args.in[11]; F.lnx_w = args.in[12]; F.lnx_b = args.in[13];
    F.w_out = args.in[14]; F.final_norm_w = args.in[15]; F.out = args.out;
    for (int u = F.tid; u < (LDS_BYTES - MISC_OFF) / 4; u += NWAVES * 64) ((LAS unsigned*)(F.lds + MISC_OFF))[u] = 0u;
    __syncthreads();
    XcdBarrier bar = xcd_barrier_post((unsigned*)(F.ctl + CW_BAR), F.MISC + 8);
#define GRID_BAR() do { xcd_barrier(bar); int t_ = threadIdx.x; asm volatile("" : "+v"(t_)); F.tid = t_; F.lane = t_ & 63; F.wave = __builtin_amdgcn_readfirstlane(t_ >> 6); } while (0)

    p0_prologue(F);
    GRID_BAR();
    {
        pg8::Gemm g{(const pg8::bf16_t*)(F.ws + WS_XN), (const pg8::bf16_t*)(F.ws + WS_W1T), T, NPROJ, D}; pg8::StaticOrder S; S.init(T, NPROJ, F.G, F.bid);
        pg8::EpiProj E{(pg8::bf16_t*)(F.ws + WS_PROJ), (pg8::bf16_t*)(F.ws + WS_WDAD), (const float*)(F.ws + WS_ROPE), (const float*)(F.ws + WS_ROPE) + (size_t)T * 16, (size_t)T * 1024};
        pg8::gemm_phase<pg8::EpiProj, pg8::StaticOrder, true, true>(F.lds, g, S, E);
    }
    GRID_BAR();
    PHASES_MID
    {
        pg8::Gemm g{(const pg8::bf16_t*)(F.ws + WS_MIXED), (const pg8::bf16_t*)(F.ws + WS_W2T), T, D, D}; pg8::StaticOrder S; S.init(T, D, F.G, F.bid);
        pg8::EpiOut E{F.x, F.out, (float*)(F.ws + WS_ROWSS), D};
        pg8::gemm_phase<pg8::EpiOut, pg8::StaticOrder, true, true>(F.lds, g, S, E);
    }
    GRID_BAR();
    p7_final_norm(F);
}

extern "C" void kernel_launch(void* const* d_in, const int* in_sizes, int n_in, void* d_out, int out_size, void* d_ws, size_t ws_size, hipStream_t stream) {
    static int grid = 0;
    if (grid == 0) {
        if (n_in != 16 || in_sizes[0] != T * D || out_size != T * D || ws_size < WS_END) { fprintf(stderr, "kernel_launch: unexpected shapes / workspace (n_in %d, in0 %d, out %d, ws %zu < %zu); nothing launched\n", n_in, n_in > 0 ? in_sizes[0] : -1, out_size, ws_size, (size_t)WS_END); grid = -1; return; }
        int dev = 0, cus = 0, per_cu = 0;
        if (hipGetDevice(&dev) != hipSuccess || hipDeviceGetAttribute(&cus, hipDeviceAttributeMultiprocessorCount, dev) != hipSuccess) { grid = -1; return; }
        if (hipFuncSetAttribute((const void*)hymba_fwd, hipFuncAttributeMaxDynamicSharedMemorySize, LDS_BYTES) != hipSuccess) { fprintf(stderr, "kernel_launch: hipFuncSetAttribute failed\n"); grid = -1; return; }
        if (hipOccupancyMaxActiveBlocksPerMultiprocessor(&per_cu, (const void*)hymba_fwd, NWAVES * 64, LDS_BYTES) != hipSuccess || per_cu < 1) { fprintf(stderr, "kernel_launch: occupancy query reports %d workgroups per CU\n", per_cu); per_cu = 1; }
        (void)hipGetLastError();
        grid = cus;
    }
    if (grid < 0) return;
    (void)hipMemsetAsync((char*)d_ws + WS_CTL, 0, CTL_ZERO_BYTES, stream);
    HOST_EXTRA
    Args a{};
    for (int i = 0; i < 16; ++i) a.in[i] = (const float*)d_in[i];
    a.out = (float*)d_out; a.ws = (unsigned char*)d_ws;
    hipLaunchKernelGGL(hymba_fwd, dim3(grid), dim3(NWAVES * 64), LDS_BYTES, stream, a);
}
```

```cpp
#include <hip/hip_runtime.h>
#include <cstdio>
#include <cstdint>
namespace pg8 {
#define PG8_LAS __attribute__((address_space(3)))
typedef unsigned short bf16_t;
typedef short bf16x8 __attribute__((ext_vector_type(8)));
typedef float f32x4 __attribute__((ext_vector_type(4)));
typedef unsigned u32x4 __attribute__((ext_vector_type(4)));
constexpr int BM = 256, BK = 64, HALF = 128, HTB = HALF * BK * 2  , STAGE_BYTES = 8 * HTB, NXCD = 8, WGM = 8;

__host__ __device__ __forceinline__ int lds_byte(int r, int c) { const int st = (r >> 4) * 2 + (c >> 5), rr = r & 15, cc = c & 31, ob = rr * 64 + cc * 2; return st * 1024 + (ob ^ (((ob >> 9) & 1) << 5)); }
__host__ __device__ __forceinline__ void stage_rc(int b, int& R, int& C) { const int st = b / 1024, sb = b % 1024, swz = sb ^ (((sb >> 9) & 1) << 5); R = (st >> 1) * 16 + swz / 64; C = (st & 1) * 32 + (swz % 64) / 2; }
__host__ __device__ __forceinline__ int perm32(int rho) { const int n = rho >> 4, i = rho & 15; return 8 * (i >> 2) + 4 * n + (i & 3); }

struct Unit { int pm, pn; };
struct Gemm { const bf16_t* A; const bf16_t* Bt; int M, N, K; };

struct StaticOrder {
    int nM, nN, nwg, G, c;
    __host__ __device__ void init(int M, int N, int G_, int c_) { nM = M / BM; nN = N / BM; nwg = nM * nN; G = G_; c = c_; }
    __host__ __device__ bool next(int i, Unit& u) const {
        const long L = (long)i * G + c; if (L >= nwg) return false;
        int wgid = (int)L; { const int q = nwg / NXCD, r = nwg % NXCD, xcd = wgid % NXCD, off = wgid / NXCD; wgid = (xcd < r ? xcd * (q + 1) : r * (q + 1) + (xcd - r) * q) + off; }
        const int nig = WGM * nN, gid = wgid / nig, fm = gid * WGM, gsz = (nM - fm) < WGM ? (nM - fm) : WGM;
        u.pm = fm + ((wgid % nig) % gsz); u.pn = (wgid % nig) / gsz; return true;
    }
    __device__ __forceinline__ void a_ready(const Unit&) const {}
    __device__ __forceinline__ void done(const Unit&) const {}
};

__device__ __forceinline__ unsigned cvt_pk_bf16(float lo, float hi) { unsigned r; asm volatile("v_cvt_pk_bf16_f32 %0, %1, %2" : "=v"(r) : "v"(lo), "v"(hi)); return r; }

struct EpiProj {
    static constexpr bool PERM = true, AFTER_DRAIN = false;
    bf16_t* base; bf16_t* wdad; const float* ropec; const float* ropes; size_t gstride;
    __device__ __forceinline__ void operator()(const f32x4 (&acc)[2][2][4][2], const Unit& u, int wr, int wc, int fr, int fq) const {
        const int row0 = u.pm * BM + wr * 64 + fr;
        if (u.pn < 32) {
            const int group = u.pn >> 2; bf16_t* bg = base + (size_t)group * gstride;
            const int col0 = (u.pn & 3) * BM + wc * 32 + 8 * fq;
            const bool rope = (group == 5 || group == 6) && wc == 0;
#pragma unroll
            for (int ai = 0; ai < 2; ++ai)
#pragma unroll
                for (int m = 0; m < 4; ++m) { const int row = row0 + ai * HALF + m * 16; bf16_t* rowp = bg + (size_t)row * 1024 + col0;
                    f32x4 cs = (f32x4){1.f, 1.f, 1.f, 1.f}, sn = (f32x4){0.f, 0.f, 0.f, 0.f};
                    if (rope) { cs = *(const f32x4*)(ropec + (size_t)row * 16 + 4 * fq); sn = *(const f32x4*)(ropes + (size_t)row * 16 + 4 * fq); }
#pragma unroll
                    for (int bj = 0; bj < 2; ++bj) { f32x4 v0 = acc[ai][bj][m][0], v1 = acc[ai][bj][m][1];
                        if (rope) { const f32x4 a = v0 * cs - v1 * sn, b = v1 * cs + v0 * sn; v0 = a; v1 = b; }
                        u32x4 w; w.x = cvt_pk_bf16(v0[0], v0[1]); w.y = cvt_pk_bf16(v0[2], v0[3]); w.z = cvt_pk_bf16(v1[0], v1[1]); w.w = cvt_pk_bf16(v1[2], v1[3]);
                        *(u32x4*)(rowp + bj * HALF) = w; } }
        } else {
            const int col0 = wc * 32 + 8 * fq;
#pragma unroll
            for (int ai = 0; ai < 2; ++ai)
#pragma unroll
                for (int m = 0; m < 4; ++m) { const int row = row0 + ai * HALF + m * 16; bf16_t* rowp = wdad + (size_t)row * 128 + col0;
                    const f32x4 v0 = acc[ai][0][m][0], v1 = acc[ai][0][m][1];
                    u32x4 w; w.x = cvt_pk_bf16(v0[0], v0[1]); w.y = cvt_pk_bf16(v0[2], v0[3]); w.z = cvt_pk_bf16(v1[0], v1[1]); w.w = cvt_pk_bf16(v1[2], v1[3]);
                    *(u32x4*)rowp = w; }
        }
    }
};

struct EpiOut {
    static constexpr bool PERM = false, AFTER_DRAIN = false;
    const float* x; float* out; float* rowss; int ldc;
    __device__ __forceinline__ void operator()(const f32x4 (&acc)[2][2][4][2], const Unit& u, int wr, int wc, int fr, int fq) const {
        const int row0 = u.pm * BM + wr * 64 + fr, col0 = u.pn * BM + wc * 32 + 4 * fq;
#pragma unroll
        for (int ai = 0; ai < 2; ++ai)
#pragma unroll
            for (int m = 0; m < 4; ++m) { const int row = row0 + ai * HALF + m * 16; const size_t off = (size_t)row * ldc + col0; float ss = 0.f;
#pragma unroll
                for (int bj = 0; bj < 2; ++bj)
#pragma unroll
                    for (int n = 0; n < 2; ++n) { const f32x4 xv = *(const f32x4*)(x + off + bj * HALF + n * 16); const f32x4 h = xv + acc[ai][bj][m][n];
                        *(f32x4*)(out + off + bj * HALF + n * 16) = h; ss += (h[0] * h[0] + h[1] * h[1]) + (h[2] * h[2] + h[3] * h[3]); }
                ss += __shfl_xor(ss, 16); ss += __shfl_xor(ss, 32);
                if (fq == 0) rowss[(size_t)row * 32 + u.pn * 4 + wc] = ss; }
    }
};
template <class Epi, class Sched, bool ALIGN_EPI = false, bool SP2 = false>
__device__ __forceinline__ void gemm_phase(PG8_LAS unsigned char* lds, const Gemm g, const Sched& S, const Epi& E) {
    int tid_ = threadIdx.x; asm volatile("" : "+v"(tid_));
    const int tid = tid_, wid = __builtin_amdgcn_readfirstlane(tid >> 6), lane = tid & 63, wr = wid >> 2, wc = wid & 3, fr = lane & 15, fq = lane >> 4;
    const int K = g.K, nt = K / BK;
    unsigned voffA[2], voffB[2];
#pragma unroll
    for (int i = 0; i < 2; ++i) { int R, C; stage_rc(tid * 16 + i * 8192, R, C); const int Rb = Epi::PERM ? ((R & ~31) + perm32(R & 31)) : R;
        voffA[i] = (unsigned)(R * K + C) * 2u; voffB[i] = (unsigned)(Rb * K + C) * 2u; }
    const size_t kstep = (size_t)(BK * 2);
    const size_t hstep = (size_t)HALF * K * 2;
    const size_t tstep = 2 * hstep;
    const unsigned ldsw = (unsigned)wid * 1024u;
    const int aoff = lds_byte(wr * 64 + fr, fq * 8), boff = lds_byte(wc * 32 + fr, fq * 8);
#define PG8_SA(b, h) (((b) * 2 + (h)) * HTB)
#define PG8_SB(b, h) ((4 + (b) * 2 + (h)) * HTB)
#define PG8_STAGE(bufoff, gbase, voff) do { _Pragma("unroll") for (int _i = 0; _i < 2; ++_i) \
        __builtin_amdgcn_global_load_lds((const unsigned*)((const char*)(gbase) + (voff)[_i]), (PG8_LAS unsigned*)(lds + (bufoff) + ldsw + _i * 8192), 16, 0, 0); } while (0)
#define PG8_LDA(dst, b, h) do { _Pragma("unroll") for (int m = 0; m < 4; ++m) _Pragma("unroll") for (int k = 0; k < 2; ++k) dst[m][k] = *(const PG8_LAS bf16x8*)(lds + PG8_SA(b, h) + aoff + m * 2048 + k * 1024); } while (0)
#define PG8_LDB(dst, b, h) do { _Pragma("unroll") for (int n = 0; n < 2; ++n) _Pragma("unroll") for (int k = 0; k < 2; ++k) dst[n][k] = *(const PG8_LAS bf16x8*)(lds + PG8_SB(b, h) + boff + n * 2048 + k * 1024); } while (0)
#define PG8_MMA(ai, bj, At, Bt) do { __builtin_amdgcn_s_setprio(1); _Pragma("unroll") for (int m = 0; m < 4; ++m) _Pragma("unroll") for (int n = 0; n < 2; ++n) _Pragma("unroll") for (int k = 0; k < 2; ++k) \
        acc[ai][bj][m][n] = __builtin_amdgcn_mfma_f32_16x16x32_bf16(Bt[n][k], At[m][k], acc[ai][bj][m][n], 0, 0, 0); __builtin_amdgcn_s_setprio(0); } while (0)
#define PG8_WAIT_V(n) asm volatile("s_waitcnt vmcnt(" #n ")" ::: "memory")
#define PG8_WAIT_L(n) asm volatile("s_waitcnt lgkmcnt(" #n ")" ::: "memory")
#define PG8_BAR __builtin_amdgcn_s_barrier()
#define PG8_SCHED __builtin_amdgcn_sched_barrier(0)
    Unit cur, nxt; int ui = 0;
    if (!S.next(0, cur)) return;
    f32x4 acc[2][2][4][2];
#pragma unroll
    for (int a = 0; a < 2; ++a)
#pragma unroll
        for (int b = 0; b < 2; ++b)
#pragma unroll
            for (int m = 0; m < 4; ++m)
#pragma unroll
                for (int n = 0; n < 2; ++n) acc[a][b][m][n] = (f32x4){0.f, 0.f, 0.f, 0.f};
    bf16x8 At[4][2], B0[2][2], B1[2][2];
    const char* cA = (const char*)g.A + (size_t)cur.pm * tstep; const char* cB = (const char*)g.Bt + (size_t)cur.pn * tstep;
    S.a_ready(cur);
    if constexpr (SP2) {
        PG8_STAGE(PG8_SB(0, 0), cB, voffB); PG8_STAGE(PG8_SB(0, 1), cB + hstep, voffB); PG8_STAGE(PG8_SA(0, 0), cA, voffA); PG8_STAGE(PG8_SA(0, 1), cA + hstep, voffA);
        if (wr == 1) PG8_BAR;
        PG8_WAIT_V(2); PG8_BAR;
        PG8_STAGE(PG8_SB(1, 0), cB + kstep, voffB); PG8_STAGE(PG8_SA(1, 0), cA + kstep, voffA); PG8_STAGE(PG8_SB(1, 1), cB + hstep + kstep, voffB);
        PG8_WAIT_V(6); PG8_BAR;
    } else {
        PG8_STAGE(PG8_SB(0, 0), cB, voffB); PG8_STAGE(PG8_SA(0, 0), cA, voffA); PG8_STAGE(PG8_SB(0, 1), cB + hstep, voffB); PG8_STAGE(PG8_SA(0, 1), cA + hstep, voffA);
        if (wr == 1) PG8_BAR;
        PG8_WAIT_V(4); PG8_BAR;
        PG8_STAGE(PG8_SB(1, 0), cB + kstep, voffB); PG8_STAGE(PG8_SA(1, 0), cA + kstep, voffA); PG8_STAGE(PG8_SB(1, 1), cB + hstep + kstep, voffB);
        PG8_WAIT_V(6); PG8_BAR;
    }
    for (;;) {
        const bool has_next = S.next(ui + 1, nxt);
        const char* nA = has_next ? (const char*)g.A + (size_t)nxt.pm * tstep : cA; const char* nB = has_next ? (const char*)g.Bt + (size_t)nxt.pn * tstep : cB;
        for (int t = 0; t < nt; t += 2) {
            const bool last = (t == nt - 2);
            const char* a1 = cA + (size_t)(t + 1) * kstep;
            const char* a2 = last ? nA : cA + (size_t)(t + 2) * kstep; const char* b2 = last ? nB : cB + (size_t)(t + 2) * kstep;
            const char* a3 = a2 + kstep; const char* b3 = b2 + kstep;
            if (last && has_next) S.a_ready(nxt);
            if constexpr (SP2) {
            PG8_LDB(B0, 0, 0); PG8_LDB(B1, 0, 1); PG8_SCHED; PG8_LDA(At, 0, 0); PG8_STAGE(PG8_SA(1, 1), a1 + hstep, voffA);
            PG8_WAIT_V(8); PG8_WAIT_L(0); PG8_BAR; PG8_MMA(0, 0, At, B0); PG8_MMA(0, 1, At, B1); PG8_BAR; PG8_SCHED;
            PG8_LDA(At, 0, 1); PG8_STAGE(PG8_SB(0, 0), b2, voffB); PG8_STAGE(PG8_SB(0, 1), b2 + hstep, voffB); PG8_STAGE(PG8_SA(0, 0), a2, voffA);
            PG8_WAIT_V(8); PG8_WAIT_L(0); PG8_BAR; PG8_MMA(1, 0, At, B0); PG8_MMA(1, 1, At, B1); PG8_BAR; PG8_SCHED;
            PG8_LDB(B0, 1, 0); PG8_LDB(B1, 1, 1); PG8_SCHED; PG8_LDA(At, 1, 0); PG8_STAGE(PG8_SA(0, 1), a2 + hstep, voffA);
            PG8_WAIT_V(8); PG8_WAIT_L(0); PG8_BAR; PG8_MMA(0, 0, At, B0); PG8_MMA(0, 1, At, B1); PG8_BAR; PG8_SCHED;
            PG8_LDA(At, 1, 1); PG8_STAGE(PG8_SB(1, 0), b3, voffB); PG8_STAGE(PG8_SB(1, 1), b3 + hstep, voffB); PG8_STAGE(PG8_SA(1, 0), a3, voffA);
            PG8_WAIT_V(8); PG8_WAIT_L(0); PG8_BAR; PG8_MMA(1, 0, At, B0); PG8_MMA(1, 1, At, B1); PG8_BAR; PG8_SCHED;
            } else {
            PG8_LDB(B0, 0, 0); PG8_SCHED; PG8_LDA(At, 0, 0); PG8_STAGE(PG8_SA(1, 1), a1 + hstep, voffA);
            PG8_WAIT_L(8); PG8_BAR; PG8_WAIT_L(0); PG8_MMA(0, 0, At, B0); PG8_BAR; PG8_SCHED;
            PG8_LDB(B1, 0, 1); PG8_STAGE(PG8_SB(0, 0), b2, voffB);
            PG8_BAR; PG8_WAIT_L(0); PG8_MMA(0, 1, At, B1); PG8_BAR;
            PG8_LDA(At, 0, 1); PG8_STAGE(PG8_SA(0, 0), a2, voffA);
            PG8_BAR; PG8_WAIT_L(0); PG8_MMA(1, 0, At, B0); PG8_BAR; PG8_SCHED;
            PG8_STAGE(PG8_SB(0, 1), b2 + hstep, voffB);
            PG8_WAIT_V(6); PG8_BAR; PG8_MMA(1, 1, At, B1); PG8_BAR;
            PG8_LDB(B0, 1, 0); PG8_SCHED; PG8_LDA(At, 1, 0); PG8_STAGE(PG8_SA(0, 1), a2 + hstep, voffA);
            PG8_WAIT_L(8); PG8_BAR; PG8_WAIT_L(0); PG8_MMA(0, 0, At, B0); PG8_BAR; PG8_SCHED;
            PG8_LDB(B1, 1, 1); PG8_STAGE(PG8_SB(1, 0), b3, voffB);
            PG8_BAR; PG8_WAIT_L(0); PG8_MMA(0, 1, At, B1); PG8_BAR;
            PG8_LDA(At, 1, 1); PG8_STAGE(PG8_SA(1, 0), a3, voffA);
            PG8_BAR; PG8_WAIT_L(0); PG8_MMA(1, 0, At, B0); PG8_BAR; PG8_SCHED;
            PG8_STAGE(PG8_SB(1, 1), b3 + hstep, voffB);
            PG8_WAIT_V(6); PG8_BAR; PG8_MMA(1, 1, At, B1); PG8_BAR;
            }
        }
        if constexpr (ALIGN_EPI) { if (wr == 0) PG8_BAR; }
        if constexpr (!Epi::AFTER_DRAIN) { E(acc, cur, wr, wc, fr, fq); S.done(cur); }
        if (!has_next) break;
#pragma unroll
        for (int a = 0; a < 2; ++a)
#pragma unroll
            for (int b = 0; b < 2; ++b)
#pragma unroll
                for (int m = 0; m < 4; ++m)
#pragma unroll
                    for (int n = 0; n < 2; ++n) acc[a][b][m][n] = (f32x4){0.f, 0.f, 0.f, 0.f};
        cur = nxt; cA = nA; cB = nB; ++ui;
        if constexpr (ALIGN_EPI) { if (wr == 1) PG8_BAR; }
    }
    PG8_WAIT_V(0);
    if constexpr (!ALIGN_EPI) { if (wr == 0) PG8_BAR; }
    PG8_BAR;
    if constexpr (Epi::AFTER_DRAIN) { E.fused(acc, cur, wr, wc, fr, fq, lds, wid, lane); S.done(cur); }
#undef PG8_SA
#undef PG8_SB
#undef PG8_STAGE
#undef PG8_LDA
#undef PG8_LDB
#undef PG8_MMA
#undef PG8_WAIT_V
#undef PG8_WAIT_L
#undef PG8_BAR
#undef PG8_SCHED
}
}

constexpr int NWAVES = 8;
constexpr int T = 16384, D = 2048, DIN = 8320, NPROJ = 8448;
constexpr int RW_H = 16, RW_N = 64, MB_H = 8, MB_D = 128, MB_BLK = 256, MB_NB = 64, LORA = 64;
constexpr float RMS_EPS = 1e-6f, LNX_EPS = 64e-5f;

constexpr size_t MiB = 1u << 20;
constexpr size_t WS_CTL = 0, CTL_ZERO_BYTES = 1 * MiB;
constexpr size_t WS_KMEAN = 1 * MiB;
constexpr size_t WS_KMEANB = WS_KMEAN + 256 * 1024;
constexpr size_t WS_BSC = 2 * MiB;
constexpr size_t WS_W2T = 4 * MiB;
constexpr size_t WS_ROPE = 12 * MiB;
constexpr size_t WS_W1T = 16 * MiB;
constexpr size_t WS_LIST = 16 * MiB;
constexpr size_t WS_XN = 52 * MiB;
constexpr size_t WS_Y = 52 * MiB;
constexpr size_t WS_PROJ = 116 * MiB;
constexpr size_t GRP = 32 * MiB;
constexpr size_t WS_R = WS_PROJ, WS_K = WS_PROJ + GRP, WS_V = WS_PROJ + 2 * GRP, WS_GR = WS_PROJ + 3 * GRP, WS_GM = WS_PROJ + 4 * GRP,
                 WS_Q = WS_PROJ + 5 * GRP, WS_KM = WS_PROJ + 6 * GRP, WS_VM = WS_PROJ + 7 * GRP;
constexpr size_t WS_WDAD = 372 * MiB;
constexpr size_t WS_PARTO = 376 * MiB;
constexpr size_t WS_PARTML = 504 * MiB;
constexpr size_t WS_ROWSS = 508 * MiB;
constexpr size_t WS_MIXED = WS_Q;
constexpr size_t WS_END = 510 * MiB;
constexpr int CW_BAR = 4096;
constexpr int CW_CNT = 16384;

constexpr int LDS_BYTES = 155648;
constexpr int MISC_OFF = 147456;

#define GAS __attribute__((address_space(1)))
#define LAS __attribute__((address_space(3)))
typedef unsigned short bf16;
typedef unsigned v4u __attribute__((ext_vector_type(4)));
typedef unsigned v2u __attribute__((ext_vector_type(2)));
typedef float f32x4 __attribute__((ext_vector_type(4)));
typedef float f32x2 __attribute__((ext_vector_type(2)));
typedef short bf16x8 __attribute__((ext_vector_type(8)));
typedef short s16x4 __attribute__((ext_vector_type(4)));
typedef GAS unsigned gu32;
#define RLX_AGENT __ATOMIC_RELAXED, __HIP_MEMORY_SCOPE_AGENT
#define LDS_WAIT() asm volatile("s_waitcnt lgkmcnt(0)" ::: "memory")
#define VM_WAIT() asm volatile("s_waitcnt vmcnt(0)" ::: "memory")
typedef __bf16 hwbf2 __attribute__((ext_vector_type(2)));
__device__ __forceinline__ unsigned f2bf(float f) { return (unsigned)__builtin_bit_cast(unsigned short, (__bf16)f); }
__device__ __forceinline__ unsigned pk2(float lo, float hi) { return __builtin_bit_cast(unsigned, __builtin_convertvector((f32x2){lo, hi}, hwbf2)); }
__device__ __forceinline__ float bflo(unsigned w) { return __builtin_bit_cast(float, w << 16); }
__device__ __forceinline__ float bfhi(unsigned w) { return __builtin_bit_cast(float, w & 0xffff0000u); }
__device__ __forceinline__ float bf2f(bf16 b) { return __builtin_bit_cast(float, (unsigned)b << 16); }
__device__ __forceinline__ float sigmoidf_(float x) { return __builtin_amdgcn_rcpf(1.f + __expf(-x)); }

#define XB_TMO      128
#define XB_XCNT(j)  (256  + 64 * (j))
#define XB_XSUB(j)  (1280 + 64 * (j))
#define XB_XGEN(j)  (2304 + 64 * (j))
#define XB_TOP      3328
#define XB_TOPGEN   3392
#define XCD_BAR_WORDS 3456
#define XB_SPIN_CAP (1u << 22)

__device__ __forceinline__ unsigned xb_ld(unsigned* p)              { return __hip_atomic_load(p, __ATOMIC_RELAXED, __HIP_MEMORY_SCOPE_AGENT); }
__device__ __forceinline__ unsigned xb_add(unsigned* p, unsigned v) { return __hip_atomic_fetch_add(p, v, __ATOMIC_RELAXED, __HIP_MEMORY_SCOPE_AGENT); }
__device__ __forceinline__ unsigned xb_xcc_id() { return (unsigned)__builtin_amdgcn_s_getreg((3 << 11) | 20) & 0xFu; }
#define XB_SPIN(cond, bar) do { unsigned _sp = 0; while (cond) { __builtin_amdgcn_s_sleep(1); \
    if ((++_sp & 255u) == 0u) { if (xb_ld(&(bar)[XB_TMO])) break; if (_sp > XB_SPIN_CAP) { atomicAdd(&(bar)[XB_TMO], 1u); break; } } } } while (0)

struct XcdBarrier { unsigned* bar; unsigned x; volatile LAS unsigned* st; };

__device__ __forceinline__ XcdBarrier xcd_barrier_post(unsigned* bar, volatile LAS unsigned* st) {
    XcdBarrier b; b.bar = bar; b.x = xb_xcc_id(); b.st = st;
    if (threadIdx.x == 0) (void)xb_add(&bar[XB_XCNT(b.x)], 1u);
    return b;
}
__device__ __forceinline__ void xcd_barrier_complete(unsigned* bar, unsigned x, unsigned& nloc, unsigned& nx) {
    const unsigned G = gridDim.x * gridDim.y * gridDim.z;
    unsigned sum, cnt, mine, sp = 0u;
    for (;;) {
        sum = 0u; cnt = 0u; mine = 0u;
#pragma unroll
        for (unsigned j = 0; j < 16; ++j) { const unsigned c = xb_ld(&bar[XB_XCNT(j)]); sum += c; cnt += (c > 0u) ? 1u : 0u; mine = (j == x) ? c : mine; }
        if (sum == G) break;
        __builtin_amdgcn_s_sleep(1);
        if ((++sp & 255u) == 0u) { if (xb_ld(&bar[XB_TMO])) break; if (sp > XB_SPIN_CAP) { atomicAdd(&bar[XB_TMO], 1u); break; } }
    }
    nloc = mine > 0u ? mine : 1u; nx = cnt > 0u ? cnt : 1u;
}
__device__ __forceinline__ void xcd_barrier(const XcdBarrier& b) {
    asm volatile("s_waitcnt vmcnt(0)" ::: "memory");
    __syncthreads();
    if (threadIdx.x == 0) {
        unsigned* bar = b.bar;
        __builtin_amdgcn_s_waitcnt(0);
        unsigned nloc = b.st[0], nx = b.st[1];
        if (nloc == 0u) { xcd_barrier_complete(bar, b.x, nloc, nx); b.st[0] = nloc; b.st[1] = nx; }
        const unsigned old = xb_add(&bar[XB_XSUB(b.x)], 1u);
        const unsigned gen = old / nloc;
        if (old + 1u == (gen + 1u) * nloc) {
            __builtin_amdgcn_fence(__ATOMIC_RELEASE, "agent");
            asm volatile("s_waitcnt vmcnt(0)" ::: "memory");
            const unsigned og = xb_add(&bar[XB_TOP], 1u);
            const unsigned tg = og / nx;
            if (og + 1u == (tg + 1u) * nx) xb_add(&bar[XB_TOPGEN], 1u);
            else XB_SPIN(xb_ld(&bar[XB_TOPGEN]) == tg, bar);
            __builtin_amdgcn_fence(__ATOMIC_ACQUIRE, "agent");
            xb_add(&bar[XB_XGEN(b.x)], 1u);
            asm volatile("s_waitcnt vmcnt(0)" ::: "memory");
        } else {
            XB_SPIN(xb_ld(&bar[XB_XGEN(b.x)]) == gen, bar);
            __builtin_amdgcn_fence(__ATOMIC_ACQUIRE, "agent");
            asm volatile("s_waitcnt vmcnt(0)" ::: "memory");
        }
    }
    __syncthreads();
}

struct Frame {
    LAS unsigned char* lds;
    volatile LAS unsigned* MISC;
    gu32* ctl;
    int tid, lane, wave;
    int G, bid;
    unsigned char* ws;
    const float *x, *norm_w, *w_in, *mu_rkv, *mu_lora, *w_decay_up, *w_decay_bias, *w_iclr_up, *w_iclr_bias, *k_k, *k_a, *r_k, *lnx_w, *lnx_b, *w_out, *final_norm_w;
    float* out;
};

__device__ __forceinline__ float wave_sum(float v) {
#pragma unroll
    for (int o = 1; o < 64; o <<= 1) v += __shfl_xor(v, o);
    return v;
}
__device__ __forceinline__ float wave_max(float v) {
#pragma unroll
    for (int o = 1; o < 64; o <<= 1) v = fmaxf(v, __shfl_xor(v, o));
    return v;
}

__device__ __forceinline__ int w1_src_col(int n) {
    if (n < 8192) {
        const int g = n >> 10, w = n & 1023;
        if (g == 5 || g == 6) {
            const int base = (g == 5) ? 4224 : 5248, hh = w >> 7, p = w & 127; int d = p;
            if (p < 32) { const int a = p >> 3, b = p & 7; d = (b < 4) ? (4 * a + b) : (16 + 4 * a + (b - 4)); }
            return base + hh * 128 + d;
        }
        const int base = (g == 0) ? 0 : (g == 1) ? 1024 : (g == 2) ? 2048 : (g == 3) ? 3200 : (g == 4) ? 7296 : 6272;
        return base + w;
    }
    if (n < 8320) return 3072 + (n - 8192);
    return -1;
}
template <bool MAP>
__device__ __forceinline__ void p0_transpose_item(const float* W, const float* rowscale, int K, int N, bf16* WT, int nblk, LAS float* scr, int item, int lane) {
    const int kb = item / nblk, nb = item % nblk, k0 = 64 * kb, n0 = 64 * nb, kq = lane >> 4, nq = lane & 15;
    const int nd = n0 + 4 * nq; const int src = MAP ? w1_src_col(nd) : nd;
    f32x4 v[16];
#pragma unroll
    for (int i = 0; i < 16; ++i) { const int k = k0 + 4 * i + kq; v[i] = (src >= 0) ? *(const GAS f32x4*)(W + (size_t)k * N + src) : (f32x4){0.f, 0.f, 0.f, 0.f}; if (MAP) v[i] = v[i] * rowscale[k]; }
#pragma unroll
    for (int i = 0; i < 16; ++i) { LAS float* d = scr + (4 * i + kq) * 65 + 4 * nq; d[0] = v[i].x; d[1] = v[i].y; d[2] = v[i].z; d[3] = v[i].w; }
    LDS_WAIT(); asm volatile("" ::: "memory");
    const int c = lane & 7;
#pragma unroll
    for (int j = 0; j < 8; ++j) { const int n = (lane >> 3) + 8 * j; const LAS float* sp = scr + (8 * c) * 65 + n;
        v4u o; o.x = pk2(sp[0 * 65], sp[1 * 65]); o.y = pk2(sp[2 * 65], sp[3 * 65]); o.z = pk2(sp[4 * 65], sp[5 * 65]); o.w = pk2(sp[6 * 65], sp[7 * 65]);
        *(GAS v4u*)(WT + (size_t)(n0 + n) * K + k0 + 8 * c) = o; }
    LDS_WAIT(); asm volatile("" ::: "memory");
}
__device__ __forceinline__ void rms_row_to_bf16(const float* xrow, bf16* orow, int lane) {
    const GAS f32x4* xr = (const GAS f32x4*)xrow + lane;
    f32x4 v[8]; float s = 0.f;
#pragma unroll
    for (int j = 0; j < 8; ++j) { v[j] = xr[64 * j]; s += (v[j].x * v[j].x + v[j].y * v[j].y) + (v[j].z * v[j].z + v[j].w * v[j].w); }
    const float rs = 1.f / sqrtf(wave_sum(s) * (1.f / D) + RMS_EPS);
    GAS unsigned long long* o8 = (GAS unsigned long long*)orow + lane;
#pragma unroll
    for (int j = 0; j < 8; ++j) o8[64 * j] = (unsigned long long)pk2(v[j].x * rs, v[j].y * rs) | ((unsigned long long)pk2(v[j].z * rs, v[j].w * rs) << 32);
}
__device__ __forceinline__ void p0_prologue(Frame& F) {
    LAS float* scr = (LAS float*)(F.lds + F.wave * 17408);
    const int gw = F.bid * NWAVES + F.wave, NGW = F.G * NWAVES;
    constexpr int I_1 = (D / 64) * (NPROJ / 64), I_2 = (D / 64) * (D / 64);
#pragma unroll 1
    for (int pass = 0; pass < 2; ++pass) {
        if ((pass == 0) == ((F.wave & 1) == 0)) {
            for (int it = gw; it < I_1 + I_2; it += NGW) {
                if (it < I_1) p0_transpose_item<true>(F.w_in, F.norm_w, D, DIN, (bf16*)(F.ws + WS_W1T), NPROJ / 64, scr, it, F.lane);
                else p0_transpose_item<false>(F.w_out, nullptr, D, D, (bf16*)(F.ws + WS_W2T), D / 64, scr, it - I_1, F.lane);
            }
        } else {
            for (int m = gw; m < T; m += NGW) rms_row_to_bf16(F.x + (size_t)m * D, (bf16*)(F.ws + WS_XN) + (size_t)m * D, F.lane);
        }
    }
    { bf16* wdt = (bf16*)(F.ws + 1 * MiB + 512 * 1024); bf16* wit = (bf16*)(F.ws + 1 * MiB + 640 * 1024);
      for (int e = F.bid * 512 + F.tid; e < 1024 * 64; e += F.G * 512) { const int c = e >> 6, l = e & 63; wdt[e] = (bf16)f2bf(F.w_decay_up[(size_t)l * 1024 + c]); wit[e] = (bf16)f2bf(F.w_iclr_up[(size_t)l * 1024 + c]); } }
    { float* rc = (float*)(F.ws + WS_ROPE); float* rsn = rc + (size_t)T * 16;
      for (int e = F.bid * 512 + F.tid; e < T * 16; e += F.G * 512) { const int t = e >> 4, i = e & 15;
          const double invf = exp2(-(double)i * (18.931568569324174 / 16.0));
          const double ang = (double)t * invf; const double n = rint(ang * 0.15915494309189535);
          double r = fma(-n, 6.283185307179586, ang); r = fma(-n, 2.4492935982947064e-16, r);
          const float rf = (float)r; rc[e] = cosf(rf); rsn[e] = sinf(rf); } }
}

__device__ __forceinline__ f32x4 mfma16(bf16x8 a, bf16x8 b, f32x4 c) { return __builtin_amdgcn_mfma_f32_16x16x32_bf16(a, b, c, 0, 0, 0); }
__device__ __forceinline__ int list_off(int h, int j) { return h * 516096 + 256 * (63 * j - (j * (j - 1)) / 2); }

__device__ __forceinline__ void p2_kmean(Frame& F) {
    const bf16* KM = (const bf16*)(F.ws + WS_KM); float* kmean = (float*)(F.ws + WS_KMEAN); bf16* kmeanb = (bf16*)(F.ws + WS_KMEANB);
    LAS float* red = (LAS float*)F.lds;
    const int dp = F.tid & 63, rg = F.tid >> 6;
    for (int u = F.bid; u < MB_NB * MB_H; u += F.G) { const int c = u >> 3, h = u & 7;
        float s0 = 0.f, s1 = 0.f;
        const unsigned* p = (const unsigned*)(KM + (size_t)(c * 256 + rg * 32) * 1024 + 128 * h) + dp;
#pragma unroll 8
        for (int r = 0; r < 32; ++r) { const unsigned w = p[(size_t)r * 512]; s0 += bflo(w); s1 += bfhi(w); }
        red[rg * 128 + 2 * dp] = s0; red[rg * 128 + 2 * dp + 1] = s1;
        __syncthreads();
        if (F.tid < 128) { float s = 0.f;
#pragma unroll
            for (int g = 0; g < 8; ++g) s += red[g * 128 + F.tid];
            s *= (1.f / 256.f); kmean[(size_t)(h * 64 + c) * 128 + F.tid] = s; kmeanb[(size_t)(h * 64 + c) * 128 + F.tid] = (bf16)f2bf(s); }
        __syncthreads();
    }
}

__device__ __forceinline__ void top3_insert(float v, int i, float& v1, int& i1, float& v2, int& i2, float& v3, int& i3) {
    const bool b1 = (v > v1) || (v == v1 && i < i1), b2 = (v > v2) || (v == v2 && i < i2), b3 = (v > v3) || (v == v3 && i < i3);
    const float n3 = b2 ? v2 : (b3 ? v : v3), n2 = b1 ? v1 : (b2 ? v : v2), n1 = b1 ? v : v1;
    const int m3 = b2 ? i2 : (b3 ? i : i3), m2 = b1 ? i1 : (b2 ? i : i2), m1 = b1 ? i : i1;
    v1 = n1; v2 = n2; v3 = n3; i1 = m1; i2 = m2; i3 = m3;
}
__device__ __forceinline__ void p3_gate(Frame& F) {
    const bf16* Q = (const bf16*)(F.ws + WS_Q); const bf16* kmb = (const bf16*)(F.ws + WS_KMEANB);
    unsigned* cnt = (unsigned*)(F.ctl + CW_CNT); int* list = (int*)(F.ws + WS_LIST);
    const int gw = F.bid * NWAVES + F.wave, NGW = F.G * NWAVES, lane = F.lane, qi = lane & 15, g = lane >> 4;
    for (int u = gw; u < (T / 16) * MB_H; u += NGW) { const int qt = u >> 3, h = u & 7, cur = qt >> 4;
        if (cur == 0) continue;
        const int t = qt * 16 + qi;
        bf16x8 qf[4];
#pragma unroll
        for (int ks = 0; ks < 4; ++ks) qf[ks] = *(const bf16x8*)(Q + (size_t)t * 1024 + 128 * h + 32 * ks + 8 * g);
        float v1 = -INFINITY, v2 = -INFINITY, v3 = -INFINITY; int i1 = 1 << 20, i2 = 1 << 20, i3 = 1 << 20;
        const int njt = ((cur - 1) >> 4) + 1;
#pragma unroll
        for (int jt = 0; jt < 4; ++jt) { if (jt < njt) {
            f32x4 acc = (f32x4){0.f, 0.f, 0.f, 0.f};
#pragma unroll
            for (int ks = 0; ks < 4; ++ks) { const bf16x8 a = *(const bf16x8*)(kmb + (size_t)(h * 64 + jt * 16 + qi) * 128 + 32 * ks + 8 * g); acc = mfma16(a, qf[ks], acc); }
#pragma unroll
            for (int r = 0; r < 4; ++r) { const int j = jt * 16 + 4 * g + r; const float v = (j < cur) ? acc[r] : -INFINITY; top3_insert(v, j, v1, i1, v2, i2, v3, i3); }
        } }
#pragma unroll
        for (int o = 16; o <= 32; o <<= 1) {
            const float a1 = __shfl_xor(v1, o), a2 = __shfl_xor(v2, o), a3 = __shfl_xor(v3, o); const int b1 = __shfl_xor(i1, o), b2 = __shfl_xor(i2, o), b3 = __shfl_xor(i3, o);
            top3_insert(a1, b1, v1, i1, v2, i2, v3, i3); top3_insert(a2, b2, v1, i1, v2, i2, v3, i3); top3_insert(a3, b3, v1, i1, v2, i2, v3, i3);
        }
        const int vc = cur < 3 ? cur : 3;
        if (g == 0) {
            if (vc > 0) { const unsigned pos = atomicAdd(&cnt[h * 64 + i1], 1u); list[list_off(h, i1) + pos] = (t << 2) | 0; }
            if (vc > 1) { const unsigned pos = atomicAdd(&cnt[h * 64 + i2], 1u); list[list_off(h, i2) + pos] = (t << 2) | 1; }
            if (vc > 2) { const unsigned pos = atomicAdd(&cnt[h * 64 + i3], 1u); list[list_off(h, i3) + pos] = (t << 2) | 2; }
        }
    }
}

constexpr int KV_STRIDE = 288;
constexpr int KLDS_OFF = 0, VLDS_OFF = 256 * KV_STRIDE, PFX_OFF = MISC_OFF + 1024;
__device__ __forceinline__ void tr_read2(s16x4& r0, s16x4& r1, unsigned a0, unsigned a1) {
    asm volatile("ds_read_b64_tr_b16 %0, %2\n\tds_read_b64_tr_b16 %1, %3\n\ts_waitcnt lgkmcnt(0)" : "=&v"(r0), "=&v"(r1) : "v"(a0), "v"(a1) : "memory"); }

template <int B0, int B1> __device__ __forceinline__ void tr_read16(s16x4 (&r)[16], unsigned base) {
    asm volatile(
        "ds_read_b64_tr_b16 %0, %16 offset:%17\n\tds_read_b64_tr_b16 %1, %16 offset:%18\n\tds_read_b64_tr_b16 %2, %16 offset:%19\n\tds_read_b64_tr_b16 %3, %16 offset:%20\n\t"
        "ds_read_b64_tr_b16 %4, %16 offset:%21\n\tds_read_b64_tr_b16 %5, %16 offset:%22\n\tds_read_b64_tr_b16 %6, %16 offset:%23\n\tds_read_b64_tr_b16 %7, %16 offset:%24\n\t"
        "ds_read_b64_tr_b16 %8, %16 offset:%25\n\tds_read_b64_tr_b16 %9, %16 offset:%26\n\tds_read_b64_tr_b16 %10, %16 offset:%27\n\tds_read_b64_tr_b16 %11, %16 offset:%28\n\t"
        "ds_read_b64_tr_b16 %12, %16 offset:%29\n\tds_read_b64_tr_b16 %13, %16 offset:%30\n\tds_read_b64_tr_b16 %14, %16 offset:%31\n\tds_read_b64_tr_b16 %15, %16 offset:%32\n\t"
        "s_waitcnt lgkmcnt(0)"
        : "=&v"(r[0]), "=&v"(r[1]), "=&v"(r[2]), "=&v"(r[3]), "=&v"(r[4]), "=&v"(r[5]), "=&v"(r[6]), "=&v"(r[7]), "=&v"(r[8]), "=&v"(r[9]), "=&v"(r[10]), "=&v"(r[11]), "=&v"(r[12]), "=&v"(r[13]), "=&v"(r[14]), "=&v"(r[15])
        : "v"(base), "i"(B0), "i"(B0 + 32), "i"(B0 + 64), "i"(B0 + 96), "i"(B0 + 128), "i"(B0 + 160), "i"(B0 + 192), "i"(B0 + 224),
          "i"(B1), "i"(B1 + 32), "i"(B1 + 64), "i"(B1 + 96), "i"(B1 + 128), "i"(B1 + 160), "i"(B1 + 192), "i"(B1 + 224)
        : "memory");
}
template <int S> __device__ __forceinline__ void pv_step(const f32x4& p0, const f32x4& p1, f32x4 (&o)[8], unsigned vb) {
    const v4u w = (v4u){pk2(p0[0], p0[1]), pk2(p0[2], p0[3]), pk2(p1[0], p1[1]), pk2(p1[2], p1[3])}; const bf16x8 pf = __builtin_bit_cast(bf16x8, w);
    s16x4 r[16]; tr_read16<32 * S * KV_STRIDE, (32 * S + 16) * KV_STRIDE>(r, vb);
#pragma unroll
    for (int dt = 0; dt < 8; ++dt) { const bf16x8 a = (bf16x8){r[dt][0], r[dt][1], r[dt][2], r[dt][3], r[8 + dt][0], r[8 + dt][1], r[8 + dt][2], r[8 + dt][3]}; o[dt] = mfma16(a, pf, o[dt]); }
}

__device__ __forceinline__ void p4_attn_items(Frame& F) {
    const bf16* Q = (const bf16*)(F.ws + WS_Q); const bf16* KM = (const bf16*)(F.ws + WS_KM); const bf16* VM = (const bf16*)(F.ws + WS_VM);
    const unsigned* cnt = (const unsigned*)(F.ctl + CW_CNT); const int* list = (const int*)(F.ws + WS_LIST);
    bf16* parto = (bf16*)(F.ws + WS_PARTO); float* partml = (float*)(F.ws + WS_PARTML);
    LAS int* pfx = (LAS int*)(F.lds + PFX_OFF);
    const int lane = F.lane, qi = lane & 15, g = lane >> 4, wv = F.wave;
    { LAS int* tmp = (LAS int*)(F.lds + PFX_OFF + 2560);
      const int c = (int)__hip_atomic_load(cnt + F.tid, RLX_AGENT); int val = ((c + 127) >> 7) + 2;
      __syncthreads();
      for (int d = 1; d < 512; d <<= 1) { tmp[F.tid] = val; __syncthreads(); if (F.tid >= d) val += tmp[F.tid - d]; __syncthreads(); }
      pfx[1 + F.tid] = val; if (F.tid == 0) pfx[0] = 0; }
    __syncthreads();
#define PFX(i) __builtin_amdgcn_readfirstlane(pfx[i])
    const int total = PFX(512);
    const int per = (total + F.G - 1) / F.G, lo = F.bid * per, hi = (lo + per < total) ? lo + per : total;
    if (lo >= hi) return;
    int u = 0; { int a = 0, b = 512; while (b - a > 1) { const int mid = (a + b) >> 1; if (PFX(mid) <= lo) a = mid; else b = mid; } u = a; }
    int loaded = -1;
    const float scale = 0.08838834764831845f;
#define P4_ENTRY(IT, UU, EN) do { const int it_ = (IT) < hi ? (IT) : hi - 1; while (it_ >= PFX(UU + 1)) ++UU; const int h_ = UU >> 6, j_ = UU & 63, tl_ = it_ - PFX(UU), ns_ = PFX(UU + 1) - PFX(UU) - 2; \
        if (tl_ >= ns_) EN = ((256 * j_ + 128 * (tl_ - ns_) + 16 * wv + qi) << 2) | 3; \
        else { const int n_ = (int)__hip_atomic_load(cnt + UU, RLX_AGENT); int e_ = tl_ * 128 + 16 * wv + qi; const bool ok_ = e_ < n_; if (!ok_) e_ = n_ - 1; const int en_ = list[list_off(h_, j_) + e_]; EN = ok_ ? en_ : (en_ | (int)0x80000000); } } while (0)
#define P4_QLOAD(QF, EN, UU) do { const int t_ = ((EN) & 0x7fffffff) >> 2; _Pragma("unroll") for (int ks = 0; ks < 4; ++ks) QF[ks] = *(const bf16x8*)(Q + (size_t)t_ * 1024 + 128 * ((UU) >> 6) + 32 * ks + 8 * g); } while (0)
    int u1 = u, u2 = u, en0, en1, en2 = 0; bf16x8 qf[4], qn[4];
    P4_ENTRY(lo, u, en0); u1 = u; P4_ENTRY(lo + 1, u1, en1); u2 = u1;
    P4_QLOAD(qf, en0, u);
    for (int it = lo; it < hi; ++it) {
        P4_QLOAD(qn, en1, u1);
        P4_ENTRY(it + 2, u2, en2);
        const int h = u >> 6, j = u & 63, tl = it - PFX(u), nsel = PFX(u + 1) - PFX(u) - 2;
        if (u != loaded) {
            __syncthreads();
#pragma unroll
            for (int i = 0; i < 8; ++i) { const int pz = F.tid + 512 * i, row = pz >> 4, cc = pz & 15;
                const v4u kv = *(const GAS v4u*)(KM + (size_t)(256 * j + row) * 1024 + 128 * h + 8 * cc); const v4u vv = *(const GAS v4u*)(VM + (size_t)(256 * j + row) * 1024 + 128 * h + 8 * cc);
                *(LAS v4u*)(F.lds + KLDS_OFF + row * KV_STRIDE + 16 * cc) = kv; *(LAS v4u*)(F.lds + VLDS_OFF + row * KV_STRIDE + 16 * cc) = vv; }
            __syncthreads();
            loaded = u;
        }
        const bool own = tl >= nsel; const int hf = tl - nsel;
        const int t = (en0 & 0x7fffffff) >> 2, slot = en0 & 3; const bool valid = en0 >= 0;
        const int nkt = own ? (8 * hf + wv + 1) : 16;
        f32x4 acc[16];
#pragma unroll
        for (int kt = 0; kt < 16; ++kt) { acc[kt] = (f32x4){0.f, 0.f, 0.f, 0.f};
            if (kt < nkt) {
#pragma unroll
                for (int ks = 0; ks < 4; ++ks) { const bf16x8 a = *(const LAS bf16x8*)(F.lds + KLDS_OFF + (16 * kt + qi) * KV_STRIDE + 64 * ks + 16 * g); acc[kt] = mfma16(a, qf[ks], acc[kt]); } } }
        const int tq = t - 256 * j;
        float m = -INFINITY;
#pragma unroll
        for (int kt = 0; kt < 16; ++kt)
#pragma unroll
            for (int r = 0; r < 4; ++r) { float s = acc[kt][r] * scale; const int key = 16 * kt + 4 * g + r; if (kt >= nkt || (own && key > tq)) s = -INFINITY; acc[kt][r] = s; m = fmaxf(m, s); }
        m = fmaxf(m, __shfl_xor(m, 16)); m = fmaxf(m, __shfl_xor(m, 32));
        float l = 0.f;
#pragma unroll
        for (int kt = 0; kt < 16; ++kt)
#pragma unroll
            for (int r = 0; r < 4; ++r) { const float p = __expf(acc[kt][r] - m); acc[kt][r] = p; l += p; }
        l += __shfl_xor(l, 16); l += __shfl_xor(l, 32);
        f32x4 o[8];
#pragma unroll
        for (int dt = 0; dt < 8; ++dt) o[dt] = (f32x4){0.f, 0.f, 0.f, 0.f};
        const unsigned vb0 = (unsigned)(VLDS_OFF + (4 * g + (qi >> 2)) * KV_STRIDE + 8 * (qi & 3)), vb1 = vb0 + 128u * KV_STRIDE;
        if (0 < nkt) pv_step<0>(acc[0], acc[1], o, vb0);
        if (2 < nkt) pv_step<1>(acc[2], acc[3], o, vb0);
        if (4 < nkt) pv_step<2>(acc[4], acc[5], o, vb0);
        if (6 < nkt) pv_step<3>(acc[6], acc[7], o, vb0);
        if (8 < nkt) pv_step<0>(acc[8], acc[9], o, vb1);
        if (10 < nkt) pv_step<1>(acc[10], acc[11], o, vb1);
        if (12 < nkt) pv_step<2>(acc[12], acc[13], o, vb1);
        if (14 < nkt) pv_step<3>(acc[14], acc[15], o, vb1);
        if (valid) { const float il = 1.f / l; const size_t pb = ((size_t)t * 8 + h) * 4 + slot;
#pragma unroll
            for (int dt = 0; dt < 8; ++dt) { v2u w; w.x = pk2(o[dt][0] * il, o[dt][1] * il); w.y = pk2(o[dt][2] * il, o[dt][3] * il); *(GAS v2u*)(parto + pb * 128 + 16 * dt + 4 * g) = w; }
            if (g == 0) { f32x2 ml; ml.x = m; ml.y = l; *(GAS f32x2*)(partml + pb * 2) = ml; } }
        en0 = en1; en1 = en2; u = u1; u1 = u2;
#pragma unroll
        for (int ks = 0; ks < 4; ++ks) qf[ks] = qn[ks];
    }
#undef P4_ENTRY
#undef P4_QLOAD
#undef PFX
}

__device__ __forceinline__ void p5_combine(Frame& F) {
    const bf16* parto = (const bf16*)(F.ws + WS_PARTO); const float* partml = (const float*)(F.ws + WS_PARTML); const bf16* GM = (const bf16*)(F.ws + WS_GM);
    bf16* mixed = (bf16*)(F.ws + WS_MIXED);
    const int gw = F.bid * NWAVES + F.wave, NGW = F.G * NWAVES, sub = F.lane >> 4, d0 = 8 * (F.lane & 15);
    for (int pq = gw; pq < T * MB_H / 4; pq += NGW) { const int pr = pq * 4 + sub, t = pr >> 3, h = pr & 7, cur = t >> 8, vc = cur < 3 ? cur : 3;
        float mm[4], ll[4]; float M = -INFINITY;
#pragma unroll
        for (int s = 0; s < 4; ++s) { const bool on = (s == 3) || (s < vc); f32x2 ml = (f32x2){-INFINITY, 0.f}; if (on) ml = *(const GAS f32x2*)(partml + ((size_t)pr * 4 + s) * 2); mm[s] = ml.x; ll[s] = ml.y; M = fmaxf(M, ml.x); }
        float acc[8]; float W = 0.f;
#pragma unroll
        for (int e = 0; e < 8; ++e) acc[e] = 0.f;
#pragma unroll
        for (int s = 0; s < 4; ++s) { const bool on = (s == 3) || (s < vc); if (on) { const float w = __expf(mm[s] - M) * ll[s]; W += w;
            const v4u ov = *(const GAS v4u*)(parto + ((size_t)pr * 4 + s) * 128 + d0);
            acc[0] += w * bflo(ov.x); acc[1] += w * bfhi(ov.x); acc[2] += w * bflo(ov.y); acc[3] += w * bfhi(ov.y); acc[4] += w * bflo(ov.z); acc[5] += w * bfhi(ov.z); acc[6] += w * bflo(ov.w); acc[7] += w * bfhi(ov.w); } }
        const float iw = 1.f / W;
        const v4u gv = *(const GAS v4u*)(GM + (size_t)t * 1024 + 128 * h + d0);
        const float gg[8] = {bflo(gv.x), bfhi(gv.x), bflo(gv.y), bfhi(gv.y), bflo(gv.z), bfhi(gv.z), bflo(gv.w), bfhi(gv.w)};
        float r[8];
#pragma unroll
        for (int e = 0; e < 8; ++e) r[e] = acc[e] * iw * gg[e] * sigmoidf_(gg[e]);
        v4u w; w.x = pk2(r[0], r[1]); w.y = pk2(r[2], r[3]); w.z = pk2(r[4], r[5]); w.w = pk2(r[6], r[7]);
        *(GAS v4u*)(mixed + (size_t)t * 2048 + 1024 + 128 * h + d0) = w;
    }
}

constexpr size_t WS_SR = 52 * MiB;
constexpr size_t WS_SA = 16 * MiB;
constexpr size_t WS_SK = 376 * MiB;
constexpr size_t WS_SV = 440 * MiB;
constexpr size_t WS_SB = WS_GM;
constexpr size_t WS_SW = WS_VM;
constexpr size_t WS_YS = WS_R;

__device__ __forceinline__ void p6_rwkv_prep(Frame& F) {
    const bf16* R = (const bf16*)(F.ws + WS_R); const bf16* K = (const bf16*)(F.ws + WS_K); const bf16* V = (const bf16*)(F.ws + WS_V); const bf16* WDAD = (const bf16*)(F.ws + WS_WDAD);
    float* SR = (float*)(F.ws + WS_SR); float* SK = (float*)(F.ws + WS_SK); float* SV = (float*)(F.ws + WS_SV);
    bf16* SA = (bf16*)(F.ws + WS_SA); bf16* SB = (bf16*)(F.ws + WS_SB); bf16* SW = (bf16*)(F.ws + WS_SW); float* BSC = (float*)(F.ws + WS_BSC);
    LAS float* WD = (LAS float*)(F.lds);
    LAS float* WI = (LAS float*)(F.lds + 16384);
    LAS float* Rs = (LAS float*)(F.lds + 32768);
    LAS float* Ks = (LAS float*)(F.lds + 49152);
    LAS float* TW = (LAS float*)(F.lds + 65536);
    LAS float* AD = (LAS float*)(F.lds + 81920);
    constexpr int NU = RW_H * (T / 64);
    const int upw = (NU + F.G - 1) / F.G;
    const int c = F.tid & 63, tg = F.tid >> 6;
    int hl_ = -1; float kkc = 0.f, kac = 0.f, rkc = 0.f, wb = 0.f, ib = 0.f;
    for (int ui = 0; ui < upw; ++ui) { const int u = F.bid * upw + ui; if (u >= NU) break; const int h = u / (T / 64), chunk = u % (T / 64), t0 = chunk * 64, ch = 64 * h + c;
        __syncthreads();
        if (h != hl_) { hl_ = h;
            for (int e = F.tid; e < 64 * 64; e += 512) { const int l = e >> 6, cc = e & 63; WD[e] = F.w_decay_up[(size_t)l * 1024 + 64 * h + cc]; WI[e] = F.w_iclr_up[(size_t)l * 1024 + 64 * h + cc]; }
            kkc = F.k_k[ch]; kac = F.k_a[ch]; rkc = F.r_k[ch]; wb = F.w_decay_bias[ch]; ib = F.w_iclr_bias[ch]; }
        { const int row = F.tid >> 3, cv = F.tid & 7, t = t0 + row; const size_t o = (size_t)t * 1024 + 64 * h + 8 * cv;
          const v4u z = (v4u){0u, 0u, 0u, 0u};
          const v4u rc = *(const GAS v4u*)(R + o), kc = *(const GAS v4u*)(K + o), vc = *(const GAS v4u*)(V + o);
          const v4u rp = t > 0 ? *(const GAS v4u*)(R + o - 1024) : z, kp = t > 0 ? *(const GAS v4u*)(K + o - 1024) : z, vp = t > 0 ? *(const GAS v4u*)(V + o - 1024) : z;
          const unsigned rcw[4] = {rc.x, rc.y, rc.z, rc.w}, rpw[4] = {rp.x, rp.y, rp.z, rp.w}, kcw[4] = {kc.x, kc.y, kc.z, kc.w}, kpw[4] = {kp.x, kp.y, kp.z, kp.w}, vcw[4] = {vc.x, vc.y, vc.z, vc.w}, vpw[4] = {vp.x, vp.y, vp.z, vp.w};
          float vs[8];
#pragma unroll
          for (int q = 0; q < 4; ++q) {
#pragma unroll
              for (int hl = 0; hl < 2; ++hl) { const int cc = 8 * cv + 2 * q + hl, chn = 64 * h + cc;
                  const float r0 = hl ? bfhi(rcw[q]) : bflo(rcw[q]), r1 = hl ? bfhi(rpw[q]) : bflo(rpw[q]);
                  const float k0 = hl ? bfhi(kcw[q]) : bflo(kcw[q]), k1 = hl ? bfhi(kpw[q]) : bflo(kpw[q]);
                  const float v0 = hl ? bfhi(vcw[q]) : bflo(vcw[q]), v1 = hl ? bfhi(vpw[q]) : bflo(vpw[q]);
                  Rs[row * 64 + cc] = r0 + F.mu_rkv[chn] * (r1 - r0); Ks[row * 64 + cc] = k0 + F.mu_rkv[1024 + chn] * (k1 - k0); vs[2 * q + hl] = v0 + F.mu_rkv[2048 + chn] * (v1 - v0); } }
          *(GAS f32x4*)(SV + o) = (f32x4){vs[0], vs[1], vs[2], vs[3]}; *(GAS f32x4*)(SV + o + 4) = (f32x4){vs[4], vs[5], vs[6], vs[7]};
#pragma unroll
          for (int part = 0; part < 2; ++part) { const int lv = 8 * cv + 64 * part;
              const v4u wc4 = *(const GAS v4u*)(WDAD + (size_t)t * 128 + lv); const v4u wp4 = t > 0 ? *(const GAS v4u*)(WDAD + (size_t)(t - 1) * 128 + lv) : z;
              const unsigned cw[4] = {wc4.x, wc4.y, wc4.z, wc4.w}, pw[4] = {wp4.x, wp4.y, wp4.z, wp4.w};
#pragma unroll
              for (int q = 0; q < 4; ++q)
#pragma unroll
                  for (int hl = 0; hl < 2; ++hl) { const int l = 8 * cv + 2 * q + hl; const float x0 = hl ? bfhi(cw[q]) : bflo(cw[q]), x1 = hl ? bfhi(pw[q]) : bflo(pw[q]);
                      const float xs = x0 + F.mu_lora[64 * part + l] * (x1 - x0);
                      if (part == 0) TW[row * 64 + l] = tanhf(xs); else AD[row * 64 + l] = xs; } } }
        __syncthreads();
        float aw[8], ai[8];
#pragma unroll
        for (int r = 0; r < 8; ++r) { aw[r] = 0.f; ai[r] = 0.f; }
        for (int l4 = 0; l4 < 16; ++l4) {
            const float wd0 = WD[(4 * l4 + 0) * 64 + c], wd1 = WD[(4 * l4 + 1) * 64 + c], wd2 = WD[(4 * l4 + 2) * 64 + c], wd3 = WD[(4 * l4 + 3) * 64 + c];
            const float wi0 = WI[(4 * l4 + 0) * 64 + c], wi1 = WI[(4 * l4 + 1) * 64 + c], wi2 = WI[(4 * l4 + 2) * 64 + c], wi3 = WI[(4 * l4 + 3) * 64 + c];
#pragma unroll
            for (int r = 0; r < 8; ++r) { const f32x4 tw = *(const LAS f32x4*)(TW + (8 * tg + r) * 64 + 4 * l4); const f32x4 ad = *(const LAS f32x4*)(AD + (8 * tg + r) * 64 + 4 * l4);
                aw[r] += tw.x * wd0 + tw.y * wd1 + tw.z * wd2 + tw.w * wd3; ai[r] += ad.x * wi0 + ad.y * wi1 + ad.z * wi2 + ad.w * wi3; }
        }
#pragma unroll
        for (int r = 0; r < 8; ++r) { const int row = 8 * tg + r, t = t0 + row; const size_t o = (size_t)t * 1024 + ch;
            const float lw = -0.6065306597126334f * sigmoidf_(wb + aw[r]);
            const float ic = sigmoidf_(ib + ai[r]);
            const float kr = Ks[row * 64 + c], rr = Rs[row * 64 + c];
            const float kk = kr * kkc; const float nrm = sqrtf(wave_sum(kk * kk)); const float kkn = kk / fmaxf(nrm, 1e-12f);
            const float kp = kr * (1.f + (ic - 1.f) * kac);
            const float bs = wave_sum(rr * kp * rkc);
            SR[o] = rr; SK[o] = kp; SA[o] = (bf16)f2bf(-kkn); SB[o] = (bf16)f2bf(kkn * ic); SW[o] = (bf16)f2bf(lw);
            if (c == 0) BSC[(size_t)t * 16 + h] = bs; }
    }
}

__device__ __forceinline__ float dpp_add16(float x) {
    x += __builtin_bit_cast(float, __builtin_amdgcn_update_dpp(0, __builtin_bit_cast(int, x), 0xB1, 0xf, 0xf, false));
    x += __builtin_bit_cast(float, __builtin_amdgcn_update_dpp(0, __builtin_bit_cast(int, x), 0x4E, 0xf, 0xf, false));
    x += __builtin_bit_cast(float, __builtin_amdgcn_update_dpp(0, __builtin_bit_cast(int, x), 0x141, 0xf, 0xf, false));
    x += __builtin_bit_cast(float, __builtin_amdgcn_update_dpp(0, __builtin_bit_cast(int, x), 0x140, 0xf, 0xf, false));
    return x;
}
constexpr int SC_CH = 64;
__device__ __forceinline__ void p7_rwkv_scan(Frame& F) {
    if (F.bid >= 32) return;
    const float* SR = (const float*)(F.ws + WS_SR); const float* SK = (const float*)(F.ws + WS_SK); const float* SV = (const float*)(F.ws + WS_SV);
    const bf16* SA = (const bf16*)(F.ws + WS_SA); const bf16* SB = (const bf16*)(F.ws + WS_SB); const bf16* SW = (const bf16*)(F.ws + WS_SW); float* Y = (float*)(F.ws + WS_YS);
    const int h = F.bid >> 1, i0 = 32 * (F.bid & 1);
    LAS float* Lr = (LAS float*)(F.lds);
    LAS float* Lk = (LAS float*)(F.lds + 16384);
    LAS float* La = (LAS float*)(F.lds + 32768);
    LAS float* Lb = (LAS float*)(F.lds + 49152);
    LAS float* Lw = (LAS float*)(F.lds + 65536);
    LAS float* Lv = (LAS float*)(F.lds + 81920);
    const int jg = F.lane & 15, rl = 4 * F.wave + (F.lane >> 4);
    f32x4 st = (f32x4){0.f, 0.f, 0.f, 0.f};
    const int srow = F.tid >> 3, scv = F.tid & 7;
    for (int t0 = 0; t0 < T; t0 += SC_CH) {
        __syncthreads();
        { const size_t o = (size_t)(t0 + srow) * 1024 + 64 * h + 8 * scv;
          const f32x4 r0 = *(const GAS f32x4*)(SR + o), r1 = *(const GAS f32x4*)(SR + o + 4), k0 = *(const GAS f32x4*)(SK + o), k1 = *(const GAS f32x4*)(SK + o + 4);
          const v4u a4 = *(const GAS v4u*)(SA + o), b4 = *(const GAS v4u*)(SB + o), w4 = *(const GAS v4u*)(SW + o);
          const f32x4 vv = *(const GAS f32x4*)(SV + (size_t)(t0 + srow) * 1024 + 64 * h + i0 + 4 * scv);
          LAS float* d = Lr + srow * 64 + 8 * scv; *(LAS f32x4*)d = r0; *(LAS f32x4*)(d + 4) = r1;
          d = Lk + srow * 64 + 8 * scv; *(LAS f32x4*)d = k0; *(LAS f32x4*)(d + 4) = k1;
          d = La + srow * 64 + 8 * scv; *(LAS f32x4*)d = (f32x4){bflo(a4.x), bfhi(a4.x), bflo(a4.y), bfhi(a4.y)}; *(LAS f32x4*)(d + 4) = (f32x4){bflo(a4.z), bfhi(a4.z), bflo(a4.w), bfhi(a4.w)};
          d = Lb + srow * 64 + 8 * scv; *(LAS f32x4*)d = (f32x4){bflo(b4.x), bfhi(b4.x), bflo(b4.y), bfhi(b4.y)}; *(LAS f32x4*)(d + 4) = (f32x4){bflo(b4.z), bfhi(b4.z), bflo(b4.w), bfhi(b4.w)};
          d = Lw + srow * 64 + 8 * scv; *(LAS f32x4*)d = (f32x4){__expf(bflo(w4.x)), __expf(bfhi(w4.x)), __expf(bflo(w4.y)), __expf(bfhi(w4.y))}; *(LAS f32x4*)(d + 4) = (f32x4){__expf(bflo(w4.z)), __expf(bfhi(w4.z)), __expf(bflo(w4.w)), __expf(bfhi(w4.w))};
          *(LAS f32x4*)(Lv + srow * 32 + 4 * scv) = vv; }
        __syncthreads();
#pragma unroll 2
        for (int s = 0; s < SC_CH; ++s) {
            const f32x4 a = *(const LAS f32x4*)(La + s * 64 + 4 * jg), b = *(const LAS f32x4*)(Lb + s * 64 + 4 * jg), w = *(const LAS f32x4*)(Lw + s * 64 + 4 * jg);
            const f32x4 k = *(const LAS f32x4*)(Lk + s * 64 + 4 * jg), r = *(const LAS f32x4*)(Lr + s * 64 + 4 * jg); const float vi = Lv[s * 32 + rl];
            const float sa = dpp_add16((st.x * a.x + st.y * a.y) + (st.z * a.z + st.w * a.w));
            st = st * w + (b * sa + k * vi);
            const float y = dpp_add16((st.x * r.x + st.y * r.y) + (st.z * r.z + st.w * r.w));
            if (jg == 0) Y[(size_t)(t0 + s) * 1024 + 64 * h + i0 + rl] = y;
        }
    }
}

__device__ __forceinline__ void p8_rwkv_final(Frame& F) {
    const float* Y = (const float*)(F.ws + WS_YS); const float* SV = (const float*)(F.ws + WS_SV); const float* BSC = (const float*)(F.ws + WS_BSC); const bf16* GR = (const bf16*)(F.ws + WS_GR);
    bf16* mixed = (bf16*)(F.ws + WS_MIXED);
    const int gw = F.bid * NWAVES + F.wave, NGW = F.G * NWAVES, c0 = 16 * F.lane, hd = F.lane >> 2;
    for (int t = gw; t < T; t += NGW) {
        float y[16]; float s = 0.f;
#pragma unroll
        for (int q = 0; q < 4; ++q) { const f32x4 v = *(const GAS f32x4*)(Y + (size_t)t * 1024 + c0 + 4 * q); y[4 * q] = v.x; y[4 * q + 1] = v.y; y[4 * q + 2] = v.z; y[4 * q + 3] = v.w; s += (v.x + v.y) + (v.z + v.w); }
        s += __shfl_xor(s, 1); s += __shfl_xor(s, 2);
        const float mean = s * (1.f / 64.f); float q2 = 0.f;
#pragma unroll
        for (int e = 0; e < 16; ++e) { y[e] -= mean; q2 += y[e] * y[e]; }
        q2 += __shfl_xor(q2, 1); q2 += __shfl_xor(q2, 2);
        const float rstd = 1.f / sqrtf(q2 * (1.f / 64.f) + LNX_EPS);
        const float bs = BSC[(size_t)t * 16 + hd];
        const v4u g0 = *(const GAS v4u*)(GR + (size_t)t * 1024 + c0), g1 = *(const GAS v4u*)(GR + (size_t)t * 1024 + c0 + 8);
        const float gg[16] = {bflo(g0.x), bfhi(g0.x), bflo(g0.y), bfhi(g0.y), bflo(g0.z), bfhi(g0.z), bflo(g0.w), bfhi(g0.w), bflo(g1.x), bfhi(g1.x), bflo(g1.y), bfhi(g1.y), bflo(g1.z), bfhi(g1.z), bflo(g1.w), bfhi(g1.w)};
        float r[16];
#pragma unroll
        for (int q = 0; q < 4; ++q) { const f32x4 v = *(const GAS f32x4*)(SV + (size_t)t * 1024 + c0 + 4 * q); const f32x4 lw = *(const GAS f32x4*)(F.lnx_w + c0 + 4 * q), lb = *(const GAS f32x4*)(F.lnx_b + c0 + 4 * q);
            const float vv[4] = {v.x, v.y, v.z, v.w}, lww[4] = {lw.x, lw.y, lw.z, lw.w}, lbb[4] = {lb.x, lb.y, lb.z, lb.w};
#pragma unroll
            for (int e = 0; e < 4; ++e) { const int i = 4 * q + e; const float o = y[i] * rstd * lww[e] + lbb[e] + bs * vv[e]; r[i] = o * gg[i] * sigmoidf_(gg[i]); } }
        v4u w0, w1; w0.x = pk2(r[0], r[1]); w0.y = pk2(r[2], r[3]); w0.z = pk2(r[4], r[5]); w0.w = pk2(r[6], r[7]); w1.x = pk2(r[8], r[9]); w1.y = pk2(r[10], r[11]); w1.z = pk2(r[12], r[13]); w1.w = pk2(r[14], r[15]);
        *(GAS v4u*)(mixed + (size_t)t * 2048 + c0) = w0; *(GAS v4u*)(mixed + (size_t)t * 2048 + c0 + 8) = w1;
    }
}

constexpr size_t WS_WDT = 1 * MiB + 512 * 1024;
constexpr size_t WS_WIT = 1 * MiB + 640 * 1024;
constexpr size_t WS_PB = 16 * MiB;
constexpr size_t WS_QC = 52 * MiB;
constexpr size_t WS_HT = 84 * MiB;
constexpr size_t WS_GT = 376 * MiB;
constexpr size_t WS_Y0T = 440 * MiB;
constexpr int IMS = 144;
constexpr int L_AT = 0, L_RT = 9216, L_BT = 18432, L_KT = 27648, L_BHT = 36864, L_KHT = 46080, L_VT = 55296, L_XT = 64512;
constexpr int L_RA = 82944;
constexpr int L_TW = L_RA, L_AD = L_RA + 9216, L_WP = L_RA + 18432, L_AP = L_WP + 16640;
constexpr int L_LAB = L_RA, L_LAK = L_RA + 17408, L_MRB = L_LAK + 9216, L_MRK = L_MRB + 9216, L_TII = L_MRK + 9216;
constexpr int L_CUMP = 134656, L_GC = L_CUMP + 2048;
constexpr int L_PAR = 137216;

__device__ __forceinline__ f32x4 mfma4f(float a, float b, f32x4 c) { return __builtin_amdgcn_mfma_f32_16x16x4f32(a, b, c, 0, 0, 0); }
__device__ __forceinline__ bf16x8 lds_frag(LAS unsigned char* img, int row, int ks, int g) { return *(const LAS bf16x8*)(img + row * IMS + 64 * ks + 16 * g); }

__device__ __forceinline__ float wave_sum_dpp(float x) {
    x = dpp_add16(x);
    x += __builtin_bit_cast(float, __builtin_amdgcn_update_dpp(0, __builtin_bit_cast(int, x), 0x142, 0xa, 0xf, false));
    x += __builtin_bit_cast(float, __builtin_amdgcn_update_dpp(0, __builtin_bit_cast(int, x), 0x143, 0xc, 0xf, false));
    return __builtin_bit_cast(float, __builtin_amdgcn_readlane(__builtin_bit_cast(int, x), 63));
}
struct R1In { v4u wd0, wd1, wp0, wp1, rc, rp, kc, kp, vc, vp; };
__device__ __forceinline__ void r1_load(Frame& F, int h, int chunk, R1In& in) {
    const bf16* R = (const bf16*)(F.ws + WS_R); const bf16* K = (const bf16*)(F.ws + WS_K); const bf16* V = (const bf16*)(F.ws + WS_V); const bf16* WDAD = (const bf16*)(F.ws + WS_WDAD);
    const int row = F.tid >> 3, cv = F.tid & 7, t = chunk * 64 + row; const size_t o = (size_t)t * 1024 + 64 * h + 8 * cv; const v4u z4 = (v4u){0u, 0u, 0u, 0u};
    in.wd0 = *(const GAS v4u*)(WDAD + (size_t)t * 128 + 8 * cv); in.wd1 = *(const GAS v4u*)(WDAD + (size_t)t * 128 + 64 + 8 * cv);
    in.rc = *(const GAS v4u*)(R + o); in.kc = *(const GAS v4u*)(K + o); in.vc = *(const GAS v4u*)(V + o);
    if (t > 0) { in.wp0 = *(const GAS v4u*)(WDAD + (size_t)(t - 1) * 128 + 8 * cv); in.wp1 = *(const GAS v4u*)(WDAD + (size_t)(t - 1) * 128 + 64 + 8 * cv);
        in.rp = *(const GAS v4u*)(R + o - 1024); in.kp = *(const GAS v4u*)(K + o - 1024); in.vp = *(const GAS v4u*)(V + o - 1024); }
    else { in.wp0 = z4; in.wp1 = z4; in.rp = z4; in.kp = z4; in.vp = z4; }
}
constexpr int L_RS = L_AT, L_KS = L_BT, L_VS = L_BHT;

__device__ __forceinline__ void r1_unit(Frame& F, int h, int chunk, R1In& in, const bf16x8 (&wfr)[2][2][2], int un) {
    float* BSC = (float*)(F.ws + WS_BSC);
    LAS unsigned char* L = F.lds; const LAS float* PAR = (const LAS float*)(L + L_PAR);
    int tid = F.tid; asm volatile("" : "+v"(tid));
    const int t0 = chunk * 64, u = h * 256 + chunk, lane = tid & 63, wv = __builtin_amdgcn_readfirstlane(tid >> 6), fr = lane & 15, g = lane >> 4;
    __syncthreads();
    { const int row = tid >> 3, cv = tid & 7;
#pragma unroll
      for (int part = 0; part < 2; ++part) { const v4u wc4 = part ? in.wd1 : in.wd0, wp4 = part ? in.wp1 : in.wp0;
          const unsigned cw[4] = {wc4.x, wc4.y, wc4.z, wc4.w}, pw[4] = {wp4.x, wp4.y, wp4.z, wp4.w}; unsigned ow[4];
#pragma unroll
          for (int q = 0; q < 4; ++q) { float xs[2];
#pragma unroll
              for (int hl = 0; hl < 2; ++hl) { const int l = 8 * cv + 2 * q + hl; const float x0 = hl ? bfhi(cw[q]) : bflo(cw[q]), x1 = hl ? bfhi(pw[q]) : bflo(pw[q]);
                  xs[hl] = x0 + PAR[192 + 64 * part + l] * (x1 - x0); if (part == 0) { const float e2 = __expf(2.f * xs[hl]); xs[hl] = 1.f - 2.f / (e2 + 1.f); } }
              ow[q] = pk2(xs[0], xs[1]); }
          *(LAS v4u*)(L + (part == 0 ? L_TW : L_AD) + row * IMS + 16 * cv) = (v4u){ow[0], ow[1], ow[2], ow[3]}; }
      const unsigned rcw[4] = {in.rc.x, in.rc.y, in.rc.z, in.rc.w}, rpw[4] = {in.rp.x, in.rp.y, in.rp.z, in.rp.w}, kcw[4] = {in.kc.x, in.kc.y, in.kc.z, in.kc.w}, kpw[4] = {in.kp.x, in.kp.y, in.kp.z, in.kp.w},
                     vcw[4] = {in.vc.x, in.vc.y, in.vc.z, in.vc.w}, vpw[4] = {in.vp.x, in.vp.y, in.vp.z, in.vp.w};
#pragma unroll
      for (int q = 0; q < 4; ++q)
#pragma unroll
          for (int hl = 0; hl < 2; ++hl) { const int cc = 8 * cv + 2 * q + hl;
              const float r0 = hl ? bfhi(rcw[q]) : bflo(rcw[q]), r1 = hl ? bfhi(rpw[q]) : bflo(rpw[q]), k0 = hl ? bfhi(kcw[q]) : bflo(kcw[q]), k1 = hl ? bfhi(kpw[q]) : bflo(kpw[q]);
              const float v0 = hl ? bfhi(vcw[q]) : bflo(vcw[q]), v1 = hl ? bfhi(vpw[q]) : bflo(vpw[q]);
              ((LAS float*)(L + L_RS))[row * 65 + cc] = r0 + PAR[cc] * (r1 - r0); ((LAS float*)(L + L_KS))[row * 65 + cc] = k0 + PAR[64 + cc] * (k1 - k0);
              ((LAS float*)(L + L_VS))[row * 65 + cc] = v0 + PAR[128 + cc] * (v1 - v0); } }
    if (un >= 0) r1_load(F, un >> 8, un & 255, in);
    __syncthreads();
    { const int tr = wv >> 1;
#pragma unroll
      for (int prod = 0; prod < 2; ++prod) { LAS unsigned char* aimg = L + (prod == 0 ? L_TW : L_AD); LAS float* o = (LAS float*)(L + (prod == 0 ? L_WP : L_AP));
#pragma unroll
          for (int cc = 0; cc < 2; ++cc) { const int ct = (wv & 1) * 2 + cc; f32x4 acc = (f32x4){0.f, 0.f, 0.f, 0.f};
#pragma unroll
              for (int ks = 0; ks < 2; ++ks) acc = mfma16(lds_frag(aimg, 16 * tr + fr, ks, g), wfr[prod][cc][ks], acc);
#pragma unroll
              for (int r = 0; r < 4; ++r) o[(16 * tr + 4 * g + r) * 65 + 16 * ct + fr] = acc[r]; } } }
    __syncthreads();
    { const int c = tid & 63, tg = tid >> 6, ch = 64 * h + c;
      const float kkc = PAR[320 + c], kac = PAR[384 + c], rkc = PAR[448 + c], wb = PAR[512 + c], ib = PAR[576 + c];
      const LAS float* WP = (const LAS float*)(L + L_WP); const LAS float* AP = (const LAS float*)(L + L_AP); LAS float* CUMP = (LAS float*)(L + L_CUMP);
      float rr[8], kr[8], vv[8], lw[8], ic[8];
      float ps = 0.f;
#pragma unroll
      for (int r = 0; r < 8; ++r) { const int row = 8 * tg + r; rr[r] = ((const LAS float*)(L + L_RS))[row * 65 + c]; kr[r] = ((const LAS float*)(L + L_KS))[row * 65 + c]; vv[r] = ((const LAS float*)(L + L_VS))[row * 65 + c];
          lw[r] = -0.6065306597126334f * sigmoidf_(wb + WP[row * 65 + c]); ic[r] = sigmoidf_(ib + AP[row * 65 + c]); ps += lw[r]; }
      CUMP[tg * 64 + c] = ps;
      __syncthreads();
      float off = 0.f, tot = 0.f;
#pragma unroll
      for (int q = 0; q < 8; ++q) { const float p = CUMP[q * 64 + c]; tot += p; if (q < tg) off += p; }
      if (tg == 0) ((LAS float*)(L + L_GC))[c] = __expf(tot);
      float av[8], rv[8], bv[8], kv[8], bhv[8], khv[8]; float cum = off;
#pragma unroll
      for (int r = 0; r < 8; ++r) { const int t = t0 + 8 * tg + r;
          const float gprev = __expf(cum); cum += lw[r]; const float gam = __expf(cum), ig = __expf(-cum), gh = __expf(tot - cum);
          const float kk = kr[r] * kkc; const float kkn = kk * __builtin_amdgcn_rsqf(fmaxf(wave_sum_dpp(kk * kk), 1e-24f));
          const float kpm = kr[r] * (1.f + (ic[r] - 1.f) * kac); const float bs = wave_sum_dpp(rr[r] * kpm * rkc);
          if (c == 0) BSC[(size_t)t * 16 + h] = bs;
          const float bq = kkn * ic[r];
          av[r] = -kkn * gprev; rv[r] = rr[r] * gam; bv[r] = bq * ig; kv[r] = kpm * ig; bhv[r] = bq * gh; khv[r] = kpm * gh; }
#define R1_PUT(OFF, A) *(LAS v4u*)(L + (OFF) + c * IMS + 16 * tg) = (v4u){pk2(A[0], A[1]), pk2(A[2], A[3]), pk2(A[4], A[5]), pk2(A[6], A[7])}
      R1_PUT(L_AT, av); R1_PUT(L_RT, rv); R1_PUT(L_BT, bv); R1_PUT(L_KT, kv); R1_PUT(L_BHT, bhv); R1_PUT(L_KHT, khv); R1_PUT(L_VT, vv);
#undef R1_PUT
    }
    __syncthreads();
    { const int prod = wv >> 1; const unsigned ximg = (unsigned)((prod < 2) ? L_AT : L_RT), yimg = (unsigned)((prod & 1) ? L_KT : L_BT);
      const unsigned trb = (unsigned)((8 * g + (fr >> 2)) * IMS + 8 * (fr & 3));
#pragma unroll
      for (int q = 0; q < 8; ++q) { const int tl = 8 * (wv & 1) + q, ti = tl >> 2, si = tl & 3; f32x4 acc = (f32x4){0.f, 0.f, 0.f, 0.f};
          if (si <= ti) {
#pragma unroll
              for (int ks = 0; ks < 2; ++ks) { s16x4 y0, y1, x0, x1;
                  tr_read2(y0, y1, yimg + trb + (unsigned)(32 * ks * IMS + 32 * si), yimg + trb + (unsigned)((32 * ks + 4) * IMS + 32 * si));
                  tr_read2(x0, x1, ximg + trb + (unsigned)(32 * ks * IMS + 32 * ti), ximg + trb + (unsigned)((32 * ks + 4) * IMS + 32 * ti));
                  acc = mfma16((bf16x8){y0[0], y0[1], y0[2], y0[3], y1[0], y1[1], y1[2], y1[3]}, (bf16x8){x0[0], x0[1], x0[2], x0[3], x1[0], x1[1], x1[2], x1[3]}, acc); } }
          const int t = 16 * ti + fr, s0 = 16 * si + 4 * g;
#pragma unroll
          for (int r = 0; r < 4; ++r) { const bool keep = (prod < 2) ? (s0 + r < t) : (s0 + r <= t); acc[r] = keep ? acc[r] : 0.f; }
          if (prod == 0) *(LAS f32x4*)(L + L_LAB + (t * 68 + s0) * 4) = acc;
          else *(LAS v2u*)(L + (prod == 1 ? L_LAK : prod == 2 ? L_MRB : L_MRK) + t * IMS + 2 * s0) = (v2u){pk2(acc[0], acc[1]), pk2(acc[2], acc[3])}; } }
    __syncthreads();
    f32x4 x[4];
    if (wv < 4) {
#pragma unroll
        for (int bi = 0; bi < 4; ++bi) { const v2u w = *(const LAS v2u*)(L + L_AT + (16 * wv + fr) * IMS + 2 * (16 * bi + 4 * g)); x[bi] = (f32x4){bflo(w.x), bfhi(w.x), bflo(w.y), bfhi(w.y)}; }
    } else {
#pragma unroll
        for (int bi = 0; bi < 4; ++bi) { x[bi] = (f32x4){0.f, 0.f, 0.f, 0.f};
#pragma unroll
            for (int ks = 0; ks < 2; ++ks) x[bi] = mfma16(lds_frag(L + L_LAK, 16 * bi + fr, ks, g), lds_frag(L + L_VT, 16 * (wv - 4) + fr, ks, g), x[bi]); }
    }
    if (wv == 0) { const int bi = g, c = fr; const LAS float* Lb = (const LAS float*)(L + L_LAB) + (16 * bi) * 68 + 16 * bi; LAS float* Tb = (LAS float*)(L + L_TII) + bi * 320;
        float xc[16];
#pragma unroll
        for (int r = 0; r < 16; ++r) { float s0 = (r == c) ? 1.f : 0.f, s1 = 0.f, s2 = 0.f, s3 = 0.f;
#pragma unroll
            for (int q = 0; q < r; ++q) { const float p = Lb[r * 68 + q] * xc[q]; if ((q & 3) == 0) s0 += p; else if ((q & 3) == 1) s1 += p; else if ((q & 3) == 2) s2 += p; else s3 += p; }
            const float s = (s0 + s1) + (s2 + s3); xc[r] = s; Tb[r * 20 + c] = s; } }
    __syncthreads();
    { const LAS float* Lab = (const LAS float*)(L + L_LAB); const LAS float* Tii = (const LAS float*)(L + L_TII);
#pragma unroll
      for (int bi = 0; bi < 4; ++bi) { f32x4 acc = x[bi];
#pragma unroll
          for (int bj = 0; bj < 4; ++bj) { if (bj < bi) { const f32x4 a = *(const LAS f32x4*)(Lab + (16 * bi + fr) * 68 + 16 * bj + 4 * g);
#pragma unroll
              for (int kk = 0; kk < 4; ++kk) acc = mfma4f(a[kk], x[bj][kk], acc); } }
          const f32x4 tq = *(const LAS f32x4*)(Tii + bi * 320 + fr * 20 + 4 * g); f32x4 xo = (f32x4){0.f, 0.f, 0.f, 0.f};
#pragma unroll
          for (int kk = 0; kk < 4; ++kk) xo = mfma4f(tq[kk], acc[kk], xo);
          x[bi] = xo;
          *(LAS v2u*)(L + L_XT + (16 * wv + fr) * IMS + 2 * (16 * bi + 4 * g)) = (v2u){pk2(xo[0], xo[1]), pk2(xo[2], xo[3])}; } }
    __syncthreads();
    { bf16* PB = (bf16*)(F.ws + WS_PB) + (size_t)u * 4096; bf16* QC = (bf16*)(F.ws + WS_QC) + (size_t)u * 4096; float* GT = (float*)(F.ws + WS_GT) + (size_t)u * 4096; bf16* Y0 = (bf16*)(F.ws + WS_Y0T) + (size_t)u * 4096;
      const LAS float* GC = (const LAS float*)(L + L_GC);
#pragma unroll
      for (int q = 0; q < 2; ++q) { const int tl = 2 * wv + q, ra = tl >> 2, cb = tl & 3;
          { f32x4 acc = (f32x4){0.f, 0.f, 0.f, 0.f};
#pragma unroll
            for (int ks = 0; ks < 2; ++ks) acc = mfma16(lds_frag(L + L_XT, 16 * ra + fr, ks, g), lds_frag(L + L_MRB, 16 * cb + fr, ks, g), acc);
            const int t = 16 * cb + fr, j0 = 16 * ra + 4 * g;
#pragma unroll
            for (int r = 0; r < 4; ++r) acc[r] += bf2f(*(const LAS bf16*)(L + L_RT + (j0 + r) * IMS + 2 * t));
            *(GAS v2u*)(QC + (size_t)t * 64 + j0) = (v2u){pk2(acc[0], acc[1]), pk2(acc[2], acc[3])}; }
          { f32x4 acc = (f32x4){0.f, 0.f, 0.f, 0.f};
#pragma unroll
            for (int ks = 0; ks < 2; ++ks) { acc = mfma16(lds_frag(L + L_XT, 64 + 16 * ra + fr, ks, g), lds_frag(L + L_MRB, 16 * cb + fr, ks, g), acc); acc = mfma16(lds_frag(L + L_VT, 16 * ra + fr, ks, g), lds_frag(L + L_MRK, 16 * cb + fr, ks, g), acc); }
            *(GAS v2u*)(Y0 + (size_t)(16 * cb + fr) * 64 + 16 * ra + 4 * g) = (v2u){pk2(acc[0], acc[1]), pk2(acc[2], acc[3])}; }
          { f32x4 acc = (f32x4){0.f, 0.f, 0.f, 0.f};
#pragma unroll
            for (int ks = 0; ks < 2; ++ks) acc = mfma16(lds_frag(L + L_XT, 16 * ra + fr, ks, g), lds_frag(L + L_BHT, 16 * cb + fr, ks, g), acc);
            const int jp = 16 * cb + fr;
#pragma unroll
            for (int r = 0; r < 4; ++r) if (16 * ra + 4 * g + r == jp) acc[r] += GC[jp];
            *(GAS v2u*)(PB + (size_t)jp * 64 + 32 * (ra >> 1) + 8 * g + 4 * (ra & 1)) = (v2u){pk2(acc[0], acc[1]), pk2(acc[2], acc[3])}; }
          { f32x4 acc = (f32x4){0.f, 0.f, 0.f, 0.f};
#pragma unroll
            for (int ks = 0; ks < 2; ++ks) { acc = mfma16(lds_frag(L + L_BHT, 16 * ra + fr, ks, g), lds_frag(L + L_XT, 64 + 16 * cb + fr, ks, g), acc); acc = mfma16(lds_frag(L + L_KHT, 16 * ra + fr, ks, g), lds_frag(L + L_VT, 16 * cb + fr, ks, g), acc); }
            *(GAS f32x4*)(GT + (size_t)(16 * cb + fr) * 64 + 16 * ra + 4 * g) = acc; } } }
}

__device__ __forceinline__ void r1_chunk_local(Frame& F) {
    constexpr int NU = RW_H * (T / 64);
    const int upw = (NU + F.G - 1) / F.G;
    const int u0 = F.bid * upw; if (u0 >= NU) return;
    const bf16* WDT = (const bf16*)(F.ws + WS_WDT); const bf16* WIT = (const bf16*)(F.ws + WS_WIT);
    const int fr = F.lane & 15, g = F.lane >> 4;
    R1In in; r1_load(F, u0 >> 8, u0 & 255, in);
    bf16x8 wfr[2][2][2]; int hw = -1;
    for (int ui = 0; ui < upw; ++ui) { const int u = u0 + ui; if (u >= NU) break; const int h = u >> 8;
        if (h != hw) { hw = h;
            __syncthreads();
            { LAS float* PARW = (LAS float*)(F.lds + L_PAR); const int e = F.tid, c = e & 63, ch = 64 * h + c; float v = 0.f;
              if (e < 64) v = F.mu_rkv[ch]; else if (e < 128) v = F.mu_rkv[1024 + ch]; else if (e < 192) v = F.mu_rkv[2048 + ch]; else if (e < 320) v = F.mu_lora[e - 192];
              else if (e < 384) v = F.k_k[ch]; else if (e < 448) v = F.k_a[ch]; else v = F.r_k[ch];
              PARW[e] = v;
              if (e < 64) PARW[512 + e] = F.w_decay_bias[ch]; else if (e < 128) PARW[512 + e] = F.w_iclr_bias[ch]; }
#pragma unroll
            for (int prod = 0; prod < 2; ++prod)
#pragma unroll
                for (int cc = 0; cc < 2; ++cc)
#pragma unroll
                    for (int ks = 0; ks < 2; ++ks) wfr[prod][cc][ks] = *(const bf16x8*)((prod ? WIT : WDT) + (size_t)(64 * h + 16 * ((F.wave & 1) * 2 + cc) + fr) * 64 + 32 * ks + 8 * g); }
        r1_unit(F, h, u & 255, in, wfr, (ui + 1 < upw && u + 1 < NU) ? u + 1 : -1); }
}

constexpr int R2_SLOT = 12288, R2_D = 8, R2_NS = 10;
__device__ __forceinline__ void r2_recurrence(Frame& F) {
    if (F.bid >= 64) return;
    const int h = 2 * (F.bid & 7) + (F.bid >> 5), cg = (F.bid >> 3) & 3, lane = F.lane, fr = lane & 15, g = lane >> 4, wv = F.wave;
    const bf16* PB = (const bf16*)(F.ws + WS_PB) + (size_t)h * 256 * 4096; const float* GT = (const float*)(F.ws + WS_GT) + (size_t)h * 256 * 4096 + (size_t)(16 * cg) * 64;
    bf16* HT = (bf16*)(F.ws + WS_HT) + (size_t)h * 256 * 4096 + (size_t)(16 * cg) * 64;
    LAS unsigned char* L = F.lds;
#define R2_BAR() do { asm volatile("" ::: "memory"); __builtin_amdgcn_s_barrier(); asm volatile("" ::: "memory"); } while (0)
    __syncthreads();
    if (wv == 0) {
#define R2_FRAGS(step, PF, GF) do { const LAS unsigned char* sl_ = L + ((step) % R2_NS) * R2_SLOT; _Pragma("unroll") for (int rt = 0; rt < 4; ++rt) { GF[rt] = *(const LAS f32x4*)(sl_ + 8192 + (fr * 64 + 16 * rt + 4 * g) * 4); \
        _Pragma("unroll") for (int ks = 0; ks < 2; ++ks) PF[rt][ks] = *(const LAS bf16x8*)(sl_ + ((16 * rt + fr) * 64 + 32 * ks + 8 * g) * 2); } } while (0)
#define R2_STEP(PF, GF) do { \
        _Pragma("unroll") for (int rt = 0; rt < 4; ++rt) *(GAS v2u*)(HT + (size_t)c * 4096 + (size_t)fr * 64 + 16 * rt + 4 * g) = (v2u){pk2(hs[rt][0], hs[rt][1]), pk2(hs[rt][2], hs[rt][3])}; \
        bf16x8 bfr[2]; \
        _Pragma("unroll") for (int ks = 0; ks < 2; ++ks) { const v4u w = (v4u){pk2(hs[2 * ks][0], hs[2 * ks][1]), pk2(hs[2 * ks][2], hs[2 * ks][3]), pk2(hs[2 * ks + 1][0], hs[2 * ks + 1][1]), pk2(hs[2 * ks + 1][2], hs[2 * ks + 1][3])}; bfr[ks] = __builtin_bit_cast(bf16x8, w); } \
        _Pragma("unroll") for (int rt = 0; rt < 4; ++rt) { f32x4 acc = GF[rt]; _Pragma("unroll") for (int ks = 0; ks < 2; ++ks) acc = mfma16(PF[rt][ks], bfr[ks], acc); hs[rt] = acc; } } while (0)
        f32x4 hs[4], gfa[4], gfb[4]; bf16x8 pfa[4][2], pfb[4][2];
#pragma unroll
        for (int rt = 0; rt < 4; ++rt) hs[rt] = (f32x4){0.f, 0.f, 0.f, 0.f};
        R2_BAR();
        R2_FRAGS(0, pfa, gfa);
        for (int c = 0; c < 256; c += 2) {
            { R2_FRAGS(c + 1, pfb, gfb); R2_STEP(pfa, gfa); asm volatile("s_waitcnt lgkmcnt(0)" ::: "memory"); R2_BAR(); }
            { const int c1 = c + 1; const int cn = (c1 + 1 < 256) ? c1 + 1 : 255; R2_FRAGS(cn, pfa, gfa); { const int c = c1; R2_STEP(pfb, gfb); } asm volatile("s_waitcnt lgkmcnt(0)" ::: "memory"); R2_BAR(); }
        }
#undef R2_FRAGS
#undef R2_STEP
    } else if (wv <= 6) {
        const int p0 = 2 * (wv - 1);
#define R2_DMA(step) do { const int st_ = (step) < 256 ? (step) : 255; LAS unsigned char* sl_ = L + ((step) % R2_NS) * R2_SLOT; \
        _Pragma("unroll") for (int q_ = 0; q_ < 2; ++q_) { const int pc_ = p0 + q_; const char* src_ = (pc_ < 8) ? ((const char*)(PB + (size_t)st_ * 4096) + pc_ * 1024) : ((const char*)(GT + (size_t)st_ * 4096) + (pc_ - 8) * 1024); \
            __builtin_amdgcn_global_load_lds((const unsigned*)(src_ + lane * 16), (LAS unsigned*)(sl_ + pc_ * 1024), 16, 0, 0); } } while (0)
#pragma unroll
        for (int s0 = 0; s0 < R2_D; ++s0) R2_DMA(s0);
        asm volatile("s_waitcnt vmcnt(12)" ::: "memory");
        R2_BAR();
        for (int c = 0; c < 256; ++c) {
            R2_DMA(c + R2_D);
            asm volatile("s_waitcnt vmcnt(12)" ::: "memory");
            R2_BAR();
        }
        asm volatile("s_waitcnt vmcnt(0)" ::: "memory");
#undef R2_DMA
    } else {
        R2_BAR();
        for (int c = 0; c < 256; ++c) R2_BAR();
    }
    __syncthreads();
#undef R2_BAR
}

__device__ __forceinline__ void r3_output(Frame& F) {
    const bf16* QC = (const bf16*)(F.ws + WS_QC); const bf16* HT = (const bf16*)(F.ws + WS_HT); const bf16* Y0 = (const bf16*)(F.ws + WS_Y0T); const float* BSC = (const float*)(F.ws + WS_BSC);
    const bf16* V = (const bf16*)(F.ws + WS_V); const bf16* GR = (const bf16*)(F.ws + WS_GR); bf16* mixed = (bf16*)(F.ws + WS_MIXED);
    const int gw = F.bid * NWAVES + F.wave, NGW = F.G * NWAVES, lane = F.lane, fr = lane & 15, g = lane >> 4;
    for (int w = gw; w < 4096 * 4; w += NGW) { const int u = w >> 2, tt = w & 3, h = u >> 8, chunk = u & 255, t = chunk * 64 + 16 * tt + fr;
        bf16x8 qb[2];
#pragma unroll
        for (int ks = 0; ks < 2; ++ks) qb[ks] = *(const bf16x8*)(QC + (size_t)u * 4096 + (size_t)(16 * tt + fr) * 64 + 32 * ks + 8 * g);
        f32x4 y[4]; float s = 0.f;
#pragma unroll
        for (int it = 0; it < 4; ++it) { const v2u y0 = *(const GAS v2u*)(Y0 + (size_t)u * 4096 + (size_t)(16 * tt + fr) * 64 + 16 * it + 4 * g); y[it] = (f32x4){bflo(y0.x), bfhi(y0.x), bflo(y0.y), bfhi(y0.y)};
#pragma unroll
            for (int ks = 0; ks < 2; ++ks) y[it] = mfma16(*(const bf16x8*)(HT + (size_t)u * 4096 + (size_t)(16 * it + fr) * 64 + 32 * ks + 8 * g), qb[ks], y[it]);
            s += (y[it][0] + y[it][1]) + (y[it][2] + y[it][3]); }
        s += __shfl_xor(s, 16); s += __shfl_xor(s, 32);
        const float mean = s * (1.f / 64.f); float q2 = 0.f;
#pragma unroll
        for (int it = 0; it < 4; ++it)
#pragma unroll
            for (int r = 0; r < 4; ++r) { y[it][r] -= mean; q2 += y[it][r] * y[it][r]; }
        q2 += __shfl_xor(q2, 16); q2 += __shfl_xor(q2, 32);
        const float rstd = __builtin_amdgcn_rsqf(q2 * (1.f / 64.f) + LNX_EPS), bs = BSC[(size_t)t * 16 + h];
#pragma unroll
        for (int it = 0; it < 4; ++it) { const int ch = 64 * h + 16 * it + 4 * g; const size_t o = (size_t)t * 1024 + ch;
            const v2u vc = *(const GAS v2u*)(V + o), vp = t > 0 ? *(const GAS v2u*)(V + o - 1024) : (v2u){0u, 0u}, gg = *(const GAS v2u*)(GR + o);
            const f32x4 mu = *(const GAS f32x4*)(F.mu_rkv + 2048 + ch), lw = *(const GAS f32x4*)(F.lnx_w + ch), lb = *(const GAS f32x4*)(F.lnx_b + ch);
            const f32x4 vcf = (f32x4){bflo(vc.x), bfhi(vc.x), bflo(vc.y), bfhi(vc.y)}, vpf = (f32x4){bflo(vp.x), bfhi(vp.x), bflo(vp.y), bfhi(vp.y)}, gf = (f32x4){bflo(gg.x), bfhi(gg.x), bflo(gg.y), bfhi(gg.y)};
            const f32x4 vs = vcf + mu * (vpf - vcf); f32x4 o4 = y[it] * rstd * lw + lb + vs * bs;
#pragma unroll
            for (int r = 0; r < 4; ++r) o4[r] = o4[r] * gf[r] * sigmoidf_(gf[r]);
            *(GAS v2u*)(mixed + (size_t)t * 2048 + ch) = (v2u){pk2(o4[0], o4[1]), pk2(o4[2], o4[3])}; }
    }
}
#define PHASES_MID \
    p2_kmean(F); GRID_BAR(); \
    p3_gate(F); GRID_BAR(); \
    p4_attn_items(F); GRID_BAR(); \
    p5_combine(F); GRID_BAR(); \
    r1_chunk_local(F); GRID_BAR(); \
    r2_recurrence(F); GRID_BAR(); \
    r3_output(F); GRID_BAR();
#define HOST_EXTRA

__device__ __forceinline__ void p7_final_norm(Frame& F) {
    const int gw = F.bid * NWAVES + F.wave, NGW = F.G * NWAVES;
    const float* rowss = (const float*)(F.ws + WS_ROWSS);
    for (int m = gw; m < T; m += NGW) {
        const float p = (F.lane < 32) ? rowss[(size_t)m * 32 + F.lane] : 0.f;
        const float rs = 1.f / sqrtf(wave_sum(p) * (1.f / D) + RMS_EPS);
        GAS f32x4* o = (GAS f32x4*)(F.out + (size_t)m * D) + F.lane; const GAS f32x4* w = (const GAS f32x4*)F.final_norm_w + F.lane;
#pragma unroll
        for (int j = 0; j < 8; ++j) { const f32x4 h = o[64 * j]; o[64 * j] = h * rs * w[64 * j]; }
    }
}

struct Args { const float* in[16]; float* out; unsigned char* ws; };
__global__ void __launch_bounds__(NWAVES * 64, 2) hymba_fwd(Args args) {
    extern __shared__ __attribute__((aligned(16))) unsigned char lds[];
    Frame F;
    F.lds = (LAS unsigned char*)lds;
    F.MISC = (volatile LAS unsigned*)(F.lds + MISC_OFF);
    F.tid = threadIdx.x; F.lane = F.tid & 63; F.wave = __builtin_amdgcn_readfirstlane(F.tid >> 6);
    F.G = gridDim.x; F.bid = blockIdx.x;
    F.ws = args.ws; F.ctl = (gu32*)(args.ws + WS_CTL);
    F.x = args.in[0]; F.norm_w = args.in[1]; F.w_in = args.in[2]; F.mu_rkv = args.in[3]; F.mu_lora = args.in[4]; F.w_decay_up = args.in[5]; F.w_decay_bias = args.in[6];
    F.w_iclr_up = args.in[7]; F.w_iclr_bias = args.in[8]; F.k_k = args.in[9]; F.k_a = args.in[10]; F.r_k = args.in[11]; F.lnx_w = args.in[12]; F.lnx_b = args.in[13];
    F.w_out = args.in[14]; F.final_norm_w = args.in[15]; F.out = args.out;
    for (int u = F.tid; u < (LDS_BYTES - MISC_OFF) / 4; u += NWAVES * 64) ((LAS unsigned*)(F.lds + MISC_OFF))[u] = 0u;
    __syncthreads();
    XcdBarrier bar = xcd_barrier_post((unsigned*)(F.ctl + CW_BAR), F.MISC + 8);
#define GRID_BAR() do { xcd_barrier(bar); int t_ = threadIdx.x; asm volatile("" : "+v"(t_)); F.tid = t_; F.lane = t_ & 63; F.wave = __builtin_amdgcn_readfirstlane(t_ >> 6); } while (0)

    p0_prologue(F);
    GRID_BAR();
    {
        pg8::Gemm g{(const pg8::bf16_t*)(F.ws + WS_XN), (const pg8::bf16_t*)(F.ws + WS_W1T), T, NPROJ, D}; pg8::StaticOrder S; S.init(T, NPROJ, F.G, F.bid);
        pg8::EpiProj E{(pg8::bf16_t*)(F.ws + WS_PROJ), (pg8::bf16_t*)(F.ws + WS_WDAD), (const float*)(F.ws + WS_ROPE), (const float*)(F.ws + WS_ROPE) + (size_t)T * 16, (size_t)T * 1024};
        pg8::gemm_phase<pg8::EpiProj, pg8::StaticOrder, true, true>(F.lds, g, S, E);
    }
    GRID_BAR();
    PHASES_MID
    {
        pg8::Gemm g{(const pg8::bf16_t*)(F.ws + WS_MIXED), (const pg8::bf16_t*)(F.ws + WS_W2T), T, D, D}; pg8::StaticOrder S; S.init(T, D, F.G, F.bid);
        pg8::EpiOut E{F.x, F.out, (float*)(F.ws + WS_ROWSS), D};
        pg8::gemm_phase<pg8::EpiOut, pg8::StaticOrder, true, true>(F.lds, g, S, E);
    }
    GRID_BAR();
    p7_final_norm(F);
}

extern "C" void kernel_launch(void* const* d_in, const int* in_sizes, int n_in, void* d_out, int out_size, void* d_ws, size_t ws_size, hipStream_t stream) {
    static int grid = 0;
    if (grid == 0) {
        if (n_in != 16 || in_sizes[0] != T * D || out_size != T * D || ws_size < WS_END) { fprintf(stderr, "kernel_launch: unexpected shapes / workspace (n_in %d, in0 %d, out %d, ws %zu < %zu); nothing launched\n", n_in, n_in > 0 ? in_sizes[0] : -1, out_size, ws_size, (size_t)WS_END); grid = -1; return; }
        int dev = 0, cus = 0, per_cu = 0;
        if (hipGetDevice(&dev) != hipSuccess || hipDeviceGetAttribute(&cus, hipDeviceAttributeMultiprocessorCount, dev) != hipSuccess) { grid = -1; return; }
        if (hipFuncSetAttribute((const void*)hymba_fwd, hipFuncAttributeMaxDynamicSharedMemorySize, LDS_BYTES) != hipSuccess) { fprintf(stderr, "kernel_launch: hipFuncSetAttribute failed\n"); grid = -1; return; }
        if (hipOccupancyMaxActiveBlocksPerMultiprocessor(&per_cu, (const void*)hymba_fwd, NWAVES * 64, LDS_BYTES) != hipSuccess || per_cu < 1) { fprintf(stderr, "kernel_launch: occupancy query reports %d workgroups per CU\n", per_cu); per_cu = 1; }
        (void)hipGetLastError();
        grid = cus;
    }
    if (grid < 0) return;
    (void)hipMemsetAsync((char*)d_ws + WS_CTL, 0, CTL_ZERO_BYTES, stream);
    HOST_EXTRA
    Args a{};
    for (int i = 0; i < 16; ++i) a.in[i] = (const float*)d_in[i];
    a.out = (float*)d_out; a.ws = (unsigned char*)d_ws;
    hipLaunchKernelGGL(hymba_fwd, dim3(grid), dim3(NWAVES * 64), LDS_BYTES, stream, a);
}
```

```cpp
#include <hip/hip_runtime.h>
#include <cstdio>
#include <cstdint>
namespace pg8 {
#define PG8_LAS __attribute__((address_space(3)))
typedef unsigned short bf16_t;
typedef short bf16x8 __attribute__((ext_vector_type(8)));
typedef float f32x4 __attribute__((ext_vector_type(4)));
typedef unsigned u32x4 __attribute__((ext_vector_type(4)));
constexpr int BM = 256, BK = 64, HALF = 128, HTB = HALF * BK * 2  , STAGE_BYTES = 8 * HTB, NXCD = 8, WGM = 8;

__host__ __device__ __forceinline__ int lds_byte(int r, int c) { const int st = (r >> 4) * 2 + (c >> 5), rr = r & 15, cc = c & 31, ob = rr * 64 + cc * 2; return st * 1024 + (ob ^ (((ob >> 9) & 1) << 5)); }
__host__ __device__ __forceinline__ void stage_rc(int b, int& R, int& C) { const int st = b / 1024, sb = b % 1024, swz = sb ^ (((sb >> 9) & 1) << 5); R = (st >> 1) * 16 + swz / 64; C = (st & 1) * 32 + (swz % 64) / 2; }
__host__ __device__ __forceinline__ int perm32(int rho) { const int n = rho >> 4, i = rho & 15; return 8 * (i >> 2) + 4 * n + (i & 3); }

struct Unit { int pm, pn; };
struct Gemm { const bf16_t* A; const bf16_t* Bt; int M, N, K; };

struct StaticOrder {
    int nM, nN, nwg, G, c;
    __host__ __device__ void init(int M, int N, int G_, int c_) { nM = M / BM; nN = N / BM; nwg = nM * nN; G = G_; c = c_; }
    __host__ __device__ bool next(int i, Unit& u) const {
        const long L = (long)i * G + c; if (L >= nwg) return false;
        int wgid = (int)L; { const int q = nwg / NXCD, r = nwg % NXCD, xcd = wgid % NXCD, off = wgid / NXCD; wgid = (xcd < r ? xcd * (q + 1) : r * (q + 1) + (xcd - r) * q) + off; }
        const int nig = WGM * nN, gid = wgid / nig, fm = gid * WGM, gsz = (nM - fm) < WGM ? (nM - fm) : WGM;
        u.pm = fm + ((wgid % nig) % gsz); u.pn = (wgid % nig) / gsz; return true;
    }
    __device__ __forceinline__ void a_ready(const Unit&) const {}
    __device__ __forceinline__ void done(const Unit&) const {}
};

__device__ __forceinline__ unsigned cvt_pk_bf16(float lo, float hi) { unsigned r; asm volatile("v_cvt_pk_bf16_f32 %0, %1, %2" : "=v"(r) : "v"(lo), "v"(hi)); return r; }

struct EpiProj {
    static constexpr bool PERM = true, AFTER_DRAIN = false;
    bf16_t* base; bf16_t* wdad; const float* ropec; const float* ropes; size_t gstride;
    __device__ __forceinline__ void operator()(const f32x4 (&acc)[2][2][4][2], const Unit& u, int wr, int wc, int fr, int fq) const {
        const int row0 = u.pm * BM + wr * 64 + fr;
        if (u.pn < 32) {
            const int group = u.pn >> 2; bf16_t* bg = base + (size_t)group * gstride;
            const int col0 = (u.pn & 3) * BM + wc * 32 + 8 * fq;
            const bool rope = (group == 5 || group == 6) && wc == 0;
#pragma unroll
            for (int ai = 0; ai < 2; ++ai)
#pragma unroll
                for (int m = 0; m < 4; ++m) { const int row = row0 + ai * HALF + m * 16; bf16_t* rowp = bg + (size_t)row * 1024 + col0;
                    f32x4 cs = (f32x4){1.f, 1.f, 1.f, 1.f}, sn = (f32x4){0.f, 0.f, 0.f, 0.f};
                    if (rope) { cs = *(const f32x4*)(ropec + (size_t)row * 16 + 4 * fq); sn = *(const f32x4*)(ropes + (size_t)row * 16 + 4 * fq); }
#pragma unroll
                    for (int bj = 0; bj < 2; ++bj) { f32x4 v0 = acc[ai][bj][m][0], v1 = acc[ai][bj][m][1];
                        if (rope) { const f32x4 a = v0 * cs - v1 * sn, b = v1 * cs + v0 * sn; v0 = a; v1 = b; }
                        u32x4 w; w.x = cvt_pk_bf16(v0[0], v0[1]); w.y = cvt_pk_bf16(v0[2], v0[3]); w.z = cvt_pk_bf16(v1[0], v1[1]); w.w = cvt_pk_bf16(v1[2], v1[3]);
                        *(u32x4*)(rowp + bj * HALF) = w; } }
        } else {
            const int col0 = wc * 32 + 8 * fq;
#pragma unroll
            for (int ai = 0; ai < 2; ++ai)
#pragma unroll
                for (int m = 0; m < 4; ++m) { const int row = row0 + ai * HALF + m * 16; bf16_t* rowp = wdad + (size_t)row * 128 + col0;
                    const f32x4 v0 = acc[ai][0][m][0], v1 = acc[ai][0][m][1];
                    u32x4 w; w.x = cvt_pk_bf16(v0[0], v0[1]); w.y = cvt_pk_bf16(v0[2], v0[3]); w.z = cvt_pk_bf16(v1[0], v1[1]); w.w = cvt_pk_bf16(v1[2], v1[3]);
                    *(u32x4*)rowp = w; }
        }
    }
};

struct EpiOut {
    static constexpr bool PERM = false, AFTER_DRAIN = false;
    const float* x; float* out; float* rowss; int ldc;
    __device__ __forceinline__ void operator()(const f32x4 (&acc)[2][2][4][2], const Unit& u, int wr, int wc, int fr, int fq) const {
        const int row0 = u.pm * BM + wr * 64 + fr, col0 = u.pn * BM + wc * 32 + 4 * fq;
#pragma unroll
        for (int ai = 0; ai < 2; ++ai)
#pragma unroll
            for (int m = 0; m < 4; ++m) { const int row = row0 + ai * HALF + m * 16; const size_t off = (size_t)row * ldc + col0; float ss = 0.f;
#pragma unroll
                for (int bj = 0; bj < 2; ++bj)
#pragma unroll
                    for (int n = 0; n < 2; ++n) { const f32x4 xv = *(const f32x4*)(x + off + bj * HALF + n * 16); const f32x4 h = xv + acc[ai][bj][m][n];
                        *(f32x4*)(out + off + bj * HALF + n * 16) = h; ss += (h[0] * h[0] + h[1] * h[1]) + (h[2] * h[2] + h[3] * h[3]); }
                ss += __shfl_xor(ss, 16); ss += __shfl_xor(ss, 32);
                if (fq == 0) rowss[(size_t)row * 32 + u.pn * 4 + wc] = ss; }
    }
};
template <class Epi, class Sched, bool ALIGN_EPI = false, bool SP2 = false>
__device__ __forceinline__ void gemm_phase(PG8_LAS unsigned char* lds, const Gemm g, const Sched& S, const Epi& E) {
    int tid_ = threadIdx.x; asm volatile("" : "+v"(tid_));
    const int tid = tid_, wid = __builtin_amdgcn_readfirstlane(tid >> 6), lane = tid & 63, wr = wid >> 2, wc = wid & 3, fr = lane & 15, fq = lane >> 4;
    const int K = g.K, nt = K / BK;
    unsigned voffA[2], voffB[2];
#pragma unroll
    for (int i = 0; i < 2; ++i) { int R, C; stage_rc(tid * 16 + i * 8192, R, C); const int Rb = Epi::PERM ? ((R & ~31) + perm32(R & 31)) : R;
        voffA[i] = (unsigned)(R * K + C) * 2u; voffB[i] = (unsigned)(Rb * K + C) * 2u; }
    const size_t kstep = (size_t)(BK * 2);
    const size_t hstep = (size_t)HALF * K * 2;
    const size_t tstep = 2 * hstep;
    const unsigned ldsw = (unsigned)wid * 1024u;
    const int aoff = lds_byte(wr * 64 + fr, fq * 8), boff = lds_byte(wc * 32 + fr, fq * 8);
#define PG8_SA(b, h) (((b) * 2 + (h)) * HTB)
#define PG8_SB(b, h) ((4 + (b) * 2 + (h)) * HTB)
#define PG8_STAGE(bufoff, gbase, voff) do { _Pragma("unroll") for (int _i = 0; _i < 2; ++_i) \
        __builtin_amdgcn_global_load_lds((const unsigned*)((const char*)(gbase) + (voff)[_i]), (PG8_LAS unsigned*)(lds + (bufoff) + ldsw + _i * 8192), 16, 0, 0); } while (0)
#define PG8_LDA(dst, b, h) do { _Pragma("unroll") for (int m = 0; m < 4; ++m) _Pragma("unroll") for (int k = 0; k < 2; ++k) dst[m][k] = *(const PG8_LAS bf16x8*)(lds + PG8_SA(b, h) + aoff + m * 2048 + k * 1024); } while (0)
#define PG8_LDB(dst, b, h) do { _Pragma("unroll") for (int n = 0; n < 2; ++n) _Pragma("unroll") for (int k = 0; k < 2; ++k) dst[n][k] = *(const PG8_LAS bf16x8*)(lds + PG8_SB(b, h) + boff + n * 2048 + k * 1024); } while (0)
#define PG8_MMA(ai, bj, At, Bt) do { __builtin_amdgcn_s_setprio(1); _Pragma("unroll") for (int m = 0; m < 4; ++m) _Pragma("unroll") for (int n = 0; n < 2; ++n) _Pragma("unroll") for (int k = 0; k < 2; ++k) \
        acc[ai][bj][m][n] = __builtin_amdgcn_mfma_f32_16x16x32_bf16(Bt[n][k], At[m][k], acc[ai][bj][m][n], 0, 0, 0); __builtin_amdgcn_s_setprio(0); } while (0)
#define PG8_WAIT_V(n) asm volatile("s_waitcnt vmcnt(" #n ")" ::: "memory")
#define PG8_WAIT_L(n) asm volatile("s_waitcnt lgkmcnt(" #n ")" ::: "memory")
#define PG8_BAR __builtin_amdgcn_s_barrier()
#define PG8_SCHED __builtin_amdgcn_sched_barrier(0)
    Unit cur, nxt; int ui = 0;
    if (!S.next(0, cur)) return;
    f32x4 acc[2][2][4][2];
#pragma unroll
    for (int a = 0; a < 2; ++a)
#pragma unroll
        for (int b = 0; b < 2; ++b)
#pragma unroll
            for (int m = 0; m < 4; ++m)
#pragma unroll
                for (int n = 0; n < 2; ++n) acc[a][b][m][n] = (f32x4){0.f, 0.f, 0.f, 0.f};
    bf16x8 At[4][2], B0[2][2], B1[2][2];
    const char* cA = (const char*)g.A + (size_t)cur.pm * tstep; const char* cB = (const char*)g.Bt + (size_t)cur.pn * tstep;
    S.a_ready(cur);
    if constexpr (SP2) {
        PG8_STAGE(PG8_SB(0, 0), cB, voffB); PG8_STAGE(PG8_SB(0, 1), cB + hstep, voffB); PG8_STAGE(PG8_SA(0, 0), cA, voffA); PG8_STAGE(PG8_SA(0, 1), cA + hstep, voffA);
        if (wr == 1) PG8_BAR;
        PG8_WAIT_V(2); PG8_BAR;
        PG8_STAGE(PG8_SB(1, 0), cB + kstep, voffB); PG8_STAGE(PG8_SA(1, 0), cA + kstep, voffA); PG8_STAGE(PG8_SB(1, 1), cB + hstep + kstep, voffB);
        PG8_WAIT_V(6); PG8_BAR;
    } else {
        PG8_STAGE(PG8_SB(0, 0), cB, voffB); PG8_STAGE(PG8_SA(0, 0), cA, voffA); PG8_STAGE(PG8_SB(0, 1), cB + hstep, voffB); PG8_STAGE(PG8_SA(0, 1), cA + hstep, voffA);
        if (wr == 1) PG8_BAR;
        PG8_WAIT_V(4); PG8_BAR;
        PG8_STAGE(PG8_SB(1, 0), cB + kstep, voffB); PG8_STAGE(PG8_SA(1, 0), cA + kstep, voffA); PG8_STAGE(PG8_SB(1, 1), cB + hstep + kstep, voffB);
        PG8_WAIT_V(6); PG8_BAR;
    }
    for (;;) {
        const bool has_next = S.next(ui + 1, nxt);
        const char* nA = has_next ? (const char*)g.A + (size_t)nxt.pm * tstep : cA; const char* nB = has_next ? (const char*)g.Bt + (size_t)nxt.pn * tstep : cB;
        for (int t = 0; t < nt; t += 2) {
            const bool last = (t == nt - 2);
            const char* a1 = cA + (size_t)(t + 1) * kstep;
            const char* a2 = last ? nA : cA + (size_t)(t + 2) * kstep; const char* b2 = last ? nB : cB + (size_t)(t + 2) * kstep;
            const char* a3 = a2 + kstep; const char* b3 = b2 + kstep;
            if (last && has_next) S.a_ready(nxt);
            if constexpr (SP2) {
            PG8_LDB(B0, 0, 0); PG8_LDB(B1, 0, 1); PG8_SCHED; PG8_LDA(At, 0, 0); PG8_STAGE(PG8_SA(1, 1), a1 + hstep, voffA);
            PG8_WAIT_V(8); PG8_WAIT_L(0); PG8_BAR; PG8_MMA(0, 0, At, B0); PG8_MMA(0, 1, At, B1); PG8_BAR; PG8_SCHED;
            PG8_LDA(At, 0, 1); PG8_STAGE(PG8_SB(0, 0), b2, voffB); PG8_STAGE(PG8_SB(0, 1), b2 + hstep, voffB); PG8_STAGE(PG8_SA(0, 0), a2, voffA);
            PG8_WAIT_V(8); PG8_WAIT_L(0); PG8_BAR; PG8_MMA(1, 0, At, B0); PG8_MMA(1, 1, At, B1); PG8_BAR; PG8_SCHED;
            PG8_LDB(B0, 1, 0); PG8_LDB(B1, 1, 1); PG8_SCHED; PG8_LDA(At, 1, 0); PG8_STAGE(PG8_SA(0, 1), a2 + hstep, voffA);
            PG8_WAIT_V(8); PG8_WAIT_L(0); PG8_BAR; PG8_MMA(0, 0, At, B0); PG8_MMA(0, 1, At, B1); PG8_BAR; PG8_SCHED;
            PG8_LDA(At, 1, 1); PG8_STAGE(PG8_SB(1, 0), b3, voffB); PG8_STAGE(PG8_SB(1, 1), b3 + hstep, voffB); PG8_STAGE(PG8_SA(1, 0), a3, voffA);
            PG8_WAIT_V(8); PG8_WAIT_L(0); PG8_BAR; PG8_MMA(1, 0, At, B0); PG8_MMA(1, 1, At, B1); PG8_BAR; PG8_SCHED;
            } else {
            PG8_LDB(B0, 0, 0); PG8_SCHED; PG8_LDA(At, 0, 0); PG8_STAGE(PG8_SA(1, 1), a1 + hstep, voffA);
            PG8_WAIT_L(8); PG8_BAR; PG8_WAIT_L(0); PG8_MMA(0, 0, At, B0); PG8_BAR; PG8_SCHED;
            PG8_LDB(B1, 0, 1); PG8_STAGE(PG8_SB(0, 0), b2, voffB);
            PG8_BAR; PG8_WAIT_L(0); PG8_MMA(0, 1, At, B1); PG8_BAR;
            PG8_LDA(At, 0, 1); PG8_STAGE(PG8_SA(0, 0), a2, voffA);
            PG8_BAR; PG8_WAIT_L(0); PG8_MMA(1, 0, At, B0); PG8_BAR; PG8_SCHED;
            PG8_STAGE(PG8_SB(0, 1), b2 + hstep, voffB);
            PG8_WAIT_V(6); PG8_BAR; PG8_MMA(1, 1, At, B1); PG8_BAR;
            PG8_LDB(B0, 1, 0); PG8_SCHED; PG8_LDA(At, 1, 0); PG8_STAGE(PG8_SA(0, 1), a2 + hstep, voffA);
            PG8_WAIT_L(8); PG8_BAR; PG8_WAIT_L(0); PG8_MMA(0, 0, At, B0); PG8_BAR; PG8_SCHED;
            PG8_LDB(B1, 1, 1); PG8_STAGE(PG8_SB(1, 0), b3, voffB);
            PG8_BAR; PG8_WAIT_L(0); PG8_MMA(0, 1, At, B1); PG8_BAR;
            PG8_LDA(At, 1, 1); PG8_STAGE(PG8_SA(1, 0), a3, voffA);
            PG8_BAR; PG8_WAIT_L(0); PG8_MMA(1, 0, At, B0); PG8_BAR; PG8_SCHED;
            PG8_STAGE(PG8_SB(1, 1), b3 + hstep, voffB);
            PG8_WAIT_V(6); PG8_BAR; PG8_MMA(1, 1, At, B1); PG8_BAR;
            }
        }
        if constexpr (ALIGN_EPI) { if (wr == 0) PG8_BAR; }
        if constexpr (!Epi::AFTER_DRAIN) { E(acc, cur, wr, wc, fr, fq); S.done(cur); }
        if (!has_next) break;
#pragma unroll
        for (int a = 0; a < 2; ++a)
#pragma unroll
            for (int b = 0; b < 2; ++b)
#pragma unroll
                for (int m = 0; m < 4; ++m)
#pragma unroll
                    for (int n = 0; n < 2; ++n) acc[a][b][m][n] = (f32x4){0.f, 0.f, 0.f, 0.f};
        cur = nxt; cA = nA; cB = nB; ++ui;
        if constexpr (ALIGN_EPI) { if (wr == 1) PG8_BAR; }
    }
    PG8_WAIT_V(0);
    if constexpr (!ALIGN_EPI) { if (wr == 0) PG8_BAR; }
    PG8_BAR;
    if constexpr (Epi::AFTER_DRAIN) { E.fused(acc, cur, wr, wc, fr, fq, lds, wid, lane); S.done(cur); }
#undef PG8_SA
#undef PG8_SB
#undef PG8_STAGE
#undef PG8_LDA
#undef PG8_LDB
#undef PG8_MMA
#undef PG8_WAIT_V
#undef PG8_WAIT_L
#undef PG8_BAR
#undef PG8_SCHED
}
}

constexpr int NWAVES = 8;
constexpr int T = 16384, D = 2048, DIN = 8320, NPROJ = 8448;
constexpr int RW_H = 16, RW_N = 64, MB_H = 8, MB_D = 128, MB_BLK = 256, MB_NB = 64, LORA = 64;
constexpr float RMS_EPS = 1e-6f, LNX_EPS = 64e-5f;

constexpr size_t MiB = 1u << 20;
constexpr size_t WS_CTL = 0, CTL_ZERO_BYTES = 1 * MiB;
constexpr size_t WS_KMEAN = 1 * MiB;
constexpr size_t WS_KMEANB = WS_KMEAN + 256 * 1024;
constexpr size_t WS_BSC = 2 * MiB;
constexpr size_t WS_W2T = 4 * MiB;
constexpr size_t WS_ROPE = 12 * MiB;
constexpr size_t WS_W1T = 16 * MiB;
constexpr size_t WS_LIST = 16 * MiB;
constexpr size_t WS_XN = 52 * MiB;
constexpr size_t WS_Y = 52 * MiB;
constexpr size_t WS_PROJ = 116 * MiB;
constexpr size_t GRP = 32 * MiB;
constexpr size_t WS_R = WS_PROJ, WS_K = WS_PROJ + GRP, WS_V = WS_PROJ + 2 * GRP, WS_GR = WS_PROJ + 3 * GRP, WS_GM = WS_PROJ + 4 * GRP,
                 WS_Q = WS_PROJ + 5 * GRP, WS_KM = WS_PROJ + 6 * GRP, WS_VM = WS_PROJ + 7 * GRP;
constexpr size_t WS_WDAD = 372 * MiB;
constexpr size_t WS_PARTO = 376 * MiB;
constexpr size_t WS_PARTML = 504 * MiB;
constexpr size_t WS_ROWSS = 508 * MiB;
constexpr size_t WS_MIXED = WS_Q;
constexpr size_t WS_END = 510 * MiB;
constexpr int CW_BAR = 4096;
constexpr int CW_CNT = 16384;

constexpr int LDS_BYTES = 155648;
constexpr int MISC_OFF = 147456;

#define GAS __attribute__((address_space(1)))
#define LAS __attribute__((address_space(3)))
typedef unsigned short bf16;
typedef unsigned v4u __attribute__((ext_vector_type(4)));
typedef unsigned v2u __attribute__((ext_vector_type(2)));
typedef float f32x4 __attribute__((ext_vector_type(4)));
typedef float f32x2 __attribute__((ext_vector_type(2)));
typedef short bf16x8 __attribute__((ext_vector_type(8)));
typedef short s16x4 __attribute__((ext_vector_type(4)));
typedef GAS unsigned gu32;
#define RLX_AGENT __ATOMIC_RELAXED, __HIP_MEMORY_SCOPE_AGENT
#define LDS_WAIT() asm volatile("s_waitcnt lgkmcnt(0)" ::: "memory")
#define VM_WAIT() asm volatile("s_waitcnt vmcnt(0)" ::: "memory")
typedef __bf16 hwbf2 __attribute__((ext_vector_type(2)));
__device__ __forceinline__ unsigned f2bf(float f) { return (unsigned)__builtin_bit_cast(unsigned short, (__bf16)f); }
__device__ __forceinline__ unsigned pk2(float lo, float hi) { return __builtin_bit_cast(unsigned, __builtin_convertvector((f32x2){lo, hi}, hwbf2)); }
__device__ __forceinline__ float bflo(unsigned w) { return __builtin_bit_cast(float, w << 16); }
__device__ __forceinline__ float bfhi(unsigned w) { return __builtin_bit_cast(float, w & 0xffff0000u); }
__device__ __forceinline__ float bf2f(bf16 b) { return __builtin_bit_cast(float, (unsigned)b << 16); }
__device__ __forceinline__ float sigmoidf_(float x) { return __builtin_amdgcn_rcpf(1.f + __expf(-x)); }

#define XB_TMO      128
#define XB_XCNT(j)  (256  + 64 * (j))
#define XB_XSUB(j)  (1280 + 64 * (j))
#define XB_XGEN(j)  (2304 + 64 * (j))
#define XB_TOP      3328
#define XB_TOPGEN   3392
#define XCD_BAR_WORDS 3456
#define XB_SPIN_CAP (1u << 22)

__device__ __forceinline__ unsigned xb_ld(unsigned* p)              { return __hip_atomic_load(p, __ATOMIC_RELAXED, __HIP_MEMORY_SCOPE_AGENT); }
__device__ __forceinline__ unsigned xb_add(unsigned* p, unsigned v) { return __hip_atomic_fetch_add(p, v, __ATOMIC_RELAXED, __HIP_MEMORY_SCOPE_AGENT); }
__device__ __forceinline__ unsigned xb_xcc_id() { return (unsigned)__builtin_amdgcn_s_getreg((3 << 11) | 20) & 0xFu; }
#define XB_SPIN(cond, bar) do { unsigned _sp = 0; while (cond) { __builtin_amdgcn_s_sleep(1); \
    if ((++_sp & 255u) == 0u) { if (xb_ld(&(bar)[XB_TMO])) break; if (_sp > XB_SPIN_CAP) { atomicAdd(&(bar)[XB_TMO], 1u); break; } } } } while (0)

struct XcdBarrier { unsigned* bar; unsigned x; volatile LAS unsigned* st; };

__device__ __forceinline__ XcdBarrier xcd_barrier_post(unsigned* bar, volatile LAS unsigned* st) {
    XcdBarrier b; b.bar = bar; b.x = xb_xcc_id(); b.st = st;
    if (threadIdx.x == 0) (void)xb_add(&bar[XB_XCNT(b.x)], 1u);
    return b;
}
__device__ __forceinline__ void xcd_barrier_complete(unsigned* bar, unsigned x, unsigned& nloc, unsigned& nx) {
    const unsigned G = gridDim.x * gridDim.y * gridDim.z;
    unsigned sum, cnt, mine, sp = 0u;
    for (;;) {
        sum = 0u; cnt = 0u; mine = 0u;
#pragma unroll
        for (unsigned j = 0; j < 16; ++j) { const unsigned c = xb_ld(&bar[XB_XCNT(j)]); sum += c; cnt += (c > 0u) ? 1u : 0u; mine = (j == x) ? c : mine; }
        if (sum == G) break;
        __builtin_amdgcn_s_sleep(1);
        if ((++sp & 255u) == 0u) { if (xb_ld(&bar[XB_TMO])) break; if (sp > XB_SPIN_CAP) { atomicAdd(&bar[XB_TMO], 1u); break; } }
    }
    nloc = mine > 0u ? mine : 1u; nx = cnt > 0u ? cnt : 1u;
}
__device__ __forceinline__ void xcd_barrier(const XcdBarrier& b) {
    asm volatile("s_waitcnt vmcnt(0)" ::: "memory");
    __syncthreads();
    if (threadIdx.x == 0) {
        unsigned* bar = b.bar;
        __builtin_amdgcn_s_waitcnt(0);
        unsigned nloc = b.st[0], nx = b.st[1];
        if (nloc == 0u) { xcd_barrier_complete(bar, b.x, nloc, nx); b.st[0] = nloc; b.st[1] = nx; }
        const unsigned old = xb_add(&bar[XB_XSUB(b.x)], 1u);
        const unsigned gen = old / nloc;
        if (old + 1u == (gen + 1u) * nloc) {
            __builtin_amdgcn_fence(__ATOMIC_RELEASE, "agent");
            asm volatile("s_waitcnt vmcnt(0)" ::: "memory");
            const unsigned og = xb_add(&bar[XB_TOP], 1u);
            const unsigned tg = og / nx;
            if (og + 1u == (tg + 1u) * nx) xb_add(&bar[XB_TOPGEN], 1u);
            else XB_SPIN(xb_ld(&bar[XB_TOPGEN]) == tg, bar);
            __builtin_amdgcn_fence(__ATOMIC_ACQUIRE, "agent");
            xb_add(&bar[XB_XGEN(b.x)], 1u);
            asm volatile("s_waitcnt vmcnt(0)" ::: "memory");
        } else {
            XB_SPIN(xb_ld(&bar[XB_XGEN(b.x)]) == gen, bar);
            __builtin_amdgcn_fence(__ATOMIC_ACQUIRE, "agent");
            asm volatile("s_waitcnt vmcnt(0)" ::: "memory");
        }
    }
    __syncthreads();
}

struct Frame {
    LAS unsigned char* lds;
    volatile LAS unsigned* MISC;
    gu32* ctl;
    int tid, lane, wave;
    int G, bid;
    unsigned char* ws;
    const float *x, *norm_w, *w_in, *mu_rkv, *mu_lora, *w_decay_up, *w_decay_bias, *w_iclr_up, *w_iclr_bias, *k_k, *k_a, *r_k, *lnx_w, *lnx_b, *w_out, *final_norm_w;
    float* out;
};

__device__ __forceinline__ float wave_sum(float v) {
#pragma unroll
    for (int o = 1; o < 64; o <<= 1) v += __shfl_xor(v, o);
    return v;
}
__device__ __forceinline__ float wave_max(float v) {
#pragma unroll
    for (int o = 1; o < 64; o <<= 1) v = fmaxf(v, __shfl_xor(v, o));
    return v;
}

__device__ __forceinline__ int w1_src_col(int n) {
    if (n < 8192) {
        const int g = n >> 10, w = n & 1023;
        if (g == 5 || g == 6) {
            const int base = (g == 5) ? 4224 : 5248, hh = w >> 7, p = w & 127; int d = p;
            if (p < 32) { const int a = p >> 3, b = p & 7; d = (b < 4) ? (4 * a + b) : (16 + 4 * a + (b - 4)); }
            return base + hh * 128 + d;
        }
        const int base = (g == 0) ? 0 : (g == 1) ? 1024 : (g == 2) ? 2048 : (g == 3) ? 3200 : (g == 4) ? 7296 : 6272;
        return base + w;
    }
    if (n < 8320) return 3072 + (n - 8192);
    return -1;
}
template <bool MAP>
__device__ __forceinline__ void p0_transpose_item(const float* W, const float* rowscale, int K, int N, bf16* WT, int nblk, LAS float* scr, int item, int lane) {
    const int kb = item / nblk, nb = item % nblk, k0 = 64 * kb, n0 = 64 * nb, kq = lane >> 4, nq = lane & 15;
    const int nd = n0 + 4 * nq; const int src = MAP ? w1_src_col(nd) : nd;
    f32x4 v[16];
#pragma unroll
    for (int i = 0; i < 16; ++i) { const int k = k0 + 4 * i + kq; v[i] = (src >= 0) ? *(const GAS f32x4*)(W + (size_t)k * N + src) : (f32x4){0.f, 0.f, 0.f, 0.f}; if (MAP) v[i] = v[i] * rowscale[k]; }
#pragma unroll
    for (int i = 0; i < 16; ++i) { LAS float* d = scr + (4 * i + kq) * 65 + 4 * nq; d[0] = v[i].x; d[1] = v[i].y; d[2] = v[i].z; d[3] = v[i].w; }
    LDS_WAIT(); asm volatile("" ::: "memory");
    const int c = lane & 7;
#pragma unroll
    for (int j = 0; j < 8; ++j) { const int n = (lane >> 3) + 8 * j; const LAS float* sp = scr + (8 * c) * 65 + n;
        v4u o; o.x = pk2(sp[0 * 65], sp[1 * 65]); o.y = pk2(sp[2 * 65], sp[3 * 65]); o.z = pk2(sp[4 * 65], sp[5 * 65]); o.w = pk2(sp[6 * 65], sp[7 * 65]);
        *(GAS v4u*)(WT + (size_t)(n0 + n) * K + k0 + 8 * c) = o; }
    LDS_WAIT(); asm volatile("" ::: "memory");
}
__device__ __forceinline__ void rms_row_to_bf16(const float* xrow, bf16* orow, int lane) {
    const GAS f32x4* xr = (const GAS f32x4*)xrow + lane;
    f32x4 v[8]; float s = 0.f;
#pragma unroll
    for (int j = 0; j < 8; ++j) { v[j] = xr[64 * j]; s += (v[j].x * v[j].x + v[j].y * v[j].y) + (v[j].z * v[j].z + v[j].w * v[j].w); }
    const float rs = 1.f / sqrtf(wave_sum(s) * (1.f / D) + RMS_EPS);
    GAS unsigned long long* o8 = (GAS unsigned long long*)orow + lane;
#pragma unroll
    for (int j = 0; j < 8; ++j) o8[64 * j] = (unsigned long long)pk2(v[j].x * rs, v[j].y * rs) | ((unsigned long long)pk2(v[j].z * rs, v[j].w * rs) << 32);
}
__device__ __forceinline__ void p0_prologue(Frame& F) {
    LAS float* scr = (LAS float*)(F.lds + F.wave * 17408);
    const int gw = F.bid * NWAVES + F.wave, NGW = F.G * NWAVES;
    constexpr int I_1 = (D / 64) * (NPROJ / 64), I_2 = (D / 64) * (D / 64);
#pragma unroll 1
    for (int pass = 0; pass < 2; ++pass) {
        if ((pass == 0) == ((F.wave & 1) == 0)) {
            for (int it = gw; it < I_1 + I_2; it += NGW) {
                if (it < I_1) p0_transpose_item<true>(F.w_in, F.norm_w, D, DIN, (bf16*)(F.ws + WS_W1T), NPROJ / 64, scr, it, F.lane);
                else p0_transpose_item<false>(F.w_out, nullptr, D, D, (bf16*)(F.ws + WS_W2T), D / 64, scr, it - I_1, F.lane);
            }
        } else {
            for (int m = gw; m < T; m += NGW) rms_row_to_bf16(F.x + (size_t)m * D, (bf16*)(F.ws + WS_XN) + (size_t)m * D, F.lane);
        }
    }
    { bf16* wdt = (bf16*)(F.ws + 1 * MiB + 512 * 1024); bf16* wit = (bf16*)(F.ws + 1 * MiB + 640 * 1024);
      for (int e = F.bid * 512 + F.tid; e < 1024 * 64; e += F.G * 512) { const int c = e >> 6, l = e & 63; wdt[e] = (bf16)f2bf(F.w_decay_up[(size_t)l * 1024 + c]); wit[e] = (bf16)f2bf(F.w_iclr_up[(size_t)l * 1024 + c]); } }
    { float* rc = (float*)(F.ws + WS_ROPE); float* rsn = rc + (size_t)T * 16;
      for (int e = F.bid * 512 + F.tid; e < T * 16; e += F.G * 512) { const int t = e >> 4, i = e & 15;
          const double invf = exp2(-(double)i * (18.931568569324174 / 16.0));
          const double ang = (double)t * invf; const double n = rint(ang * 0.15915494309189535);
          double r = fma(-n, 6.283185307179586, ang); r = fma(-n, 2.4492935982947064e-16, r);
          const float rf = (float)r; rc[e] = cosf(rf); rsn[e] = sinf(rf); } }
}

__device__ __forceinline__ f32x4 mfma16(bf16x8 a, bf16x8 b, f32x4 c) { return __builtin_amdgcn_mfma_f32_16x16x32_bf16(a, b, c, 0, 0, 0); }
__device__ __forceinline__ int list_off(int h, int j) { return h * 516096 + 256 * (63 * j - (j * (j - 1)) / 2); }

__device__ __forceinline__ void p2_kmean(Frame& F) {
    const bf16* KM = (const bf16*)(F.ws + WS_KM); float* kmean = (float*)(F.ws + WS_KMEAN); bf16* kmeanb = (bf16*)(F.ws + WS_KMEANB);
    LAS float* red = (LAS float*)F.lds;
    const int dp = F.tid & 63, rg = F.tid >> 6;
    for (int u = F.bid; u < MB_NB * MB_H; u += F.G) { const int c = u >> 3, h = u & 7;
        float s0 = 0.f, s1 = 0.f;
        const unsigned* p = (const unsigned*)(KM + (size_t)(c * 256 + rg * 32) * 1024 + 128 * h) + dp;
#pragma unroll 8
        for (int r = 0; r < 32; ++r) { const unsigned w = p[(size_t)r * 512]; s0 += bflo(w); s1 += bfhi(w); }
        red[rg * 128 + 2 * dp] = s0; red[rg * 128 + 2 * dp + 1] = s1;
        __syncthreads();
        if (F.tid < 128) { float s = 0.f;
#pragma unroll
            for (int g = 0; g < 8; ++g) s += red[g * 128 + F.tid];
            s *= (1.f / 256.f); kmean[(size_t)(h * 64 + c) * 128 + F.tid] = s; kmeanb[(size_t)(h * 64 + c) * 128 + F.tid] = (bf16)f2bf(s); }
        __syncthreads();
    }
}

__device__ __forceinline__ void top3_insert(float v, int i, float& v1, int& i1, float& v2, int& i2, float& v3, int& i3) {
    const bool b1 = (v > v1) || (v == v1 && i < i1), b2 = (v > v2) || (v == v2 && i < i2), b3 = (v > v3) || (v == v3 && i < i3);
    const float n3 = b2 ? v2 : (b3 ? v : v3), n2 = b1 ? v1 : (b2 ? v : v2), n1 = b1 ? v : v1;
    const int m3 = b2 ? i2 : (b3 ? i : i3), m2 = b1 ? i1 : (b2 ? i : i2), m1 = b1 ? i : i1;
    v1 = n1; v2 = n2; v3 = n3; i1 = m1; i2 = m2; i3 = m3;
}
__device__ __forceinline__ void p3_gate(Frame& F) {
    const bf16* Q = (const bf16*)(F.ws + WS_Q); const bf16* kmb = (const bf16*)(F.ws + WS_KMEANB);
    unsigned* cnt = (unsigned*)(F.ctl + CW_CNT); int* list = (int*)(F.ws + WS_LIST);
    const int gw = F.bid * NWAVES + F.wave, NGW = F.G * NWAVES, lane = F.lane, qi = lane & 15, g = lane >> 4;
    for (int u = gw; u < (T / 16) * MB_H; u += NGW) { const int qt = u >> 3, h = u & 7, cur = qt >> 4;
        if (cur == 0) continue;
        const int t = qt * 16 + qi;
        bf16x8 qf[4];
#pragma unroll
        for (int ks = 0; ks < 4; ++ks) qf[ks] = *(const bf16x8*)(Q + (size_t)t * 1024 + 128 * h + 32 * ks + 8 * g);
        float v1 = -INFINITY, v2 = -INFINITY, v3 = -INFINITY; int i1 = 1 << 20, i2 = 1 << 20, i3 = 1 << 20;
        const int njt = ((cur - 1) >> 4) + 1;
#pragma unroll
        for (int jt = 0; jt < 4; ++jt) { if (jt < njt) {
            f32x4 acc = (f32x4){0.f, 0.f, 0.f, 0.f};
#pragma unroll
            for (int ks = 0; ks < 4; ++ks) { const bf16x8 a = *(const bf16x8*)(kmb + (size_t)(h * 64 + jt * 16 + qi) * 128 + 32 * ks + 8 * g); acc = mfma16(a, qf[ks], acc); }
#pragma unroll
            for (int r = 0; r < 4; ++r) { const int j = jt * 16 + 4 * g + r; const float v = (j < cur) ? acc[r] : -INFINITY; top3_insert(v, j, v1, i1, v2, i2, v3, i3); }
        } }
#pragma unroll
        for (int o = 16; o <= 32; o <<= 1) {
            const float a1 = __shfl_xor(v1, o), a2 = __shfl_xor(v2, o), a3 = __shfl_xor(v3, o); const int b1 = __shfl_xor(i1, o), b2 = __shfl_xor(i2, o), b3 = __shfl_xor(i3, o);
            top3_insert(a1, b1, v1, i1, v2, i2, v3, i3); top3_insert(a2, b2, v1, i1, v2, i2, v3, i3); top3_insert(a3, b3, v1, i1, v2, i2, v3, i3);
        }
        const int vc = cur < 3 ? cur : 3;
        if (g == 0) {
            if (vc > 0) { const unsigned pos = atomicAdd(&cnt[h * 64 + i1], 1u); list[list_off(h, i1) + pos] = (t << 2) | 0; }
            if (vc > 1) { const unsigned pos = atomicAdd(&cnt[h * 64 + i2], 1u); list[list_off(h, i2) + pos] = (t << 2) | 1; }
            if (vc > 2) { const unsigned pos = atomicAdd(&cnt[h * 64 + i3], 1u); list[list_off(h, i3) + pos] = (t << 2) | 2; }
        }
    }
}

constexpr int KV_STRIDE = 288;
constexpr int KLDS_OFF = 0, VLDS_OFF = 256 * KV_STRIDE, PFX_OFF = MISC_OFF + 1024;
__device__ __forceinline__ void tr_read2(s16x4& r0, s16x4& r1, unsigned a0, unsigned a1) {
    asm volatile("ds_read_b64_tr_b16 %0, %2\n\tds_read_b64_tr_b16 %1, %3\n\ts_waitcnt lgkmcnt(0)" : "=&v"(r0), "=&v"(r1) : "v"(a0), "v"(a1) : "memory"); }

template <int B0, int B1> __device__ __forceinline__ void tr_read16(s16x4 (&r)[16], unsigned base) {
    asm volatile(
        "ds_read_b64_tr_b16 %0, %16 offset:%17\n\tds_read_b64_tr_b16 %1, %16 offset:%18\n\tds_read_b64_tr_b16 %2, %16 offset:%19\n\tds_read_b64_tr_b16 %3, %16 offset:%20\n\t"
        "ds_read_b64_tr_b16 %4, %16 offset:%21\n\tds_read_b64_tr_b16 %5, %16 offset:%22\n\tds_read_b64_tr_b16 %6, %16 offset:%23\n\tds_read_b64_tr_b16 %7, %16 offset:%24\n\t"
        "ds_read_b64_tr_b16 %8, %16 offset:%25\n\tds_read_b64_tr_b16 %9, %16 offset:%26\n\tds_read_b64_tr_b16 %10, %16 offset:%27\n\tds_read_b64_tr_b16 %11, %16 offset:%28\n\t"
        "ds_read_b64_tr_b16 %12, %16 offset:%29\n\tds_read_b64_tr_b16 %13, %16 offset:%30\n\tds_read_b64_tr_b16 %14, %16 offset:%31\n\tds_read_b64_tr_b16 %15, %16 offset:%32\n\t"
        "s_waitcnt lgkmcnt(0)"
        : "=&v"(r[0]), "=&v"(r[1]), "=&v"(r[2]), "=&v"(r[3]), "=&v"(r[4]), "=&v"(r[5]), "=&v"(r[6]), "=&v"(r[7]), "=&v"(r[8]), "=&v"(r[9]), "=&v"(r[10]), "=&v"(r[11]), "=&v"(r[12]), "=&v"(r[13]), "=&v"(r[14]), "=&v"(r[15])
        : "v"(base), "i"(B0), "i"(B0 + 32), "i"(B0 + 64), "i"(B0 + 96), "i"(B0 + 128), "i"(B0 + 160), "i"(B0 + 192), "i"(B0 + 224),
          "i"(B1), "i"(B1 + 32), "i"(B1 + 64), "i"(B1 + 96), "i"(B1 + 128), "i"(B1 + 160), "i"(B1 + 192), "i"(B1 + 224)
        : "memory");
}
template <int S> __device__ __forceinline__ void pv_step(const f32x4& p0, const f32x4& p1, f32x4 (&o)[8], unsigned vb) {
    const v4u w = (v4u){pk2(p0[0], p0[1]), pk2(p0[2], p0[3]), pk2(p1[0], p1[1]), pk2(p1[2], p1[3])}; const bf16x8 pf = __builtin_bit_cast(bf16x8, w);
    s16x4 r[16]; tr_read16<32 * S * KV_STRIDE, (32 * S + 16) * KV_STRIDE>(r, vb);
#pragma unroll
    for (int dt = 0; dt < 8; ++dt) { const bf16x8 a = (bf16x8){r[dt][0], r[dt][1], r[dt][2], r[dt][3], r[8 + dt][0], r[8 + dt][1], r[8 + dt][2], r[8 + dt][3]}; o[dt] = mfma16(a, pf, o[dt]); }
}

__device__ __forceinline__ void p4_attn_items(Frame& F) {
    const bf16* Q = (const bf16*)(F.ws + WS_Q); const bf16* KM = (const bf16*)(F.ws + WS_KM); const bf16* VM = (const bf16*)(F.ws + WS_VM);
    const unsigned* cnt = (const unsigned*)(F.ctl + CW_CNT); const int* list = (const int*)(F.ws + WS_LIST);
    bf16* parto = (bf16*)(F.ws + WS_PARTO); float* partml = (float*)(F.ws + WS_PARTML);
    LAS int* pfx = (LAS int*)(F.lds + PFX_OFF);
    const int lane = F.lane, qi = lane & 15, g = lane >> 4, wv = F.wave;
    { LAS int* tmp = (LAS int*)(F.lds + PFX_OFF + 2560);
      const int c = (int)__hip_atomic_load(cnt + F.tid, RLX_AGENT); int val = ((c + 127) >> 7) + 2;
      __syncthreads();
      for (int d = 1; d < 512; d <<= 1) { tmp[F.tid] = val; __syncthreads(); if (F.tid >= d) val += tmp[F.tid - d]; __syncthreads(); }
      pfx[1 + F.tid] = val; if (F.tid == 0) pfx[0] = 0; }
    __syncthreads();
#define PFX(i) __builtin_amdgcn_readfirstlane(pfx[i])
    const int total = PFX(512);
    const int per = (total + F.G - 1) / F.G, lo = F.bid * per, hi = (lo + per < total) ? lo + per : total;
    if (lo >= hi) return;
    int u = 0; { int a = 0, b = 512; while (b - a > 1) { const int mid = (a + b) >> 1; if (PFX(mid) <= lo) a = mid; else b = mid; } u = a; }
    int loaded = -1;
    const float scale = 0.08838834764831845f;
#define P4_ENTRY(IT, UU, EN) do { const int it_ = (IT) < hi ? (IT) : hi - 1; while (it_ >= PFX(UU + 1)) ++UU; const int h_ = UU >> 6, j_ = UU & 63, tl_ = it_ - PFX(UU), ns_ = PFX(UU + 1) - PFX(UU) - 2; \
        if (tl_ >= ns_) EN = ((256 * j_ + 128 * (tl_ - ns_) + 16 * wv + qi) << 2) | 3; \
        else { const int n_ = (int)__hip_atomic_load(cnt + UU, RLX_AGENT); int e_ = tl_ * 128 + 16 * wv + qi; const bool ok_ = e_ < n_; if (!ok_) e_ = n_ - 1; const int en_ = list[list_off(h_, j_) + e_]; EN = ok_ ? en_ : (en_ | (int)0x80000000); } } while (0)
#define P4_QLOAD(QF, EN, UU) do { const int t_ = ((EN) & 0x7fffffff) >> 2; _Pragma("unroll") for (int ks = 0; ks < 4; ++ks) QF[ks] = *(const bf16x8*)(Q + (size_t)t_ * 1024 + 128 * ((UU) >> 6) + 32 * ks + 8 * g); } while (0)
    int u1 = u, u2 = u, en0, en1, en2 = 0; bf16x8 qf[4], qn[4];
    P4_ENTRY(lo, u, en0); u1 = u; P4_ENTRY(lo + 1, u1, en1); u2 = u1;
    P4_QLOAD(qf, en0, u);
    for (int it = lo; it < hi; ++it) {
        P4_QLOAD(qn, en1, u1);
        P4_ENTRY(it + 2, u2, en2);
        const int h = u >> 6, j = u & 63, tl = it - PFX(u), nsel = PFX(u + 1) - PFX(u) - 2;
        if (u != loaded) {
            __syncthreads();
#pragma unroll
            for (int i = 0; i < 8; ++i) { const int pz = F.tid + 512 * i, row = pz >> 4, cc = pz & 15;
                const v4u kv = *(const GAS v4u*)(KM + (size_t)(256 * j + row) * 1024 + 128 * h + 8 * cc); const v4u vv = *(const GAS v4u*)(VM + (size_t)(256 * j + row) * 1024 + 128 * h + 8 * cc);
                *(LAS v4u*)(F.lds + KLDS_OFF + row * KV_STRIDE + 16 * cc) = kv; *(LAS v4u*)(F.lds + VLDS_OFF + row * KV_STRIDE + 16 * cc) = vv; }
            __syncthreads();
            loaded = u;
        }
        const bool own = tl >= nsel; const int hf = tl - nsel;
        const int t = (en0 & 0x7fffffff) >> 2, slot = en0 & 3; const bool valid = en0 >= 0;
        const int nkt = own ? (8 * hf + wv + 1) : 16;
        f32x4 acc[16];
#pragma unroll
        for (int kt = 0; kt < 16; ++kt) { acc[kt] = (f32x4){0.f, 0.f, 0.f, 0.f};
            if (kt < nkt) {
#pragma unroll
                for (int ks = 0; ks < 4; ++ks) { const bf16x8 a = *(const LAS bf16x8*)(F.lds + KLDS_OFF + (16 * kt + qi) * KV_STRIDE + 64 * ks + 16 * g); acc[kt] = mfma16(a, qf[ks], acc[kt]); } } }
        const int tq = t - 256 * j;
        float m = -INFINITY;
#pragma unroll
        for (int kt = 0; kt < 16; ++kt)
#pragma unroll
            for (int r = 0; r < 4; ++r) { float s = acc[kt][r] * scale; const int key = 16 * kt + 4 * g + r; if (kt >= nkt || (own && key > tq)) s = -INFINITY; acc[kt][r] = s; m = fmaxf(m, s); }
        m = fmaxf(m, __shfl_xor(m, 16)); m = fmaxf(m, __shfl_xor(m, 32));
        float l = 0.f;
#pragma unroll
        for (int kt = 0; kt < 16; ++kt)
#pragma unroll
            for (int r = 0; r < 4; ++r) { const float p = __expf(acc[kt][r] - m); acc[kt][r] = p; l += p; }
        l += __shfl_xor(l, 16); l += __shfl_xor(l, 32);
        f32x4 o[8];
#pragma unroll
        for (int dt = 0; dt < 8; ++dt) o[dt] = (f32x4){0.f, 0.f, 0.f, 0.f};
        const unsigned vb0 = (unsigned)(VLDS_OFF + (4 * g + (qi >> 2)) * KV_STRIDE + 8 * (qi & 3)), vb1 = vb0 + 128u * KV_STRIDE;
        if (0 < nkt) pv_step<0>(acc[0], acc[1], o, vb0);
        if (2 < nkt) pv_step<1>(acc[2], acc[3], o, vb0);
        if (4 < nkt) pv_step<2>(acc[4], acc[5], o, vb0);
        if (6 < nkt) pv_step<3>(acc[6], acc[7], o, vb0);
        if (8 < nkt) pv_step<0>(acc[8], acc[9], o, vb1);
        if (10 < nkt) pv_step<1>(acc[10], acc[11], o, vb1);
        if (12 < nkt) pv_step<2>(acc[12], acc[13], o, vb1);
        if (14 < nkt) pv_step<3>(acc[14], acc[15], o, vb1);
        if (valid) { const float il = 1.f / l; const size_t pb = ((size_t)t * 8 + h) * 4 + slot;
#pragma unroll
            for (int dt = 0; dt < 8; ++dt) { v2u w; w.x = pk2(o[dt][0] * il, o[dt][1] * il); w.y = pk2(o[dt][2] * il, o[dt][3] * il); *(GAS v2u*)(parto + pb * 128 + 16 * dt + 4 * g) = w; }
            if (g == 0) { f32x2 ml; ml.x = m; ml.y = l; *(GAS f32x2*)(partml + pb * 2) = ml; } }
        en0 = en1; en1 = en2; u = u1; u1 = u2;
#pragma unroll
        for (int ks = 0; ks < 4; ++ks) qf[ks] = qn[ks];
    }
#undef P4_ENTRY
#undef P4_QLOAD
#undef PFX
}

__device__ __forceinline__ void p5_combine(Frame& F) {
    const bf16* parto = (const bf16*)(F.ws + WS_PARTO); const float* partml = (const float*)(F.ws + WS_PARTML); const bf16* GM = (const bf16*)(F.ws + WS_GM);
    bf16* mixed = (bf16*)(F.ws + WS_MIXED);
    const int gw = F.bid * NWAVES + F.wave, NGW = F.G * NWAVES, sub = F.lane >> 4, d0 = 8 * (F.lane & 15);
    for (int pq = gw; pq < T * MB_H / 4; pq += NGW) { const int pr = pq * 4 + sub, t = pr >> 3, h = pr & 7, cur = t >> 8, vc = cur < 3 ? cur : 3;
        float mm[4], ll[4]; float M = -INFINITY;
#pragma unroll
        for (int s = 0; s < 4; ++s) { const bool on = (s == 3) || (s < vc); f32x2 ml = (f32x2){-INFINITY, 0.f}; if (on) ml = *(const GAS f32x2*)(partml + ((size_t)pr * 4 + s) * 2); mm[s] = ml.x; ll[s] = ml.y; M = fmaxf(M, ml.x); }
        float acc[8]; float W = 0.f;
#pragma unroll
        for (int e = 0; e < 8; ++e) acc[e] = 0.f;
#pragma unroll
        for (int s = 0; s < 4; ++s) { const bool on = (s == 3) || (s < vc); if (on) { const float w = __expf(mm[s] - M) * ll[s]; W += w;
            const v4u ov = *(const GAS v4u*)(parto + ((size_t)pr * 4 + s) * 128 + d0);
            acc[0] += w * bflo(ov.x); acc[1] += w * bfhi(ov.x); acc[2] += w * bflo(ov.y); acc[3] += w * bfhi(ov.y); acc[4] += w * bflo(ov.z); acc[5] += w * bfhi(ov.z); acc[6] += w * bflo(ov.w); acc[7] += w * bfhi(ov.w); } }
        const float iw = 1.f / W;
        const v4u gv = *(const GAS v4u*)(GM + (size_t)t * 1024 + 128 * h + d0);
        const float gg[8] = {bflo(gv.x), bfhi(gv.x), bflo(gv.y), bfhi(gv.y), bflo(gv.z), bfhi(gv.z), bflo(gv.w), bfhi(gv.w)};
        float r[8];
#pragma unroll
        for (int e = 0; e < 8; ++e) r[e] = acc[e] * iw * gg[e] * sigmoidf_(gg[e]);
        v4u w; w.x = pk2(r[0], r[1]); w.y = pk2(r[2], r[3]); w.z = pk2(r[4], r[5]); w.w = pk2(r[6], r[7]);
        *(GAS v4u*)(mixed + (size_t)t * 2048 + 1024 + 128 * h + d0) = w;
    }
}

constexpr size_t WS_SR = 52 * MiB;
constexpr size_t WS_SA = 16 * MiB;
constexpr size_t WS_SK = 376 * MiB;
constexpr size_t WS_SV = 440 * MiB;
constexpr size_t WS_SB = WS_GM;
constexpr size_t WS_SW = WS_VM;
constexpr size_t WS_YS = WS_R;

__device__ __forceinline__ void p6_rwkv_prep(Frame& F) {
    const bf16* R = (const bf16*)(F.ws + WS_R); const bf16* K = (const bf16*)(F.ws + WS_K); const bf16* V = (const bf16*)(F.ws + WS_V); const bf16* WDAD = (const bf16*)(F.ws + WS_WDAD);
    float* SR = (float*)(F.ws + WS_SR); float* SK = (float*)(F.ws + WS_SK); float* SV = (float*)(F.ws + WS_SV);
    bf16* SA = (bf16*)(F.ws + WS_SA); bf16* SB = (bf16*)(F.ws + WS_SB); bf16* SW = (bf16*)(F.ws + WS_SW); float* BSC = (float*)(F.ws + WS_BSC);
    LAS float* WD = (LAS float*)(F.lds);
    LAS float* WI = (LAS float*)(F.lds + 16384);
    LAS float* Rs = (LAS float*)(F.lds + 32768);
    LAS float* Ks = (LAS float*)(F.lds + 49152);
    LAS float* TW = (LAS float*)(F.lds + 65536);
    LAS float* AD = (LAS float*)(F.lds + 81920);
    constexpr int NU = RW_H * (T / 64);
    const int upw = (NU + F.G - 1) / F.G;
    const int c = F.tid & 63, tg = F.tid >> 6;
    int hl_ = -1; float kkc = 0.f, kac = 0.f, rkc = 0.f, wb = 0.f, ib = 0.f;
    for (int ui = 0; ui < upw; ++ui) { const int u = F.bid * upw + ui; if (u >= NU) break; const int h = u / (T / 64), chunk = u % (T / 64), t0 = chunk * 64, ch = 64 * h + c;
        __syncthreads();
        if (h != hl_) { hl_ = h;
            for (int e = F.tid; e < 64 * 64; e += 512) { const int l = e >> 6, cc = e & 63; WD[e] = F.w_decay_up[(size_t)l * 1024 + 64 * h + cc]; WI[e] = F.w_iclr_up[(size_t)l * 1024 + 64 * h + cc]; }
            kkc = F.k_k[ch]; kac = F.k_a[ch]; rkc = F.r_k[ch]; wb = F.w_decay_bias[ch]; ib = F.w_iclr_bias[ch]; }
        { const int row = F.tid >> 3, cv = F.tid & 7, t = t0 + row; const size_t o = (size_t)t * 1024 + 64 * h + 8 * cv;
          const v4u z = (v4u){0u, 0u, 0u, 0u};
          const v4u rc = *(const GAS v4u*)(R + o), kc = *(const GAS v4u*)(K + o), vc = *(const GAS v4u*)(V + o);
          const v4u rp = t > 0 ? *(const GAS v4u*)(R + o - 1024) : z, kp = t > 0 ? *(const GAS v4u*)(K + o - 1024) : z, vp = t > 0 ? *(const GAS v4u*)(V + o - 1024) : z;
          const unsigned rcw[4] = {rc.x, rc.y, rc.z, rc.w}, rpw[4] = {rp.x, rp.y, rp.z, rp.w}, kcw[4] = {kc.x, kc.y, kc.z, kc.w}, kpw[4] = {kp.x, kp.y, kp.z, kp.w}, vcw[4] = {vc.x, vc.y, vc.z, vc.w}, vpw[4] = {vp.x, vp.y, vp.z, vp.w};
          float vs[8];
#pragma unroll
          for (int q = 0; q < 4; ++q) {
#pragma unroll
              for (int hl = 0; hl < 2; ++hl) { const int cc = 8 * cv + 2 * q + hl, chn = 64 * h + cc;
                  const float r0 = hl ? bfhi(rcw[q]) : bflo(rcw[q]), r1 = hl ? bfhi(rpw[q]) : bflo(rpw[q]);
                  const float k0 = hl ? bfhi(kcw[q]) : bflo(kcw[q]), k1 = hl ? bfhi(kpw[q]) : bflo(kpw[q]);
                  const float v0 = hl ? bfhi(vcw[q]) : bflo(vcw[q]), v1 = hl ? bfhi(vpw[q]) : bflo(vpw[q]);
                  Rs[row * 64 + cc] = r0 + F.mu_rkv[chn] * (r1 - r0); Ks[row * 64 + cc] = k0 + F.mu_rkv[1024 + chn] * (k1 - k0); vs[2 * q + hl] = v0 + F.mu_rkv[2048 + chn] * (v1 - v0); } }
          *(GAS f32x4*)(SV + o) = (f32x4){vs[0], vs[1], vs[2], vs[3]}; *(GAS f32x4*)(SV + o + 4) = (f32x4){vs[4], vs[5], vs[6], vs[7]};
#pragma unroll
          for (int part = 0; part < 2; ++part) { const int lv = 8 * cv + 64 * part;
              const v4u wc4 = *(const GAS v4u*)(WDAD + (size_t)t * 128 + lv); const v4u wp4 = t > 0 ? *(const GAS v4u*)(WDAD + (size_t)(t - 1) * 128 + lv) : z;
              const unsigned cw[4] = {wc4.x, wc4.y, wc4.z, wc4.w}, pw[4] = {wp4.x, wp4.y, wp4.z, wp4.w};
#pragma unroll
              for (int q = 0; q < 4; ++q)
#pragma unroll
                  for (int hl = 0; hl < 2; ++hl) { const int l = 8 * cv + 2 * q + hl; const float x0 = hl ? bfhi(cw[q]) : bflo(cw[q]), x1 = hl ? bfhi(pw[q]) : bflo(pw[q]);
                      const float xs = x0 + F.mu_lora[64 * part + l] * (x1 - x0);
                      if (part == 0) TW[row * 64 + l] = tanhf(xs); else AD[row * 64 + l] = xs; } } }
        __syncthreads();
        float aw[8], ai[8];
#pragma unroll
        for (int r = 0; r < 8; ++r) { aw[r] = 0.f; ai[r] = 0.f; }
        for (int l4 = 0; l4 < 16; ++l4) {
            const float wd0 = WD[(4 * l4 + 0) * 64 + c], wd1 = WD[(4 * l4 + 1) * 64 + c], wd2 = WD[(4 * l4 + 2) * 64 + c], wd3 = WD[(4 * l4 + 3) * 64 + c];
            const float wi0 = WI[(4 * l4 + 0) * 64 + c], wi1 = WI[(4 * l4 + 1) * 64 + c], wi2 = WI[(4 * l4 + 2) * 64 + c], wi3 = WI[(4 * l4 + 3) * 64 + c];
#pragma unroll
            for (int r = 0; r < 8; ++r) { const f32x4 tw = *(const LAS f32x4*)(TW + (8 * tg + r) * 64 + 4 * l4); const f32x4 ad = *(const LAS f32x4*)(AD + (8 * tg + r) * 64 + 4 * l4);
                aw[r] += tw.x * wd0 + tw.y * wd1 + tw.z * wd2 + tw.w * wd3; ai[r] += ad.x * wi0 + ad.y * wi1 + ad.z * wi2 + ad.w * wi3; }
        }
#pragma unroll
        for (int r = 0; r < 8; ++r) { const int row = 8 * tg + r, t = t0 + row; const size_t o = (size_t)t * 1024 + ch;
            const float lw = -0.6065306597126334f * sigmoidf_(wb + aw[r]);
            const float ic = sigmoidf_(ib + ai[r]);
            const float kr = Ks[row * 64 + c], rr = Rs[row * 64 + c];
            const float kk = kr * kkc; const float nrm = sqrtf(wave_sum(kk * kk)); const float kkn = kk / fmaxf(nrm, 1e-12f);
            const float kp = kr * (1.f + (ic - 1.f) * kac);
            const float bs = wave_sum(rr * kp * rkc);
            SR[o] = rr; SK[o] = kp; SA[o] = (bf16)f2bf(-kkn); SB[o] = (bf16)f2bf(kkn * ic); SW[o] = (bf16)f2bf(lw);
            if (c == 0) BSC[(size_t)t * 16 + h] = bs; }
    }
}

__device__ __forceinline__ float dpp_add16(float x) {
    x += __builtin_bit_cast(float, __builtin_amdgcn_update_dpp(0, __builtin_bit_cast(int, x), 0xB1, 0xf, 0xf, false));
    x += __builtin_bit_cast(float, __builtin_amdgcn_update_dpp(0, __builtin_bit_cast(int, x), 0x4E, 0xf, 0xf, false));
    x += __builtin_bit_cast(float, __builtin_amdgcn_update_dpp(0, __builtin_bit_cast(int, x), 0x141, 0xf, 0xf, false));
    x += __builtin_bit_cast(float, __builtin_amdgcn_update_dpp(0, __builtin_bit_cast(int, x), 0x140, 0xf, 0xf, false));
    return x;
}
constexpr int SC_CH = 64;
__device__ __forceinline__ void p7_rwkv_scan(Frame& F) {
    if (F.bid >= 32) return;
    const float* SR = (const float*)(F.ws + WS_SR); const float* SK = (const float*)(F.ws + WS_SK); const float* SV = (const float*)(F.ws + WS_SV);
    const bf16* SA = (const bf16*)(F.ws + WS_SA); const bf16* SB = (const bf16*)(F.ws + WS_SB); const bf16* SW = (const bf16*)(F.ws + WS_SW); float* Y = (float*)(F.ws + WS_YS);
    const int h = F.bid >> 1, i0 = 32 * (F.bid & 1);
    LAS float* Lr = (LAS float*)(F.lds);
    LAS float* Lk = (LAS float*)(F.lds + 16384);
    LAS float* La = (LAS float*)(F.lds + 32768);
    LAS float* Lb = (LAS float*)(F.lds + 49152);
    LAS float* Lw = (LAS float*)(F.lds + 65536);
    LAS float* Lv = (LAS float*)(F.lds + 81920);
    const int jg = F.lane & 15, rl = 4 * F.wave + (F.lane >> 4);
    f32x4 st = (f32x4){0.f, 0.f, 0.f, 0.f};
    const int srow = F.tid >> 3, scv = F.tid & 7;
    for (int t0 = 0; t0 < T; t0 += SC_CH) {
        __syncthreads();
        { const size_t o = (size_t)(t0 + srow) * 1024 + 64 * h + 8 * scv;
          const f32x4 r0 = *(const GAS f32x4*)(SR + o), r1 = *(const GAS f32x4*)(SR + o + 4), k0 = *(const GAS f32x4*)(SK + o), k1 = *(const GAS f32x4*)(SK + o + 4);
          const v4u a4 = *(const GAS v4u*)(SA + o), b4 = *(const GAS v4u*)(SB + o), w4 = *(const GAS v4u*)(SW + o);
          const f32x4 vv = *(const GAS f32x4*)(SV + (size_t)(t0 + srow) * 1024 + 64 * h + i0 + 4 * scv);
          LAS float* d = Lr + srow * 64 + 8 * scv; *(LAS f32x4*)d = r0; *(LAS f32x4*)(d + 4) = r1;
          d = Lk + srow * 64 + 8 * scv; *(LAS f32x4*)d = k0; *(LAS f32x4*)(d + 4) = k1;
          d = La + srow * 64 + 8 * scv; *(LAS f32x4*)d = (f32x4){bflo(a4.x), bfhi(a4.x), bflo(a4.y), bfhi(a4.y)}; *(LAS f32x4*)(d + 4) = (f32x4){bflo(a4.z), bfhi(a4.z), bflo(a4.w), bfhi(a4.w)};
          d = Lb + srow * 64 + 8 * scv; *(LAS f32x4*)d = (f32x4){bflo(b4.x), bfhi(b4.x), bflo(b4.y), bfhi(b4.y)}; *(LAS f32x4*)(d + 4) = (f32x4){bflo(b4.z), bfhi(b4.z), bflo(b4.w), bfhi(b4.w)};
          d = Lw + srow * 64 + 8 * scv; *(LAS f32x4*)d = (f32x4){__expf(bflo(w4.x)), __expf(bfhi(w4.x)), __expf(bflo(w4.y)), __expf(bfhi(w4.y))}; *(LAS f32x4*)(d + 4) = (f32x4){__expf(bflo(w4.z)), __expf(bfhi(w4.z)), __expf(bflo(w4.w)), __expf(bfhi(w4.w))};
          *(LAS f32x4*)(Lv + srow * 32 + 4 * scv) = vv; }
        __syncthreads();
#pragma unroll 2
        for (int s = 0; s < SC_CH; ++s) {
            const f32x4 a = *(const LAS f32x4*)(La + s * 64 + 4 * jg), b = *(const LAS f32x4*)(Lb + s * 64 + 4 * jg), w = *(const LAS f32x4*)(Lw + s * 64 + 4 * jg);
            const f32x4 k = *(const LAS f32x4*)(Lk + s * 64 + 4 * jg), r = *(const LAS f32x4*)(Lr + s * 64 + 4 * jg); const float vi = Lv[s * 32 + rl];
            const float sa = dpp_add16((st.x * a.x + st.y * a.y) + (st.z * a.z + st.w * a.w));
            st = st * w + (b * sa + k * vi);
            const float y = dpp_add16((st.x * r.x + st.y * r.y) + (st.z * r.z + st.w * r.w));
            if (jg == 0) Y[(size_t)(t0 + s) * 1024 + 64 * h + i0 + rl] = y;
        }
    }
}

__device__ __forceinline__ void p8_rwkv_final(Frame& F) {
    const float* Y = (const float*)(F.ws + WS_YS); const float* SV = (const float*)(F.ws + WS_SV); const float* BSC = (const float*)(F.ws + WS_BSC); const bf16* GR = (const bf16*)(F.ws + WS_GR);
    bf16* mixed = (bf16*)(F.ws + WS_MIXED);
    const int gw = F.bid * NWAVES + F.wave, NGW = F.G * NWAVES, c0 = 16 * F.lane, hd = F.lane >> 2;
    for (int t = gw; t < T; t += NGW) {
        float y[16]; float s = 0.f;
#pragma unroll
        for (int q = 0; q < 4; ++q) { const f32x4 v = *(const GAS f32x4*)(Y + (size_t)t * 1024 + c0 + 4 * q); y[4 * q] = v.x; y[4 * q + 1] = v.y; y[4 * q + 2] = v.z; y[4 * q + 3] = v.w; s += (v.x + v.y) + (v.z + v.w); }
        s += __shfl_xor(s, 1); s += __shfl_xor(s, 2);
        const float mean = s * (1.f / 64.f); float q2 = 0.f;
#pragma unroll
        for (int e = 0; e < 16; ++e) { y[e] -= mean; q2 += y[e] * y[e]; }
        q2 += __shfl_xor(q2, 1); q2 += __shfl_xor(q2, 2);
        const float rstd = 1.f / sqrtf(q2 * (1.f / 64.f) + LNX_EPS);
        const float bs = BSC[(size_t)t * 16 + hd];
        const v4u g0 = *(const GAS v4u*)(GR + (size_t)t * 1024 + c0), g1 = *(const GAS v4u*)(GR + (size_t)t * 1024 + c0 + 8);
        const float gg[16] = {bflo(g0.x), bfhi(g0.x), bflo(g0.y), bfhi(g0.y), bflo(g0.z), bfhi(g0.z), bflo(g0.w), bfhi(g0.w), bflo(g1.x), bfhi(g1.x), bflo(g1.y), bfhi(g1.y), bflo(g1.z), bfhi(g1.z), bflo(g1.w), bfhi(g1.w)};
        float r[16];
#pragma unroll
        for (int q = 0; q < 4; ++q) { const f32x4 v = *(const GAS f32x4*)(SV + (size_t)t * 1024 + c0 + 4 * q); const f32x4 lw = *(const GAS f32x4*)(F.lnx_w + c0 + 4 * q), lb = *(const GAS f32x4*)(F.lnx_b + c0 + 4 * q);
            const float vv[4] = {v.x, v.y, v.z, v.w}, lww[4] = {lw.x, lw.y, lw.z, lw.w}, lbb[4] = {lb.x, lb.y, lb.z, lb.w};
#pragma unroll
            for (int e = 0; e < 4; ++e) { const int i = 4 * q + e; const float o = y[i] * rstd * lww[e] + lbb[e] + bs * vv[e]; r[i] = o * gg[i] * sigmoidf_(gg[i]); } }
        v4u w0, w1; w0.x = pk2(r[0], r[1]); w0.y = pk2(r[2], r[3]); w0.z = pk2(r[4], r[5]); w0.w = pk2(r[6], r[7]); w1.x = pk2(r[8], r[9]); w1.y = pk2(r[10], r[11]); w1.z = pk2(r[12], r[13]); w1.w = pk2(r[14], r[15]);
        *(GAS v4u*)(mixed + (size_t)t * 2048 + c0) = w0; *(GAS v4u*)(mixed + (size_t)t * 2048 + c0 + 8) = w1;
    }
}

constexpr size_t WS_WDT = 1 * MiB + 512 * 1024;
constexpr size_t WS_WIT = 1 * MiB + 640 * 1024;
constexpr size_t WS_PB = 16 * MiB;
constexpr size_t WS_QC = 52 * MiB;
constexpr size_t WS_HT = 84 * MiB;
constexpr size_t WS_GT = 376 * MiB;
constexpr size_t WS_Y0T = 440 * MiB;
constexpr int IMS = 144;
constexpr int L_AT = 0, L_RT = 9216, L_BT = 18432, L_KT = 27648, L_BHT = 36864, L_KHT = 46080, L_VT = 55296, L_XT = 64512;
constexpr int L_RA = 82944;
constexpr int L_TW = L_RA, L_AD = L_RA + 9216, L_WP = L_RA + 18432, L_AP = L_WP + 16640;
constexpr int L_LAB = L_RA, L_LAK = L_RA + 17408, L_MRB = L_LAK + 9216, L_MRK = L_MRB + 9216, L_TII = L_MRK + 9216;
constexpr int L_CUMP = 134656, L_GC = L_CUMP + 2048;
constexpr int L_NRM = 136960;
constexpr int L_PAR = 137216;

__device__ __forceinline__ f32x4 mfma4f(float a, float b, f32x4 c) { return __builtin_amdgcn_mfma_f32_16x16x4f32(a, b, c, 0, 0, 0); }
__device__ __forceinline__ bf16x8 lds_frag(LAS unsigned char* img, int row, int ks, int g) { return *(const LAS bf16x8*)(img + row * IMS + 64 * ks + 16 * g); }

__device__ __forceinline__ float wave_sum_dpp(float x) {
    x = dpp_add16(x);
    x += __builtin_bit_cast(float, __builtin_amdgcn_update_dpp(0, __builtin_bit_cast(int, x), 0x142, 0xa, 0xf, false));
    x += __builtin_bit_cast(float, __builtin_amdgcn_update_dpp(0, __builtin_bit_cast(int, x), 0x143, 0xc, 0xf, false));
    return __builtin_bit_cast(float, __builtin_amdgcn_readlane(__builtin_bit_cast(int, x), 63));
}
struct R1In { v4u wd0, wd1, wp0, wp1, rc, rp, kc, kp, vc, vp; };
__device__ __forceinline__ void r1_load(Frame& F, int h, int chunk, R1In& in) {
    const bf16* R = (const bf16*)(F.ws + WS_R); const bf16* K = (const bf16*)(F.ws + WS_K); const bf16* V = (const bf16*)(F.ws + WS_V); const bf16* WDAD = (const bf16*)(F.ws + WS_WDAD);
    const int row = F.tid >> 3, cv = F.tid & 7, t = chunk * 64 + row; const size_t o = (size_t)t * 1024 + 64 * h + 8 * cv; const v4u z4 = (v4u){0u, 0u, 0u, 0u};
    in.wd0 = *(const GAS v4u*)(WDAD + (size_t)t * 128 + 8 * cv); in.wd1 = *(const GAS v4u*)(WDAD + (size_t)t * 128 + 64 + 8 * cv);
    in.rc = *(const GAS v4u*)(R + o); in.kc = *(const GAS v4u*)(K + o); in.vc = *(const GAS v4u*)(V + o);
    if (t > 0) { in.wp0 = *(const GAS v4u*)(WDAD + (size_t)(t - 1) * 128 + 8 * cv); in.wp1 = *(const GAS v4u*)(WDAD + (size_t)(t - 1) * 128 + 64 + 8 * cv);
        in.rp = *(const GAS v4u*)(R + o - 1024); in.kp = *(const GAS v4u*)(K + o - 1024); in.vp = *(const GAS v4u*)(V + o - 1024); }
    else { in.wp0 = z4; in.wp1 = z4; in.rp = z4; in.kp = z4; in.vp = z4; }
}
constexpr int L_RS = L_AT, L_KS = L_BT, L_VS = L_BHT;

__device__ __forceinline__ void r1_unit(Frame& F, int h, int chunk, R1In& in, const bf16x8 (&wfr)[2][2][2], int un) {
    float* BSC = (float*)(F.ws + WS_BSC);
    LAS unsigned char* L = F.lds; const LAS float* PAR = (const LAS float*)(L + L_PAR);
    int tid = F.tid; asm volatile("" : "+v"(tid));
    const int t0 = chunk * 64, u = h * 256 + chunk, lane = tid & 63, wv = __builtin_amdgcn_readfirstlane(tid >> 6), fr = lane & 15, g = lane >> 4;
    __syncthreads();
    { const int row = tid >> 3, cv = tid & 7;
#pragma unroll
      for (int part = 0; part < 2; ++part) { const v4u wc4 = part ? in.wd1 : in.wd0, wp4 = part ? in.wp1 : in.wp0;
          const unsigned cw[4] = {wc4.x, wc4.y, wc4.z, wc4.w}, pw[4] = {wp4.x, wp4.y, wp4.z, wp4.w}; unsigned ow[4];
#pragma unroll
          for (int q = 0; q < 4; ++q) { float xs[2];
#pragma unroll
              for (int hl = 0; hl < 2; ++hl) { const int l = 8 * cv + 2 * q + hl; const float x0 = hl ? bfhi(cw[q]) : bflo(cw[q]), x1 = hl ? bfhi(pw[q]) : bflo(pw[q]);
                  xs[hl] = x0 + PAR[192 + 64 * part + l] * (x1 - x0); if (part == 0) { const float e2 = __expf(2.f * xs[hl]); xs[hl] = 1.f - 2.f / (e2 + 1.f); } }
              ow[q] = pk2(xs[0], xs[1]); }
          *(LAS v4u*)(L + (part == 0 ? L_TW : L_AD) + row * IMS + 16 * cv) = (v4u){ow[0], ow[1], ow[2], ow[3]}; }
      const unsigned rcw[4] = {in.rc.x, in.rc.y, in.rc.z, in.rc.w}, rpw[4] = {in.rp.x, in.rp.y, in.rp.z, in.rp.w}, kcw[4] = {in.kc.x, in.kc.y, in.kc.z, in.kc.w}, kpw[4] = {in.kp.x, in.kp.y, in.kp.z, in.kp.w},
                     vcw[4] = {in.vc.x, in.vc.y, in.vc.z, in.vc.w}, vpw[4] = {in.vp.x, in.vp.y, in.vp.z, in.vp.w};
      float nrm2 = 0.f;
#pragma unroll
      for (int q = 0; q < 4; ++q)
#pragma unroll
          for (int hl = 0; hl < 2; ++hl) { const int cc = 8 * cv + 2 * q + hl;
              const float r0 = hl ? bfhi(rcw[q]) : bflo(rcw[q]), r1 = hl ? bfhi(rpw[q]) : bflo(rpw[q]), k0 = hl ? bfhi(kcw[q]) : bflo(kcw[q]), k1 = hl ? bfhi(kpw[q]) : bflo(kpw[q]);
              const float v0 = hl ? bfhi(vcw[q]) : bflo(vcw[q]), v1 = hl ? bfhi(vpw[q]) : bflo(vpw[q]);
              const float ksh = k0 + PAR[64 + cc] * (k1 - k0), kkv = ksh * PAR[320 + cc]; nrm2 += kkv * kkv;
              ((LAS float*)(L + L_RS))[row * 65 + cc] = r0 + PAR[cc] * (r1 - r0); ((LAS float*)(L + L_KS))[row * 65 + cc] = ksh;
              ((LAS float*)(L + L_VS))[row * 65 + cc] = v0 + PAR[128 + cc] * (v1 - v0); }
      nrm2 += __builtin_bit_cast(float, __builtin_amdgcn_update_dpp(0, __builtin_bit_cast(int, nrm2), 0xB1, 0xf, 0xf, false));
      nrm2 += __builtin_bit_cast(float, __builtin_amdgcn_update_dpp(0, __builtin_bit_cast(int, nrm2), 0x4E, 0xf, 0xf, false));
      nrm2 += __builtin_bit_cast(float, __builtin_amdgcn_update_dpp(0, __builtin_bit_cast(int, nrm2), 0x141, 0xf, 0xf, false));
      if (cv == 0) ((LAS float*)(L + L_NRM))[row] = __builtin_amdgcn_rsqf(fmaxf(nrm2, 1e-24f)); }
    if (un >= 0) r1_load(F, un >> 8, un & 255, in);
    __syncthreads();
    { const int tr = wv >> 1;
#pragma unroll
      for (int prod = 0; prod < 2; ++prod) { LAS unsigned char* aimg = L + (prod == 0 ? L_TW : L_AD); LAS float* o = (LAS float*)(L + (prod == 0 ? L_WP : L_AP));
#pragma unroll
          for (int cc = 0; cc < 2; ++cc) { const int ct = (wv & 1) * 2 + cc; f32x4 acc = (f32x4){0.f, 0.f, 0.f, 0.f};
#pragma unroll
              for (int ks = 0; ks < 2; ++ks) acc = mfma16(lds_frag(aimg, 16 * tr + fr, ks, g), wfr[prod][cc][ks], acc);
#pragma unroll
              for (int r = 0; r < 4; ++r) o[(16 * tr + 4 * g + r) * 65 + 16 * ct + fr] = acc[r]; } } }
    __syncthreads();
    { const int c = tid & 63, tg = tid >> 6, ch = 64 * h + c;
      const float kkc = PAR[320 + c], kac = PAR[384 + c], rkc = PAR[448 + c], wb = PAR[512 + c], ib = PAR[576 + c];
      const LAS float* WP = (const LAS float*)(L + L_WP); const LAS float* AP = (const LAS float*)(L + L_AP); LAS float* CUMP = (LAS float*)(L + L_CUMP);
      float rr[8], kr[8], vv[8], lw[8], ic[8];
      float ps = 0.f;
#pragma unroll
      for (int r = 0; r < 8; ++r) { const int row = 8 * tg + r; rr[r] = ((const LAS float*)(L + L_RS))[row * 65 + c]; kr[r] = ((const LAS float*)(L + L_KS))[row * 65 + c]; vv[r] = ((const LAS float*)(L + L_VS))[row * 65 + c];
          lw[r] = -0.6065306597126334f * sigmoidf_(wb + WP[row * 65 + c]); ic[r] = sigmoidf_(ib + AP[row * 65 + c]); ps += lw[r]; }
      CUMP[tg * 64 + c] = ps;
      __syncthreads();
      float off = 0.f, tot = 0.f;
#pragma unroll
      for (int q = 0; q < 8; ++q) { const float p = CUMP[q * 64 + c]; tot += p; if (q < tg) off += p; }
      float av[8], rv[8], bv[8], kv[8], bhv[8], khv[8]; float cum = off, gcar = __expf(off); const float gtot = __expf(tot);
      if (tg == 0) ((LAS float*)(L + L_GC))[c] = gtot;
#pragma unroll
      for (int r = 0; r < 8; ++r) { const int t = t0 + 8 * tg + r;
          const float gprev = gcar; cum += lw[r]; const float gam = __expf(cum), ig = __builtin_amdgcn_rcpf(gam), gh = gtot * ig; gcar = gam;
          const float kkn = kr[r] * kkc * ((const LAS float*)(L + L_NRM))[8 * tg + r];
          const float kpm = kr[r] * (1.f + (ic[r] - 1.f) * kac); const float bs = wave_sum_dpp(rr[r] * kpm * rkc);
          if (c == 0) BSC[(size_t)t * 16 + h] = bs;
          const float bq = kkn * ic[r];
          av[r] = -kkn * gprev; rv[r] = rr[r] * gam; bv[r] = bq * ig; kv[r] = kpm * ig; bhv[r] = bq * gh; khv[r] = kpm * gh; }
#define R1_PUT(OFF, A) *(LAS v4u*)(L + (OFF) + c * IMS + 16 * tg) = (v4u){pk2(A[0], A[1]), pk2(A[2], A[3]), pk2(A[4], A[5]), pk2(A[6], A[7])}
      R1_PUT(L_AT, av); R1_PUT(L_RT, rv); R1_PUT(L_BT, bv); R1_PUT(L_KT, kv); R1_PUT(L_BHT, bhv); R1_PUT(L_KHT, khv); R1_PUT(L_VT, vv);
#undef R1_PUT
    }
    __syncthreads();
    { const int prod = wv >> 1; const unsigned ximg = (unsigned)((prod < 2) ? L_AT : L_RT), yimg = (unsigned)((prod & 1) ? L_KT : L_BT);
      const unsigned trb = (unsigned)((8 * g + (fr >> 2)) * IMS + 8 * (fr & 3));
#pragma unroll
      for (int q = 0; q < 8; ++q) { const int tl = 8 * (wv & 1) + q, ti = tl >> 2, si = tl & 3; f32x4 acc = (f32x4){0.f, 0.f, 0.f, 0.f};
          if (si <= ti) {
#pragma unroll
              for (int ks = 0; ks < 2; ++ks) { s16x4 y0, y1, x0, x1;
                  tr_read2(y0, y1, yimg + trb + (unsigned)(32 * ks * IMS + 32 * si), yimg + trb + (unsigned)((32 * ks + 4) * IMS + 32 * si));
                  tr_read2(x0, x1, ximg + trb + (unsigned)(32 * ks * IMS + 32 * ti), ximg + trb + (unsigned)((32 * ks + 4) * IMS + 32 * ti));
                  acc = mfma16((bf16x8){y0[0], y0[1], y0[2], y0[3], y1[0], y1[1], y1[2], y1[3]}, (bf16x8){x0[0], x0[1], x0[2], x0[3], x1[0], x1[1], x1[2], x1[3]}, acc); } }
          const int t = 16 * ti + fr, s0 = 16 * si + 4 * g;
#pragma unroll
          for (int r = 0; r < 4; ++r) { const bool keep = (prod < 2) ? (s0 + r < t) : (s0 + r <= t); acc[r] = keep ? acc[r] : 0.f; }
          if (prod == 0) *(LAS f32x4*)(L + L_LAB + (t * 68 + s0) * 4) = acc;
          else *(LAS v2u*)(L + (prod == 1 ? L_LAK : prod == 2 ? L_MRB : L_MRK) + t * IMS + 2 * s0) = (v2u){pk2(acc[0], acc[1]), pk2(acc[2], acc[3])}; } }
    __syncthreads();
    f32x4 x[4];
    if (wv < 4) {
#pragma unroll
        for (int bi = 0; bi < 4; ++bi) { const v2u w = *(const LAS v2u*)(L + L_AT + (16 * wv + fr) * IMS + 2 * (16 * bi + 4 * g)); x[bi] = (f32x4){bflo(w.x), bfhi(w.x), bflo(w.y), bfhi(w.y)}; }
    } else {
#pragma unroll
        for (int bi = 0; bi < 4; ++bi) { x[bi] = (f32x4){0.f, 0.f, 0.f, 0.f};
#pragma unroll
            for (int ks = 0; ks < 2; ++ks) x[bi] = mfma16(lds_frag(L + L_LAK, 16 * bi + fr, ks, g), lds_frag(L + L_VT, 16 * (wv - 4) + fr, ks, g), x[bi]); }
    }
    if (wv == 0) { const int bi = g, c = fr; const LAS float* Lb = (const LAS float*)(L + L_LAB) + (16 * bi) * 68 + 16 * bi; LAS float* Tb = (LAS float*)(L + L_TII) + bi * 320;
        float xc[16];
#pragma unroll
        for (int r = 0; r < 16; ++r) { float s0 = (r == c) ? 1.f : 0.f, s1 = 0.f, s2 = 0.f, s3 = 0.f;
#pragma unroll
            for (int q = 0; q < r; ++q) { const float p = Lb[r * 68 + q] * xc[q]; if ((q & 3) == 0) s0 += p; else if ((q & 3) == 1) s1 += p; else if ((q & 3) == 2) s2 += p; else s3 += p; }
            const float s = (s0 + s1) + (s2 + s3); xc[r] = s; Tb[r * 20 + c] = s; } }
    __syncthreads();
    { const LAS float* Lab = (const LAS float*)(L + L_LAB); const LAS float* Tii = (const LAS float*)(L + L_TII);
#pragma unroll
      for (int bi = 0; bi < 4; ++bi) { f32x4 acc = x[bi];
#pragma unroll
          for (int bj = 0; bj < 4; ++bj) { if (bj < bi) { const f32x4 a = *(const LAS f32x4*)(Lab + (16 * bi + fr) * 68 + 16 * bj + 4 * g);
#pragma unroll
              for (int kk = 0; kk < 4; ++kk) acc = mfma4f(a[kk], x[bj][kk], acc); } }
          const f32x4 tq = *(const LAS f32x4*)(Tii + bi * 320 + fr * 20 + 4 * g); f32x4 xo = (f32x4){0.f, 0.f, 0.f, 0.f};
#pragma unroll
          for (int kk = 0; kk < 4; ++kk) xo = mfma4f(tq[kk], acc[kk], xo);
          x[bi] = xo;
          *(LAS v2u*)(L + L_XT + (16 * wv + fr) * IMS + 2 * (16 * bi + 4 * g)) = (v2u){pk2(xo[0], xo[1]), pk2(xo[2], xo[3])}; } }
    __syncthreads();
    { bf16* PB = (bf16*)(F.ws + WS_PB) + (size_t)u * 4096; bf16* QC = (bf16*)(F.ws + WS_QC) + (size_t)u * 4096; float* GT = (float*)(F.ws + WS_GT) + (size_t)u * 4096; bf16* Y0 = (bf16*)(F.ws + WS_Y0T) + (size_t)u * 4096;
      const LAS float* GC = (const LAS float*)(L + L_GC);
#pragma unroll
      for (int q = 0; q < 2; ++q) { const int tl = 2 * wv + q, ra = tl >> 2, cb = tl & 3;
          { f32x4 acc = (f32x4){0.f, 0.f, 0.f, 0.f};
#pragma unroll
            for (int ks = 0; ks < 2; ++ks) acc = mfma16(lds_frag(L + L_XT, 16 * ra + fr, ks, g), lds_frag(L + L_MRB, 16 * cb + fr, ks, g), acc);
            const int t = 16 * cb + fr, j0 = 16 * ra + 4 * g;
#pragma unroll
            for (int r = 0; r < 4; ++r) acc[r] += bf2f(*(const LAS bf16*)(L + L_RT + (j0 + r) * IMS + 2 * t));
            *(GAS v2u*)(QC + (size_t)t * 64 + j0) = (v2u){pk2(acc[0], acc[1]), pk2(acc[2], acc[3])}; }
          { f32x4 acc = (f32x4){0.f, 0.f, 0.f, 0.f};
#pragma unroll
            for (int ks = 0; ks < 2; ++ks) { acc = mfma16(lds_frag(L + L_XT, 64 + 16 * ra + fr, ks, g), lds_frag(L + L_MRB, 16 * cb + fr, ks, g), acc); acc = mfma16(lds_frag(L + L_VT, 16 * ra + fr, ks, g), lds_frag(L + L_MRK, 16 * cb + fr, ks, g), acc); }
            *(GAS v2u*)(Y0 + (size_t)(16 * cb + fr) * 64 + 16 * ra + 4 * g) = (v2u){pk2(acc[0], acc[1]), pk2(acc[2], acc[3])}; }
          { f32x4 acc = (f32x4){0.f, 0.f, 0.f, 0.f};
#pragma unroll
            for (int ks = 0; ks < 2; ++ks) acc = mfma16(lds_frag(L + L_XT, 16 * ra + fr, ks, g), lds_frag(L + L_BHT, 16 * cb + fr, ks, g), acc);
            const int jp = 16 * cb + fr;
#pragma unroll
            for (int r = 0; r < 4; ++r) if (16 * ra + 4 * g + r == jp) acc[r] += GC[jp];
            *(GAS v2u*)(PB + (size_t)jp * 64 + 32 * (ra >> 1) + 8 * g + 4 * (ra & 1)) = (v2u){pk2(acc[0], acc[1]), pk2(acc[2], acc[3])}; }
          { f32x4 acc = (f32x4){0.f, 0.f, 0.f, 0.f};
#pragma unroll
            for (int ks = 0; ks < 2; ++ks) { acc = mfma16(lds_frag(L + L_BHT, 16 * ra + fr, ks, g), lds_frag(L + L_XT, 64 + 16 * cb + fr, ks, g), acc); acc = mfma16(lds_frag(L + L_KHT, 16 * ra + fr, ks, g), lds_frag(L + L_VT, 16 * cb + fr, ks, g), acc); }
            *(GAS f32x4*)(GT + (size_t)(16 * cb + fr) * 64 + 16 * ra + 4 * g) = acc; } } }
}

__device__ __forceinline__ void r1_chunk_local(Frame& F) {
    constexpr int NU = RW_H * (T / 64);
    const int upw = (NU + F.G - 1) / F.G;
    const int u0 = F.bid * upw; if (u0 >= NU) return;
    const bf16* WDT = (const bf16*)(F.ws + WS_WDT); const bf16* WIT = (const bf16*)(F.ws + WS_WIT);
    const int fr = F.lane & 15, g = F.lane >> 4;
    R1In in; r1_load(F, u0 >> 8, u0 & 255, in);
    bf16x8 wfr[2][2][2]; int hw = -1;
    for (int ui = 0; ui < upw; ++ui) { const int u = u0 + ui; if (u >= NU) break; const int h = u >> 8;
        if (h != hw) { hw = h;
            __syncthreads();
            { LAS float* PARW = (LAS float*)(F.lds + L_PAR); const int e = F.tid, c = e & 63, ch = 64 * h + c; float v = 0.f;
              if (e < 64) v = F.mu_rkv[ch]; else if (e < 128) v = F.mu_rkv[1024 + ch]; else if (e < 192) v = F.mu_rkv[2048 + ch]; else if (e < 320) v = F.mu_lora[e - 192];
              else if (e < 384) v = F.k_k[ch]; else if (e < 448) v = F.k_a[ch]; else v = F.r_k[ch];
              PARW[e] = v;
              if (e < 64) PARW[512 + e] = F.w_decay_bias[ch]; else if (e < 128) PARW[512 + e] = F.w_iclr_bias[ch]; }
#pragma unroll
            for (int prod = 0; prod < 2; ++prod)
#pragma unroll
                for (int cc = 0; cc < 2; ++cc)
#pragma unroll
                    for (int ks = 0; ks < 2; ++ks) wfr[prod][cc][ks] = *(const bf16x8*)((prod ? WIT : WDT) + (size_t)(64 * h + 16 * ((F.wave & 1) * 2 + cc) + fr) * 64 + 32 * ks + 8 * g); }
        r1_unit(F, h, u & 255, in, wfr, (ui + 1 < upw && u + 1 < NU) ? u + 1 : -1); }
}

constexpr int R2_SLOT = 12288, R2_D = 8, R2_NS = 10;
__device__ __forceinline__ void r2_recurrence(Frame& F) {
    if (F.bid >= 64) return;
    const int h = 2 * (F.bid & 7) + (F.bid >> 5), cg = (F.bid >> 3) & 3, lane = F.lane, fr = lane & 15, g = lane >> 4, wv = F.wave;
    const bf16* PB = (const bf16*)(F.ws + WS_PB) + (size_t)h * 256 * 4096; const float* GT = (const float*)(F.ws + WS_GT) + (size_t)h * 256 * 4096 + (size_t)(16 * cg) * 64;
    bf16* HT = (bf16*)(F.ws + WS_HT) + (size_t)h * 256 * 4096 + (size_t)(16 * cg) * 64;
    LAS unsigned char* L = F.lds;
#define R2_BAR() do { asm volatile("" ::: "memory"); __builtin_amdgcn_s_barrier(); asm volatile("" ::: "memory"); } while (0)
    __syncthreads();
    if (wv == 0) {
#define R2_FRAGS(step, PF, GF) do { const LAS unsigned char* sl_ = L + ((step) % R2_NS) * R2_SLOT; _Pragma("unroll") for (int rt = 0; rt < 4; ++rt) { GF[rt] = *(const LAS f32x4*)(sl_ + 8192 + (fr * 64 + 16 * rt + 4 * g) * 4); \
        _Pragma("unroll") for (int ks = 0; ks < 2; ++ks) PF[rt][ks] = *(const LAS bf16x8*)(sl_ + ((16 * rt + fr) * 64 + 32 * ks + 8 * g) * 2); } } while (0)
#define R2_STEP(PF, GF) do { \
        _Pragma("unroll") for (int rt = 0; rt < 4; ++rt) *(GAS v2u*)(HT + (size_t)c * 4096 + (size_t)fr * 64 + 16 * rt + 4 * g) = (v2u){pk2(hs[rt][0], hs[rt][1]), pk2(hs[rt][2], hs[rt][3])}; \
        bf16x8 bfr[2]; \
        _Pragma("unroll") for (int ks = 0; ks < 2; ++ks) { const v4u w = (v4u){pk2(hs[2 * ks][0], hs[2 * ks][1]), pk2(hs[2 * ks][2], hs[2 * ks][3]), pk2(hs[2 * ks + 1][0], hs[2 * ks + 1][1]), pk2(hs[2 * ks + 1][2], hs[2 * ks + 1][3])}; bfr[ks] = __builtin_bit_cast(bf16x8, w); } \
        _Pragma("unroll") for (int rt = 0; rt < 4; ++rt) { f32x4 acc = GF[rt]; _Pragma("unroll") for (int ks = 0; ks < 2; ++ks) acc = mfma16(PF[rt][ks], bfr[ks], acc); hs[rt] = acc; } } while (0)
        f32x4 hs[4], gfa[4], gfb[4]; bf16x8 pfa[4][2], pfb[4][2];
#pragma unroll
        for (int rt = 0; rt < 4; ++rt) hs[rt] = (f32x4){0.f, 0.f, 0.f, 0.f};
        R2_BAR();
        R2_FRAGS(0, pfa, gfa);
        for (int c = 0; c < 256; c += 2) {
            { R2_FRAGS(c + 1, pfb, gfb); R2_STEP(pfa, gfa); asm volatile("s_waitcnt lgkmcnt(0)" ::: "memory"); R2_BAR(); }
            { const int c1 = c + 1; const int cn = (c1 + 1 < 256) ? c1 + 1 : 255; R2_FRAGS(cn, pfa, gfa); { const int c = c1; R2_STEP(pfb, gfb); } asm volatile("s_waitcnt lgkmcnt(0)" ::: "memory"); R2_BAR(); }
        }
#undef R2_FRAGS
#undef R2_STEP
    } else if (wv <= 6) {
        const int p0 = 2 * (wv - 1);
#define R2_DMA(step) do { const int st_ = (step) < 256 ? (step) : 255; LAS unsigned char* sl_ = L + ((step) % R2_NS) * R2_SLOT; \
        _Pragma("unroll") for (int q_ = 0; q_ < 2; ++q_) { const int pc_ = p0 + q_; const char* src_ = (pc_ < 8) ? ((const char*)(PB + (size_t)st_ * 4096) + pc_ * 1024) : ((const char*)(GT + (size_t)st_ * 4096) + (pc_ - 8) * 1024); \
            __builtin_amdgcn_global_load_lds((const unsigned*)(src_ + lane * 16), (LAS unsigned*)(sl_ + pc_ * 1024), 16, 0, 0); } } while (0)
#pragma unroll
        for (int s0 = 0; s0 < R2_D; ++s0) R2_DMA(s0);
        asm volatile("s_waitcnt vmcnt(12)" ::: "memory");
        R2_BAR();
        for (int c = 0; c < 256; ++c) {
            R2_DMA(c + R2_D);
            asm volatile("s_waitcnt vmcnt(12)" ::: "memory");
            R2_BAR();
        }
        asm volatile("s_waitcnt vmcnt(0)" ::: "memory");
#undef R2_DMA
    } else {
        R2_BAR();
        for (int c = 0; c < 256; ++c) R2_BAR();
    }
    __syncthreads();
#undef R2_BAR
}

__device__ __forceinline__ void r3_output(Frame& F) {
    const bf16* QC = (const bf16*)(F.ws + WS_QC); const bf16* HT = (const bf16*)(F.ws + WS_HT); const bf16* Y0 = (const bf16*)(F.ws + WS_Y0T); const float* BSC = (const float*)(F.ws + WS_BSC);
    const bf16* V = (const bf16*)(F.ws + WS_V); const bf16* GR = (const bf16*)(F.ws + WS_GR); bf16* mixed = (bf16*)(F.ws + WS_MIXED);
    const int gw = F.bid * NWAVES + F.wave, NGW = F.G * NWAVES, lane = F.lane, fr = lane & 15, g = lane >> 4;
    for (int w = gw; w < 4096 * 4; w += NGW) { const int u = w >> 2, tt = w & 3, h = u >> 8, chunk = u & 255, t = chunk * 64 + 16 * tt + fr;
        bf16x8 qb[2];
#pragma unroll
        for (int ks = 0; ks < 2; ++ks) qb[ks] = *(const bf16x8*)(QC + (size_t)u * 4096 + (size_t)(16 * tt + fr) * 64 + 32 * ks + 8 * g);
        f32x4 y[4]; float s = 0.f;
#pragma unroll
        for (int it = 0; it < 4; ++it) { const v2u y0 = *(const GAS v2u*)(Y0 + (size_t)u * 4096 + (size_t)(16 * tt + fr) * 64 + 16 * it + 4 * g); y[it] = (f32x4){bflo(y0.x), bfhi(y0.x), bflo(y0.y), bfhi(y0.y)};
#pragma unroll
            for (int ks = 0; ks < 2; ++ks) y[it] = mfma16(*(const bf16x8*)(HT + (size_t)u * 4096 + (size_t)(16 * it + fr) * 64 + 32 * ks + 8 * g), qb[ks], y[it]);
            s += (y[it][0] + y[it][1]) + (y[it][2] + y[it][3]); }
        s += __shfl_xor(s, 16); s += __shfl_xor(s, 32);
        const float mean = s * (1.f / 64.f); float q2 = 0.f;
#pragma unroll
        for (int it = 0; it < 4; ++it)
#pragma unroll
            for (int r = 0; r < 4; ++r) { y[it][r] -= mean; q2 += y[it][r] * y[it][r]; }
        q2 += __shfl_xor(q2, 16); q2 += __shfl_xor(q2, 32);
        const float rstd = __builtin_amdgcn_rsqf(q2 * (1.f / 64.f) + LNX_EPS), bs = BSC[(size_t)t * 16 + h];
#pragma unroll
        for (int it = 0; it < 4; ++it) { const int ch = 64 * h + 16 * it + 4 * g; const size_t o = (size_t)t * 1024 + ch;
            const v2u vc = *(const GAS v2u*)(V + o), vp = t > 0 ? *(const GAS v2u*)(V + o - 1024) : (v2u){0u, 0u}, gg = *(const GAS v2u*)(GR + o);
            const f32x4 mu = *(const GAS f32x4*)(F.mu_rkv + 2048 + ch), lw = *(const GAS f32x4*)(F.lnx_w + ch), lb = *(const GAS f32x4*)(F.lnx_b + ch);
            const f32x4 vcf = (f32x4){bflo(vc.x), bfhi(vc.x), bflo(vc.y), bfhi(vc.y)}, vpf = (f32x4){bflo(vp.x), bfhi(vp.x), bflo(vp.y), bfhi(vp.y)}, gf = (f32x4){bflo(gg.x), bfhi(gg.x), bflo(gg.y), bfhi(gg.y)};
            const f32x4 vs = vcf + mu * (vpf - vcf); f32x4 o4 = y[it] * rstd * lw + lb + vs * bs;
#pragma unroll
            for (int r = 0; r < 4; ++r) o4[r] = o4[r] * gf[r] * sigmoidf_(gf[r]);
            *(GAS v2u*)(mixed + (size_t)t * 2048 + ch) = (v2u){pk2(o4[0], o4[1]), pk2(o4[2], o4[3])}; }
    }
}
#define PHASES_MID \
    p2_kmean(F); GRID_BAR(); \
    p3_gate(F); GRID_BAR(); \
    p4_attn_items(F); GRID_BAR(); \
    p5_combine(F); GRID_BAR(); \
    r1_chunk_local(F); GRID_BAR(); \
    r2_recurrence(F); GRID_BAR(); \
    r3_output(F); GRID_BAR();
#define HOST_EXTRA

__device__ __forceinline__ void p7_final_norm(Frame& F) {
    const int gw = F.bid * NWAVES + F.wave, NGW = F.G * NWAVES;
    const float* rowss = (const float*)(F.ws + WS_ROWSS);
    for (int m = gw; m < T; m += NGW) {
        const float p = (F.lane < 32) ? rowss[(size_t)m * 32 + F.lane] : 0.f;
        const float rs = 1.f / sqrtf(wave_sum(p) * (1.f / D) + RMS_EPS);
        GAS f32x4* o = (GAS f32x4*)(F.out + (size_t)m * D) + F.lane; const GAS f32x4* w = (const GAS f32x4*)F.final_norm_w + F.lane;
#pragma unroll
        for (int j = 0; j < 8; ++j) { const f32x4 h = o[64 * j]; o[64 * j] = h * rs * w[64 * j]; }
    }
}

struct Args { const float* in[16]; float* out; unsigned char* ws; };
__global__ void __launch_bounds__(NWAVES * 64, 2) hymba_fwd(Args args) {
    extern __shared__ __attribute__((aligned(16))) unsigned char lds[];
    Frame F;
    F.lds = (LAS unsigned char*)lds;
    F.MISC = (volatile LAS unsigned*)(F.lds + MISC_OFF);
    F.tid = threadIdx.x; F.lane = F.tid & 63; F.wave = __builtin_amdgcn_readfirstlane(F.tid >> 6);
    F.G = gridDim.x; F.bid = blockIdx.x;
    F.ws = args.ws; F.ctl = (gu32*)(args.ws + WS_CTL);
    F.x = args.in[0]; F.norm_w = args.in[1]; F.w_in = args.in[2]; F.mu_rkv = args.in[3]; F.mu_lora = args.in[4]; F.w_decay_up = args.in[5]; F.w_decay_bias = args.in[6];
    F.w_iclr_up = args.in[7]; F.w_iclr_bias = args.in[8]; F.k_k = args.in[9]; F.k_a = args.in[10]; F.r_k = args.in[11]; F.lnx_w = args.in[12]; F.lnx_b = args.in[13];
    F.w_out = args.in[14]; F.final_norm_w = args.in[15]; F.out = args.out;
    for (int u = F.tid; u < (LDS_BYTES - MISC_OFF) / 4; u += NWAVES * 64) ((LAS unsigned*)(F.lds + MISC_OFF))[u] = 0u;
    __syncthreads();
    XcdBarrier bar = xcd_barrier_post((unsigned*)(F.ctl + CW_BAR), F.MISC + 8);
#define GRID_BAR() do { xcd_barrier(bar); int t_ = threadIdx.x; asm volatile("" : "+v"(t_)); F.tid = t_; F.lane = t_ & 63; F.wave = __builtin_amdgcn_readfirstlane(t_ >> 6); } while (0)

    p0_prologue(F);
    GRID_BAR();
    {
        pg8::Gemm g{(const pg8::bf16_t*)(F.ws + WS_XN), (const pg8::bf16_t*)(F.ws + WS_W1T), T, NPROJ, D}; pg8::StaticOrder S; S.init(T, NPROJ, F.G, F.bid);
        pg8::EpiProj E{(pg8::bf16_t*)(F.ws + WS_PROJ), (pg8::bf16_t*)(F.ws + WS_WDAD), (const float*)(F.ws + WS_ROPE), (const float*)(F.ws + WS_ROPE) + (size_t)T * 16, (size_t)T * 1024};
        pg8::gemm_phase<pg8::EpiProj, pg8::StaticOrder, true, true>(F.lds, g, S, E);
    }
    GRID_BAR();
    PHASES_MID
    {
        pg8::Gemm g{(const pg8::bf16_t*)(F.ws + WS_MIXED), (const pg8::bf16_t*)(F.ws + WS_W2T), T, D, D}; pg8::StaticOrder S; S.init(T, D, F.G, F.bid);
        pg8::EpiOut E{F.x, F.out, (float*)(F.ws + WS_ROWSS), D};
        pg8::gemm_phase<pg8::EpiOut, pg8::StaticOrder, true, true>(F.lds, g, S, E);
    }
    GRID_BAR();
    p7_final_norm(F);
}

extern "C" void kernel_launch(void* const* d_in, const int* in_sizes, int n_in, void* d_out, int out_size, void* d_ws, size_t ws_size, hipStream_t stream) {
    static int grid = 0;
    if (grid == 0) {
        if (n_in != 16 || in_sizes[0] != T * D || out_size != T * D || ws_size < WS_END) { fprintf(stderr, "kernel_launch: unexpected shapes / workspace (n_in %d, in0 %d, out %d, ws %zu < %zu); nothing launched\n", n_in, n_in > 0 ? in_sizes[0] : -1, out_size, ws_size, (size_t)WS_END); grid = -1; return; }
        int dev = 0, cus = 0, per_cu = 0;
        if (hipGetDevice(&dev) != hipSuccess || hipDeviceGetAttribute(&cus, hipDeviceAttributeMultiprocessorCount, dev) != hipSuccess) { grid = -1; return; }
        if (hipFuncSetAttribute((const void*)hymba_fwd, hipFuncAttributeMaxDynamicSharedMemorySize, LDS_BYTES) != hipSuccess) { fprintf(stderr, "kernel_launch: hipFuncSetAttribute failed\n"); grid = -1; return; }
        if (hipOccupancyMaxActiveBlocksPerMultiprocessor(&per_cu, (const void*)hymba_fwd, NWAVES * 64, LDS_BYTES) != hipSuccess || per_cu < 1) { fprintf(stderr, "kernel_launch: occupancy query reports %d workgroups per CU\n", per_cu); per_cu = 1; }
        (void)hipGetLastError();
        grid = cus;
    }
    if (grid < 0) return;
    (void)hipMemsetAsync((char*)d_ws + WS_CTL, 0, CTL_ZERO_BYTES, stream);
    HOST_EXTRA
    Args a{};
    for (int i = 0; i < 16; ++i) a.in[i] = (const float*)d_in[i];
    a.out = (float*)d_out; a.ws = (unsigned char*)d_ws;
    hipLaunchKernelGGL(hymba_fwd, dim3(grid), dim3(NWAVES * 64), LDS_BYTES, stream, a);
}
```

```cpp
#include <hip/hip_runtime.h>
#include <cstdio>
#include <cstdint>
namespace pg8 {
#define PG8_LAS __attribute__((address_space(3)))
typedef unsigned short bf16_t;
typedef short bf16x8 __attribute__((ext_vector_type(8)));
typedef float f32x4 __attribute__((ext_vector_type(4)));
typedef unsigned u32x4 __attribute__((ext_vector_type(4)));
constexpr int BM = 256, BK = 64, HALF = 128, HTB = HALF * BK * 2  , STAGE_BYTES = 8 * HTB, NXCD = 8, WGM = 8;

__host__ __device__ __forceinline__ int lds_byte(int r, int c) { const int st = (r >> 4) * 2 + (c >> 5), rr = r & 15, cc = c & 31, ob = rr * 64 + cc * 2; return st * 1024 + (ob ^ (((ob >> 9) & 1) << 5)); }
__host__ __device__ __forceinline__ void stage_rc(int b, int& R, int& C) { const int st = b / 1024, sb = b % 1024, swz = sb ^ (((sb >> 9) & 1) << 5); R = (st >> 1) * 16 + swz / 64; C = (st & 1) * 32 + (swz % 64) / 2; }
__host__ __device__ __forceinline__ int perm32(int rho) { const int n = rho >> 4, i = rho & 15; return 8 * (i >> 2) + 4 * n + (i & 3); }

struct Unit { int pm, pn; };
struct Gemm { const bf16_t* A; const bf16_t* Bt; int M, N, K; };

struct StaticOrder {
    int nM, nN, nwg, G, c;
    __host__ __device__ void init(int M, int N, int G_, int c_) { nM = M / BM; nN = N / BM; nwg = nM * nN; G = G_; c = c_; }
    __host__ __device__ bool next(int i, Unit& u) const {
        const long L = (long)i * G + c; if (L >= nwg) return false;
        int wgid = (int)L; { const int q = nwg / NXCD, r = nwg % NXCD, xcd = wgid % NXCD, off = wgid / NXCD; wgid = (xcd < r ? xcd * (q + 1) : r * (q + 1) + (xcd - r) * q) + off; }
        const int nig = WGM * nN, gid = wgid / nig, fm = gid * WGM, gsz = (nM - fm) < WGM ? (nM - fm) : WGM;
        u.pm = fm + ((wgid % nig) % gsz); u.pn = (wgid % nig) / gsz; return true;
    }
    __device__ __forceinline__ void a_ready(const Unit&) const {}
    __device__ __forceinline__ void done(const Unit&) const {}
};

__device__ __forceinline__ unsigned cvt_pk_bf16(float lo, float hi) { unsigned r; asm volatile("v_cvt_pk_bf16_f32 %0, %1, %2" : "=v"(r) : "v"(lo), "v"(hi)); return r; }

__device__ __forceinline__ float epi_dpp_add16(float x) {
    x += __builtin_bit_cast(float, __builtin_amdgcn_update_dpp(0, __builtin_bit_cast(int, x), 0xB1, 0xf, 0xf, false));
    x += __builtin_bit_cast(float, __builtin_amdgcn_update_dpp(0, __builtin_bit_cast(int, x), 0x4E, 0xf, 0xf, false));
    x += __builtin_bit_cast(float, __builtin_amdgcn_update_dpp(0, __builtin_bit_cast(int, x), 0x141, 0xf, 0xf, false));
    x += __builtin_bit_cast(float, __builtin_amdgcn_update_dpp(0, __builtin_bit_cast(int, x), 0x140, 0xf, 0xf, false));
    return x;
}
struct EpiProj {
    static constexpr bool PERM = true, AFTER_DRAIN = false;
    bf16_t* base; bf16_t* wdad; const float* ropec; const float* ropes; size_t gstride; float* kmsum;
    __device__ __forceinline__ void operator()(const f32x4 (&acc)[2][2][4][2], const Unit& u, int wr, int wc, int fr, int fq) const {
        const int row0 = u.pm * BM + wr * 64 + fr;
        if (u.pn < 32) {
            const int group = u.pn >> 2; bf16_t* bg = base + (size_t)group * gstride;
            const int col0 = (u.pn & 3) * BM + wc * 32 + 8 * fq;
            const bool rope = (group == 5 || group == 6) && wc == 0;
            f32x4 cs0[2] = {(f32x4){0.f, 0.f, 0.f, 0.f}, (f32x4){0.f, 0.f, 0.f, 0.f}}, cs1[2] = {(f32x4){0.f, 0.f, 0.f, 0.f}, (f32x4){0.f, 0.f, 0.f, 0.f}};
#pragma unroll
            for (int ai = 0; ai < 2; ++ai)
#pragma unroll
                for (int m = 0; m < 4; ++m) { const int row = row0 + ai * HALF + m * 16; bf16_t* rowp = bg + (size_t)row * 1024 + col0;
                    f32x4 cs = (f32x4){1.f, 1.f, 1.f, 1.f}, sn = (f32x4){0.f, 0.f, 0.f, 0.f};
                    if (rope) { cs = *(const f32x4*)(ropec + (size_t)row * 16 + 4 * fq); sn = *(const f32x4*)(ropes + (size_t)row * 16 + 4 * fq); }
#pragma unroll
                    for (int bj = 0; bj < 2; ++bj) { f32x4 v0 = acc[ai][bj][m][0], v1 = acc[ai][bj][m][1];
                        if (rope) { const f32x4 a = v0 * cs - v1 * sn, b = v1 * cs + v0 * sn; v0 = a; v1 = b; }
                        cs0[bj] += v0; cs1[bj] += v1;
                        u32x4 w; w.x = cvt_pk_bf16(v0[0], v0[1]); w.y = cvt_pk_bf16(v0[2], v0[3]); w.z = cvt_pk_bf16(v1[0], v1[1]); w.w = cvt_pk_bf16(v1[2], v1[3]);
                        *(u32x4*)(rowp + bj * HALF) = w; } }
            if (group == 6) {
#pragma unroll
                for (int bj = 0; bj < 2; ++bj) { float* dst = kmsum + ((size_t)((2 * (u.pn & 3) + bj) * 64 + u.pm)) * 128 + wc * 32 + 8 * fq;
#pragma unroll
                    for (int j = 0; j < 4; ++j) { const float a = epi_dpp_add16(cs0[bj][j]), b = epi_dpp_add16(cs1[bj][j]); if (fr == 0) { atomicAdd(dst + j, a); atomicAdd(dst + 4 + j, b); } } } }
        } else {
            const int col0 = wc * 32 + 8 * fq;
#pragma unroll
            for (int ai = 0; ai < 2; ++ai)
#pragma unroll
                for (int m = 0; m < 4; ++m) { const int row = row0 + ai * HALF + m * 16; bf16_t* rowp = wdad + (size_t)row * 128 + col0;
                    const f32x4 v0 = acc[ai][0][m][0], v1 = acc[ai][0][m][1];
                    u32x4 w; w.x = cvt_pk_bf16(v0[0], v0[1]); w.y = cvt_pk_bf16(v0[2], v0[3]); w.z = cvt_pk_bf16(v1[0], v1[1]); w.w = cvt_pk_bf16(v1[2], v1[3]);
                    *(u32x4*)rowp = w; }
        }
    }
};

struct EpiOut {
    static constexpr bool PERM = false, AFTER_DRAIN = false;
    const float* x; float* out; float* rowss; int ldc;
    __device__ __forceinline__ void operator()(const f32x4 (&acc)[2][2][4][2], const Unit& u, int wr, int wc, int fr, int fq) const {
        const int row0 = u.pm * BM + wr * 64 + fr, col0 = u.pn * BM + wc * 32 + 4 * fq;
#pragma unroll
        for (int ai = 0; ai < 2; ++ai)
#pragma unroll
            for (int m = 0; m < 4; ++m) { const int row = row0 + ai * HALF + m * 16; const size_t off = (size_t)row * ldc + col0; float ss = 0.f;
#pragma unroll
                for (int bj = 0; bj < 2; ++bj)
#pragma unroll
                    for (int n = 0; n < 2; ++n) { const f32x4 xv = *(const f32x4*)(x + off + bj * HALF + n * 16); const f32x4 h = xv + acc[ai][bj][m][n];
                        *(f32x4*)(out + off + bj * HALF + n * 16) = h; ss += (h[0] * h[0] + h[1] * h[1]) + (h[2] * h[2] + h[3] * h[3]); }
                ss += __shfl_xor(ss, 16); ss += __shfl_xor(ss, 32);
                if (fq == 0) rowss[(size_t)row * 32 + u.pn * 4 + wc] = ss; }
    }
};
template <class Epi, class Sched, bool ALIGN_EPI = false, bool SP2 = false>
__device__ __forceinline__ void gemm_phase(PG8_LAS unsigned char* lds, const Gemm g, const Sched& S, const Epi& E) {
    int tid_ = threadIdx.x; asm volatile("" : "+v"(tid_));
    const int tid = tid_, wid = __builtin_amdgcn_readfirstlane(tid >> 6), lane = tid & 63, wr = wid >> 2, wc = wid & 3, fr = lane & 15, fq = lane >> 4;
    const int K = g.K, nt = K / BK;
    unsigned voffA[2], voffB[2];
#pragma unroll
    for (int i = 0; i < 2; ++i) { int R, C; stage_rc(tid * 16 + i * 8192, R, C); const int Rb = Epi::PERM ? ((R & ~31) + perm32(R & 31)) : R;
        voffA[i] = (unsigned)(R * K + C) * 2u; voffB[i] = (unsigned)(Rb * K + C) * 2u; }
    const size_t kstep = (size_t)(BK * 2);
    const size_t hstep = (size_t)HALF * K * 2;
    const size_t tstep = 2 * hstep;
    const unsigned ldsw = (unsigned)wid * 1024u;
    const int aoff = lds_byte(wr * 64 + fr, fq * 8), boff = lds_byte(wc * 32 + fr, fq * 8);
#define PG8_SA(b, h) (((b) * 2 + (h)) * HTB)
#define PG8_SB(b, h) ((4 + (b) * 2 + (h)) * HTB)
#define PG8_STAGE(bufoff, gbase, voff) do { _Pragma("unroll") for (int _i = 0; _i < 2; ++_i) \
        __builtin_amdgcn_global_load_lds((const unsigned*)((const char*)(gbase) + (voff)[_i]), (PG8_LAS unsigned*)(lds + (bufoff) + ldsw + _i * 8192), 16, 0, 0); } while (0)
#define PG8_LDA(dst, b, h) do { _Pragma("unroll") for (int m = 0; m < 4; ++m) _Pragma("unroll") for (int k = 0; k < 2; ++k) dst[m][k] = *(const PG8_LAS bf16x8*)(lds + PG8_SA(b, h) + aoff + m * 2048 + k * 1024); } while (0)
#define PG8_LDB(dst, b, h) do { _Pragma("unroll") for (int n = 0; n < 2; ++n) _Pragma("unroll") for (int k = 0; k < 2; ++k) dst[n][k] = *(const PG8_LAS bf16x8*)(lds + PG8_SB(b, h) + boff + n * 2048 + k * 1024); } while (0)
#define PG8_MMA(ai, bj, At, Bt) do { __builtin_amdgcn_s_setprio(1); _Pragma("unroll") for (int m = 0; m < 4; ++m) _Pragma("unroll") for (int n = 0; n < 2; ++n) _Pragma("unroll") for (int k = 0; k < 2; ++k) \
        acc[ai][bj][m][n] = __builtin_amdgcn_mfma_f32_16x16x32_bf16(Bt[n][k], At[m][k], acc[ai][bj][m][n], 0, 0, 0); __builtin_amdgcn_s_setprio(0); } while (0)
#define PG8_WAIT_V(n) asm volatile("s_waitcnt vmcnt(" #n ")" ::: "memory")
#define PG8_WAIT_L(n) asm volatile("s_waitcnt lgkmcnt(" #n ")" ::: "memory")
#define PG8_BAR __builtin_amdgcn_s_barrier()
#define PG8_SCHED __builtin_amdgcn_sched_barrier(0)
    Unit cur, nxt; int ui = 0;
    if (!S.next(0, cur)) return;
    f32x4 acc[2][2][4][2];
#pragma unroll
    for (int a = 0; a < 2; ++a)
#pragma unroll
        for (int b = 0; b < 2; ++b)
#pragma unroll
            for (int m = 0; m < 4; ++m)
#pragma unroll
                for (int n = 0; n < 2; ++n) acc[a][b][m][n] = (f32x4){0.f, 0.f, 0.f, 0.f};
    bf16x8 At[4][2], B0[2][2], B1[2][2];
    const char* cA = (const char*)g.A + (size_t)cur.pm * tstep; const char* cB = (const char*)g.Bt + (size_t)cur.pn * tstep;
    S.a_ready(cur);
    if constexpr (SP2) {
        PG8_STAGE(PG8_SB(0, 0), cB, voffB); PG8_STAGE(PG8_SB(0, 1), cB + hstep, voffB); PG8_STAGE(PG8_SA(0, 0), cA, voffA); PG8_STAGE(PG8_SA(0, 1), cA + hstep, voffA);
        if (wr == 1) PG8_BAR;
        PG8_WAIT_V(2); PG8_BAR;
        PG8_STAGE(PG8_SB(1, 0), cB + kstep, voffB); PG8_STAGE(PG8_SA(1, 0), cA + kstep, voffA); PG8_STAGE(PG8_SB(1, 1), cB + hstep + kstep, voffB);
        PG8_WAIT_V(6); PG8_BAR;
    } else {
        PG8_STAGE(PG8_SB(0, 0), cB, voffB); PG8_STAGE(PG8_SA(0, 0), cA, voffA); PG8_STAGE(PG8_SB(0, 1), cB + hstep, voffB); PG8_STAGE(PG8_SA(0, 1), cA + hstep, voffA);
        if (wr == 1) PG8_BAR;
        PG8_WAIT_V(4); PG8_BAR;
        PG8_STAGE(PG8_SB(1, 0), cB + kstep, voffB); PG8_STAGE(PG8_SA(1, 0), cA + kstep, voffA); PG8_STAGE(PG8_SB(1, 1), cB + hstep + kstep, voffB);
        PG8_WAIT_V(6); PG8_BAR;
    }
    for (;;) {
        const bool has_next = S.next(ui + 1, nxt);
        const char* nA = has_next ? (const char*)g.A + (size_t)nxt.pm * tstep : cA; const char* nB = has_next ? (const char*)g.Bt + (size_t)nxt.pn * tstep : cB;
        for (int t = 0; t < nt; t += 2) {
            const bool last = (t == nt - 2);
            const char* a1 = cA + (size_t)(t + 1) * kstep;
            const char* a2 = last ? nA : cA + (size_t)(t + 2) * kstep; const char* b2 = last ? nB : cB + (size_t)(t + 2) * kstep;
            const char* a3 = a2 + kstep; const char* b3 = b2 + kstep;
            if (last && has_next) S.a_ready(nxt);
            if constexpr (SP2) {
            PG8_LDB(B0, 0, 0); PG8_LDB(B1, 0, 1); PG8_SCHED; PG8_LDA(At, 0, 0); PG8_STAGE(PG8_SA(1, 1), a1 + hstep, voffA);
            PG8_WAIT_V(8); PG8_WAIT_L(0); PG8_BAR; PG8_MMA(0, 0, At, B0); PG8_MMA(0, 1, At, B1); PG8_BAR; PG8_SCHED;
            PG8_LDA(At, 0, 1); PG8_STAGE(PG8_SB(0, 0), b2, voffB); PG8_STAGE(PG8_SB(0, 1), b2 + hstep, voffB); PG8_STAGE(PG8_SA(0, 0), a2, voffA);
            PG8_WAIT_V(8); PG8_WAIT_L(0); PG8_BAR; PG8_MMA(1, 0, At, B0); PG8_MMA(1, 1, At, B1); PG8_BAR; PG8_SCHED;
            PG8_LDB(B0, 1, 0); PG8_LDB(B1, 1, 1); PG8_SCHED; PG8_LDA(At, 1, 0); PG8_STAGE(PG8_SA(0, 1), a2 + hstep, voffA);
            PG8_WAIT_V(8); PG8_WAIT_L(0); PG8_BAR; PG8_MMA(0, 0, At, B0); PG8_MMA(0, 1, At, B1); PG8_BAR; PG8_SCHED;
            PG8_LDA(At, 1, 1); PG8_STAGE(PG8_SB(1, 0), b3, voffB); PG8_STAGE(PG8_SB(1, 1), b3 + hstep, voffB); PG8_STAGE(PG8_SA(1, 0), a3, voffA);
            PG8_WAIT_V(8); PG8_WAIT_L(0); PG8_BAR; PG8_MMA(1, 0, At, B0); PG8_MMA(1, 1, At, B1); PG8_BAR; PG8_SCHED;
            } else {
            PG8_LDB(B0, 0, 0); PG8_SCHED; PG8_LDA(At, 0, 0); PG8_STAGE(PG8_SA(1, 1), a1 + hstep, voffA);
            PG8_WAIT_L(8); PG8_BAR; PG8_WAIT_L(0); PG8_MMA(0, 0, At, B0); PG8_BAR; PG8_SCHED;
            PG8_LDB(B1, 0, 1); PG8_STAGE(PG8_SB(0, 0), b2, voffB);
            PG8_BAR; PG8_WAIT_L(0); PG8_MMA(0, 1, At, B1); PG8_BAR;
            PG8_LDA(At, 0, 1); PG8_STAGE(PG8_SA(0, 0), a2, voffA);
            PG8_BAR; PG8_WAIT_L(0); PG8_MMA(1, 0, At, B0); PG8_BAR; PG8_SCHED;
            PG8_STAGE(PG8_SB(0, 1), b2 + hstep, voffB);
            PG8_WAIT_V(6); PG8_BAR; PG8_MMA(1, 1, At, B1); PG8_BAR;
            PG8_LDB(B0, 1, 0); PG8_SCHED; PG8_LDA(At, 1, 0); PG8_STAGE(PG8_SA(0, 1), a2 + hstep, voffA);
            PG8_WAIT_L(8); PG8_BAR; PG8_WAIT_L(0); PG8_MMA(0, 0, At, B0); PG8_BAR; PG8_SCHED;
            PG8_LDB(B1, 1, 1); PG8_STAGE(PG8_SB(1, 0), b3, voffB);
            PG8_BAR; PG8_WAIT_L(0); PG8_MMA(0, 1, At, B1); PG8_BAR;
            PG8_LDA(At, 1, 1); PG8_STAGE(PG8_SA(1, 0), a3, voffA);
            PG8_BAR; PG8_WAIT_L(0); PG8_MMA(1, 0, At, B0); PG8_BAR; PG8_SCHED;
            PG8_STAGE(PG8_SB(1, 1), b3 + hstep, voffB);
            PG8_WAIT_V(6); PG8_BAR; PG8_MMA(1, 1, At, B1); PG8_BAR;
            }
        }
        if constexpr (ALIGN_EPI) { if (wr == 0) PG8_BAR; }
        if constexpr (!Epi::AFTER_DRAIN) { E(acc, cur, wr, wc, fr, fq); S.done(cur); }
        if (!has_next) break;
#pragma unroll
        for (int a = 0; a < 2; ++a)
#pragma unroll
            for (int b = 0; b < 2; ++b)
#pragma unroll
                for (int m = 0; m < 4; ++m)
#pragma unroll
                    for (int n = 0; n < 2; ++n) acc[a][b][m][n] = (f32x4){0.f, 0.f, 0.f, 0.f};
        cur = nxt; cA = nA; cB = nB; ++ui;
        if constexpr (ALIGN_EPI) { if (wr == 1) PG8_BAR; }
    }
    PG8_WAIT_V(0);
    if constexpr (!ALIGN_EPI) { if (wr == 0) PG8_BAR; }
    PG8_BAR;
    if constexpr (Epi::AFTER_DRAIN) { E.fused(acc, cur, wr, wc, fr, fq, lds, wid, lane); S.done(cur); }
#undef PG8_SA
#undef PG8_SB
#undef PG8_STAGE
#undef PG8_LDA
#undef PG8_LDB
#undef PG8_MMA
#undef PG8_WAIT_V
#undef PG8_WAIT_L
#undef PG8_BAR
#undef PG8_SCHED
}
}

constexpr int NWAVES = 8;
constexpr int T = 16384, D = 2048, DIN = 8320, NPROJ = 8448;
constexpr int RW_H = 16, RW_N = 64, MB_H = 8, MB_D = 128, MB_BLK = 256, MB_NB = 64, LORA = 64;
constexpr float RMS_EPS = 1e-6f, LNX_EPS = 64e-5f;

constexpr size_t MiB = 1u << 20;
constexpr size_t WS_CTL = 0, CTL_ZERO_BYTES = 1 * MiB;
constexpr size_t WS_KMSUM = 512 * 1024;
constexpr size_t WS_KMEAN = 1 * MiB;
constexpr size_t WS_KMEANB = WS_KMEAN + 256 * 1024;
constexpr size_t WS_BSC = 2 * MiB;
constexpr size_t WS_W2T = 4 * MiB;
constexpr size_t WS_ROPE = 12 * MiB;
constexpr size_t WS_W1T = 16 * MiB;
constexpr size_t WS_LIST = 16 * MiB;
constexpr size_t WS_XN = 52 * MiB;
constexpr size_t WS_Y = 52 * MiB;
constexpr size_t WS_PROJ = 116 * MiB;
constexpr size_t GRP = 32 * MiB;
constexpr size_t WS_R = WS_PROJ, WS_K = WS_PROJ + GRP, WS_V = WS_PROJ + 2 * GRP, WS_GR = WS_PROJ + 3 * GRP, WS_GM = WS_PROJ + 4 * GRP,
                 WS_Q = WS_PROJ + 5 * GRP, WS_KM = WS_PROJ + 6 * GRP, WS_VM = WS_PROJ + 7 * GRP;
constexpr size_t WS_WDAD = 372 * MiB;
constexpr size_t WS_PARTO = 376 * MiB;
constexpr size_t WS_PARTML = 504 * MiB;
constexpr size_t WS_ROWSS = 508 * MiB;
constexpr size_t WS_MIXED = WS_Q;
constexpr size_t WS_END = 510 * MiB;
constexpr int CW_BAR = 4096;
constexpr int CW_CNT = 16384;

constexpr int LDS_BYTES = 155648;
constexpr int MISC_OFF = 147456;

#define GAS __attribute__((address_space(1)))
#define LAS __attribute__((address_space(3)))
typedef unsigned short bf16;
typedef unsigned v4u __attribute__((ext_vector_type(4)));
typedef unsigned v2u __attribute__((ext_vector_type(2)));
typedef float f32x4 __attribute__((ext_vector_type(4)));
typedef float f32x2 __attribute__((ext_vector_type(2)));
typedef short bf16x8 __attribute__((ext_vector_type(8)));
typedef short s16x4 __attribute__((ext_vector_type(4)));
typedef GAS unsigned gu32;
#define RLX_AGENT __ATOMIC_RELAXED, __HIP_MEMORY_SCOPE_AGENT
#define LDS_WAIT() asm volatile("s_waitcnt lgkmcnt(0)" ::: "memory")
#define VM_WAIT() asm volatile("s_waitcnt vmcnt(0)" ::: "memory")
typedef __bf16 hwbf2 __attribute__((ext_vector_type(2)));
__device__ __forceinline__ unsigned f2bf(float f) { return (unsigned)__builtin_bit_cast(unsigned short, (__bf16)f); }
__device__ __forceinline__ unsigned pk2(float lo, float hi) { return __builtin_bit_cast(unsigned, __builtin_convertvector((f32x2){lo, hi}, hwbf2)); }
__device__ __forceinline__ float bflo(unsigned w) { return __builtin_bit_cast(float, w << 16); }
__device__ __forceinline__ float bfhi(unsigned w) { return __builtin_bit_cast(float, w & 0xffff0000u); }
__device__ __forceinline__ float bf2f(bf16 b) { return __builtin_bit_cast(float, (unsigned)b << 16); }
__device__ __forceinline__ float sigmoidf_(float x) { return __builtin_amdgcn_rcpf(1.f + __expf(-x)); }

#define XB_TMO      128
#define XB_XCNT(j)  (256  + 64 * (j))
#define XB_XSUB(j)  (1280 + 64 * (j))
#define XB_XGEN(j)  (2304 + 64 * (j))
#define XB_TOP      3328
#define XB_TOPGEN   3392
#define XCD_BAR_WORDS 3456
#define XB_SPIN_CAP (1u << 22)

__device__ __forceinline__ unsigned xb_ld(unsigned* p)              { return __hip_atomic_load(p, __ATOMIC_RELAXED, __HIP_MEMORY_SCOPE_AGENT); }
__device__ __forceinline__ unsigned xb_add(unsigned* p, unsigned v) { return __hip_atomic_fetch_add(p, v, __ATOMIC_RELAXED, __HIP_MEMORY_SCOPE_AGENT); }
__device__ __forceinline__ unsigned xb_xcc_id() { return (unsigned)__builtin_amdgcn_s_getreg((3 << 11) | 20) & 0xFu; }
#define XB_SPIN(cond, bar) do { unsigned _sp = 0; while (cond) { __builtin_amdgcn_s_sleep(1); \
    if ((++_sp & 255u) == 0u) { if (xb_ld(&(bar)[XB_TMO])) break; if (_sp > XB_SPIN_CAP) { atomicAdd(&(bar)[XB_TMO], 1u); break; } } } } while (0)

struct XcdBarrier { unsigned* bar; unsigned x; volatile LAS unsigned* st; };

__device__ __forceinline__ XcdBarrier xcd_barrier_post(unsigned* bar, volatile LAS unsigned* st) {
    XcdBarrier b; b.bar = bar; b.x = xb_xcc_id(); b.st = st;
    if (threadIdx.x == 0) (void)xb_add(&bar[XB_XCNT(b.x)], 1u);
    return b;
}
__device__ __forceinline__ void xcd_barrier_complete(unsigned* bar, unsigned x, unsigned& nloc, unsigned& nx) {
    const unsigned G = gridDim.x * gridDim.y * gridDim.z;
    unsigned sum, cnt, mine, sp = 0u;
    for (;;) {
        sum = 0u; cnt = 0u; mine = 0u;
#pragma unroll
        for (unsigned j = 0; j < 16; ++j) { const unsigned c = xb_ld(&bar[XB_XCNT(j)]); sum += c; cnt += (c > 0u) ? 1u : 0u; mine = (j == x) ? c : mine; }
        if (sum == G) break;
        __builtin_amdgcn_s_sleep(1);
        if ((++sp & 255u) == 0u) { if (xb_ld(&bar[XB_TMO])) break; if (sp > XB_SPIN_CAP) { atomicAdd(&bar[XB_TMO], 1u); break; } }
    }
    nloc = mine > 0u ? mine : 1u; nx = cnt > 0u ? cnt : 1u;
}
__device__ __forceinline__ void xcd_barrier(const XcdBarrier& b) {
    asm volatile("s_waitcnt vmcnt(0)" ::: "memory");
    __syncthreads();
    if (threadIdx.x == 0) {
        unsigned* bar = b.bar;
        __builtin_amdgcn_s_waitcnt(0);
        unsigned nloc = b.st[0], nx = b.st[1];
        if (nloc == 0u) { xcd_barrier_complete(bar, b.x, nloc, nx); b.st[0] = nloc; b.st[1] = nx; }
        const unsigned old = xb_add(&bar[XB_XSUB(b.x)], 1u);
        const unsigned gen = old / nloc;
        if (old + 1u == (gen + 1u) * nloc) {
            __builtin_amdgcn_fence(__ATOMIC_RELEASE, "agent");
            asm volatile("s_waitcnt vmcnt(0)" ::: "memory");
            const unsigned og = xb_add(&bar[XB_TOP], 1u);
            const unsigned tg = og / nx;
            if (og + 1u == (tg + 1u) * nx) xb_add(&bar[XB_TOPGEN], 1u);
            else XB_SPIN(xb_ld(&bar[XB_TOPGEN]) == tg, bar);
            __builtin_amdgcn_fence(__ATOMIC_ACQUIRE, "agent");
            xb_add(&bar[XB_XGEN(b.x)], 1u);
            asm volatile("s_waitcnt vmcnt(0)" ::: "memory");
        } else {
            XB_SPIN(xb_ld(&bar[XB_XGEN(b.x)]) == gen, bar);
            __builtin_amdgcn_fence(__ATOMIC_ACQUIRE, "agent");
            asm volatile("s_waitcnt vmcnt(0)" ::: "memory");
        }
    }
    __syncthreads();
}

struct Frame {
    LAS unsigned char* lds;
    volatile LAS unsigned* MISC;
    gu32* ctl;
    int tid, lane, wave;
    int G, bid;
    unsigned char* ws;
    const float *x, *norm_w, *w_in, *mu_rkv, *mu_lora, *w_decay_up, *w_decay_bias, *w_iclr_up, *w_iclr_bias, *k_k, *k_a, *r_k, *lnx_w, *lnx_b, *w_out, *final_norm_w;
    float* out;
};

__device__ __forceinline__ float wave_sum(float v) {
#pragma unroll
    for (int o = 1; o < 64; o <<= 1) v += __shfl_xor(v, o);
    return v;
}
__device__ __forceinline__ float wave_max(float v) {
#pragma unroll
    for (int o = 1; o < 64; o <<= 1) v = fmaxf(v, __shfl_xor(v, o));
    return v;
}

__device__ __forceinline__ int w1_src_col(int n) {
    if (n < 8192) {
        const int g = n >> 10, w = n & 1023;
        if (g == 5 || g == 6) {
            const int base = (g == 5) ? 4224 : 5248, hh = w >> 7, p = w & 127; int d = p;
            if (p < 32) { const int a = p >> 3, b = p & 7; d = (b < 4) ? (4 * a + b) : (16 + 4 * a + (b - 4)); }
            return base + hh * 128 + d;
        }
        const int base = (g == 0) ? 0 : (g == 1) ? 1024 : (g == 2) ? 2048 : (g == 3) ? 3200 : (g == 4) ? 7296 : 6272;
        return base + w;
    }
    if (n < 8320) return 3072 + (n - 8192);
    return -1;
}
template <bool MAP>
__device__ __forceinline__ void p0_transpose_item(const float* W, const float* rowscale, int K, int N, bf16* WT, int nblk, LAS float* scr, int item, int lane) {
    const int kb = item / nblk, nb = item % nblk, k0 = 64 * kb, n0 = 64 * nb, kq = lane >> 4, nq = lane & 15;
    const int nd = n0 + 4 * nq; const int src = MAP ? w1_src_col(nd) : nd;
    f32x4 v[16];
#pragma unroll
    for (int i = 0; i < 16; ++i) { const int k = k0 + 4 * i + kq; v[i] = (src >= 0) ? *(const GAS f32x4*)(W + (size_t)k * N + src) : (f32x4){0.f, 0.f, 0.f, 0.f}; if (MAP) v[i] = v[i] * rowscale[k]; }
#pragma unroll
    for (int i = 0; i < 16; ++i) { LAS float* d = scr + (4 * i + kq) * 65 + 4 * nq; d[0] = v[i].x; d[1] = v[i].y; d[2] = v[i].z; d[3] = v[i].w; }
    LDS_WAIT(); asm volatile("" ::: "memory");
    const int c = lane & 7;
#pragma unroll
    for (int j = 0; j < 8; ++j) { const int n = (lane >> 3) + 8 * j; const LAS float* sp = scr + (8 * c) * 65 + n;
        v4u o; o.x = pk2(sp[0 * 65], sp[1 * 65]); o.y = pk2(sp[2 * 65], sp[3 * 65]); o.z = pk2(sp[4 * 65], sp[5 * 65]); o.w = pk2(sp[6 * 65], sp[7 * 65]);
        *(GAS v4u*)(WT + (size_t)(n0 + n) * K + k0 + 8 * c) = o; }
    LDS_WAIT(); asm volatile("" ::: "memory");
}
__device__ __forceinline__ void rms_row_to_bf16(const float* xrow, bf16* orow, int lane) {
    const GAS f32x4* xr = (const GAS f32x4*)xrow + lane;
    f32x4 v[8]; float s = 0.f;
#pragma unroll
    for (int j = 0; j < 8; ++j) { v[j] = xr[64 * j]; s += (v[j].x * v[j].x + v[j].y * v[j].y) + (v[j].z * v[j].z + v[j].w * v[j].w); }
    const float rs = 1.f / sqrtf(wave_sum(s) * (1.f / D) + RMS_EPS);
    GAS unsigned long long* o8 = (GAS unsigned long long*)orow + lane;
#pragma unroll
    for (int j = 0; j < 8; ++j) o8[64 * j] = (unsigned long long)pk2(v[j].x * rs, v[j].y * rs) | ((unsigned long long)pk2(v[j].z * rs, v[j].w * rs) << 32);
}
__device__ __forceinline__ void p0_prologue(Frame& F) {
    LAS float* scr = (LAS float*)(F.lds + F.wave * 17408);
    const int gw = F.bid * NWAVES + F.wave, NGW = F.G * NWAVES;
    constexpr int I_1 = (D / 64) * (NPROJ / 64), I_2 = (D / 64) * (D / 64);
#pragma unroll 1
    for (int pass = 0; pass < 2; ++pass) {
        if ((pass == 0) == ((F.wave & 1) == 0)) {
            for (int it = gw; it < I_1 + I_2; it += NGW) {
                if (it < I_1) p0_transpose_item<true>(F.w_in, F.norm_w, D, DIN, (bf16*)(F.ws + WS_W1T), NPROJ / 64, scr, it, F.lane);
                else p0_transpose_item<false>(F.w_out, nullptr, D, D, (bf16*)(F.ws + WS_W2T), D / 64, scr, it - I_1, F.lane);
            }
        } else {
            for (int m = gw; m < T; m += NGW) rms_row_to_bf16(F.x + (size_t)m * D, (bf16*)(F.ws + WS_XN) + (size_t)m * D, F.lane);
        }
    }
    { bf16* wdt = (bf16*)(F.ws + 1 * MiB + 512 * 1024); bf16* wit = (bf16*)(F.ws + 1 * MiB + 640 * 1024);
      for (int e = F.bid * 512 + F.tid; e < 1024 * 64; e += F.G * 512) { const int c = e >> 6, l = e & 63; wdt[e] = (bf16)f2bf(F.w_decay_up[(size_t)l * 1024 + c]); wit[e] = (bf16)f2bf(F.w_iclr_up[(size_t)l * 1024 + c]); } }
    { float* rc = (float*)(F.ws + WS_ROPE); float* rsn = rc + (size_t)T * 16;
      for (int e = F.bid * 512 + F.tid; e < T * 16; e += F.G * 512) { const int t = e >> 4, i = e & 15;
          const double invf = exp2(-(double)i * (18.931568569324174 / 16.0));
          const double ang = (double)t * invf; const double n = rint(ang * 0.15915494309189535);
          double r = fma(-n, 6.283185307179586, ang); r = fma(-n, 2.4492935982947064e-16, r);
          const float rf = (float)r; rc[e] = cosf(rf); rsn[e] = sinf(rf); } }
}

__device__ __forceinline__ f32x4 mfma16(bf16x8 a, bf16x8 b, f32x4 c) { return __builtin_amdgcn_mfma_f32_16x16x32_bf16(a, b, c, 0, 0, 0); }
__device__ __forceinline__ int list_off(int h, int j) { return h * 516096 + 256 * (63 * j - (j * (j - 1)) / 2); }

__device__ __forceinline__ void p2_kmean(Frame& F) {
    const bf16* KM = (const bf16*)(F.ws + WS_KM); float* kmean = (float*)(F.ws + WS_KMEAN); bf16* kmeanb = (bf16*)(F.ws + WS_KMEANB);
    LAS float* red = (LAS float*)F.lds;
    const int dp = F.tid & 63, rg = F.tid >> 6;
    for (int u = F.bid; u < MB_NB * MB_H; u += F.G) { const int c = u >> 3, h = u & 7;
        float s0 = 0.f, s1 = 0.f;
        const unsigned* p = (const unsigned*)(KM + (size_t)(c * 256 + rg * 32) * 1024 + 128 * h) + dp;
#pragma unroll 8
        for (int r = 0; r < 32; ++r) { const unsigned w = p[(size_t)r * 512]; s0 += bflo(w); s1 += bfhi(w); }
        red[rg * 128 + 2 * dp] = s0; red[rg * 128 + 2 * dp + 1] = s1;
        __syncthreads();
        if (F.tid < 128) { float s = 0.f;
#pragma unroll
            for (int g = 0; g < 8; ++g) s += red[g * 128 + F.tid];
            s *= (1.f / 256.f); kmean[(size_t)(h * 64 + c) * 128 + F.tid] = s; kmeanb[(size_t)(h * 64 + c) * 128 + F.tid] = (bf16)f2bf(s); }
        __syncthreads();
    }
}

__device__ __forceinline__ void top3_insert(float v, int i, float& v1, int& i1, float& v2, int& i2, float& v3, int& i3) {
    const bool b1 = (v > v1) || (v == v1 && i < i1), b2 = (v > v2) || (v == v2 && i < i2), b3 = (v > v3) || (v == v3 && i < i3);
    const float n3 = b2 ? v2 : (b3 ? v : v3), n2 = b1 ? v1 : (b2 ? v : v2), n1 = b1 ? v : v1;
    const int m3 = b2 ? i2 : (b3 ? i : i3), m2 = b1 ? i1 : (b2 ? i : i2), m1 = b1 ? i : i1;
    v1 = n1; v2 = n2; v3 = n3; i1 = m1; i2 = m2; i3 = m3;
}
__device__ __forceinline__ void p3_gate(Frame& F) {
    const bf16* Q = (const bf16*)(F.ws + WS_Q); const float* kms = (const float*)(F.ws + WS_KMSUM);
    unsigned* cnt = (unsigned*)(F.ctl + CW_CNT); int* list = (int*)(F.ws + WS_LIST);
    const int gw = F.bid * NWAVES + F.wave, NGW = F.G * NWAVES, lane = F.lane, qi = lane & 15, g = lane >> 4;
    for (int u = gw; u < (T / 16) * MB_H; u += NGW) { const int qt = u >> 3, h = u & 7, cur = qt >> 4;
        if (cur == 0) continue;
        const int t = qt * 16 + qi;
        bf16x8 qf[4];
#pragma unroll
        for (int ks = 0; ks < 4; ++ks) qf[ks] = *(const bf16x8*)(Q + (size_t)t * 1024 + 128 * h + 32 * ks + 8 * g);
        float v1 = -INFINITY, v2 = -INFINITY, v3 = -INFINITY; int i1 = 1 << 20, i2 = 1 << 20, i3 = 1 << 20;
        const int njt = ((cur - 1) >> 4) + 1;
#pragma unroll
        for (int jt = 0; jt < 4; ++jt) { if (jt < njt) {
            f32x4 acc = (f32x4){0.f, 0.f, 0.f, 0.f};
#pragma unroll
            for (int ks = 0; ks < 4; ++ks) { const float* kp = kms + (size_t)(h * 64 + jt * 16 + qi) * 128 + 32 * ks + 8 * g; const f32x4 k0 = *(const GAS f32x4*)kp * (1.f / 256.f), k1 = *(const GAS f32x4*)(kp + 4) * (1.f / 256.f);
                const v4u aw = (v4u){pk2(k0[0], k0[1]), pk2(k0[2], k0[3]), pk2(k1[0], k1[1]), pk2(k1[2], k1[3])}; acc = mfma16(__builtin_bit_cast(bf16x8, aw), qf[ks], acc); }
#pragma unroll
            for (int r = 0; r < 4; ++r) { const int j = jt * 16 + 4 * g + r; const float v = (j < cur) ? acc[r] : -INFINITY; top3_insert(v, j, v1, i1, v2, i2, v3, i3); }
        } }
#pragma unroll
        for (int o = 16; o <= 32; o <<= 1) {
            const float a1 = __shfl_xor(v1, o), a2 = __shfl_xor(v2, o), a3 = __shfl_xor(v3, o); const int b1 = __shfl_xor(i1, o), b2 = __shfl_xor(i2, o), b3 = __shfl_xor(i3, o);
            top3_insert(a1, b1, v1, i1, v2, i2, v3, i3); top3_insert(a2, b2, v1, i1, v2, i2, v3, i3); top3_insert(a3, b3, v1, i1, v2, i2, v3, i3);
        }
        const int vc = cur < 3 ? cur : 3;
        if (g == 0) {
            if (vc > 0) { const unsigned pos = atomicAdd(&cnt[h * 64 + i1], 1u); list[list_off(h, i1) + pos] = (t << 2) | 0; }
            if (vc > 1) { const unsigned pos = atomicAdd(&cnt[h * 64 + i2], 1u); list[list_off(h, i2) + pos] = (t << 2) | 1; }
            if (vc > 2) { const unsigned pos = atomicAdd(&cnt[h * 64 + i3], 1u); list[list_off(h, i3) + pos] = (t << 2) | 2; }
        }
    }
}

constexpr int KV_STRIDE = 288;
constexpr int KLDS_OFF = 0, VLDS_OFF = 256 * KV_STRIDE, PFX_OFF = MISC_OFF + 1024;
__device__ __forceinline__ void tr_read2(s16x4& r0, s16x4& r1, unsigned a0, unsigned a1) {
    asm volatile("ds_read_b64_tr_b16 %0, %2\n\tds_read_b64_tr_b16 %1, %3\n\ts_waitcnt lgkmcnt(0)" : "=&v"(r0), "=&v"(r1) : "v"(a0), "v"(a1) : "memory"); }

template <int B0, int B1> __device__ __forceinline__ void tr_read16(s16x4 (&r)[16], unsigned base) {
    asm volatile(
        "ds_read_b64_tr_b16 %0, %16 offset:%17\n\tds_read_b64_tr_b16 %1, %16 offset:%18\n\tds_read_b64_tr_b16 %2, %16 offset:%19\n\tds_read_b64_tr_b16 %3, %16 offset:%20\n\t"
        "ds_read_b64_tr_b16 %4, %16 offset:%21\n\tds_read_b64_tr_b16 %5, %16 offset:%22\n\tds_read_b64_tr_b16 %6, %16 offset:%23\n\tds_read_b64_tr_b16 %7, %16 offset:%24\n\t"
        "ds_read_b64_tr_b16 %8, %16 offset:%25\n\tds_read_b64_tr_b16 %9, %16 offset:%26\n\tds_read_b64_tr_b16 %10, %16 offset:%27\n\tds_read_b64_tr_b16 %11, %16 offset:%28\n\t"
        "ds_read_b64_tr_b16 %12, %16 offset:%29\n\tds_read_b64_tr_b16 %13, %16 offset:%30\n\tds_read_b64_tr_b16 %14, %16 offset:%31\n\tds_read_b64_tr_b16 %15, %16 offset:%32\n\t"
        "s_waitcnt lgkmcnt(0)"
        : "=&v"(r[0]), "=&v"(r[1]), "=&v"(r[2]), "=&v"(r[3]), "=&v"(r[4]), "=&v"(r[5]), "=&v"(r[6]), "=&v"(r[7]), "=&v"(r[8]), "=&v"(r[9]), "=&v"(r[10]), "=&v"(r[11]), "=&v"(r[12]), "=&v"(r[13]), "=&v"(r[14]), "=&v"(r[15])
        : "v"(base), "i"(B0), "i"(B0 + 32), "i"(B0 + 64), "i"(B0 + 96), "i"(B0 + 128), "i"(B0 + 160), "i"(B0 + 192), "i"(B0 + 224),
          "i"(B1), "i"(B1 + 32), "i"(B1 + 64), "i"(B1 + 96), "i"(B1 + 128), "i"(B1 + 160), "i"(B1 + 192), "i"(B1 + 224)
        : "memory");
}
template <int S> __device__ __forceinline__ void pv_step(const f32x4& p0, const f32x4& p1, f32x4 (&o)[8], unsigned vb) {
    const v4u w = (v4u){pk2(p0[0], p0[1]), pk2(p0[2], p0[3]), pk2(p1[0], p1[1]), pk2(p1[2], p1[3])}; const bf16x8 pf = __builtin_bit_cast(bf16x8, w);
    s16x4 r[16]; tr_read16<32 * S * KV_STRIDE, (32 * S + 16) * KV_STRIDE>(r, vb);
#pragma unroll
    for (int dt = 0; dt < 8; ++dt) { const bf16x8 a = (bf16x8){r[dt][0], r[dt][1], r[dt][2], r[dt][3], r[8 + dt][0], r[8 + dt][1], r[8 + dt][2], r[8 + dt][3]}; o[dt] = mfma16(a, pf, o[dt]); }
}

__device__ __forceinline__ void p4_attn_items(Frame& F) {
    const bf16* Q = (const bf16*)(F.ws + WS_Q); const bf16* KM = (const bf16*)(F.ws + WS_KM); const bf16* VM = (const bf16*)(F.ws + WS_VM);
    const unsigned* cnt = (const unsigned*)(F.ctl + CW_CNT); const int* list = (const int*)(F.ws + WS_LIST);
    bf16* parto = (bf16*)(F.ws + WS_PARTO); float* partml = (float*)(F.ws + WS_PARTML);
    LAS int* pfx = (LAS int*)(F.lds + PFX_OFF);
    const int lane = F.lane, qi = lane & 15, g = lane >> 4, wv = F.wave;
    { LAS int* tmp = (LAS int*)(F.lds + PFX_OFF + 2560);
      const int c = (int)__hip_atomic_load(cnt + F.tid, RLX_AGENT); int val = ((c + 127) >> 7) + 2;
      __syncthreads();
      for (int d = 1; d < 512; d <<= 1) { tmp[F.tid] = val; __syncthreads(); if (F.tid >= d) val += tmp[F.tid - d]; __syncthreads(); }
      pfx[1 + F.tid] = val; if (F.tid == 0) pfx[0] = 0; }
    __syncthreads();
#define PFX(i) __builtin_amdgcn_readfirstlane(pfx[i])
    const int total = PFX(512);
    const int per = (total + F.G - 1) / F.G, lo = F.bid * per, hi = (lo + per < total) ? lo + per : total;
    if (lo >= hi) return;
    int u = 0; { int a = 0, b = 512; while (b - a > 1) { const int mid = (a + b) >> 1; if (PFX(mid) <= lo) a = mid; else b = mid; } u = a; }
    int loaded = -1;
    const float scale = 0.08838834764831845f;
#define P4_ENTRY(IT, UU, EN) do { const int it_ = (IT) < hi ? (IT) : hi - 1; while (it_ >= PFX(UU + 1)) ++UU; const int h_ = UU >> 6, j_ = UU & 63, tl_ = it_ - PFX(UU), ns_ = PFX(UU + 1) - PFX(UU) - 2; \
        if (tl_ >= ns_) EN = ((256 * j_ + 128 * (tl_ - ns_) + 16 * wv + qi) << 2) | 3; \
        else { const int n_ = (int)__hip_atomic_load(cnt + UU, RLX_AGENT); int e_ = tl_ * 128 + 16 * wv + qi; const bool ok_ = e_ < n_; if (!ok_) e_ = n_ - 1; const int en_ = list[list_off(h_, j_) + e_]; EN = ok_ ? en_ : (en_ | (int)0x80000000); } } while (0)
#define P4_QLOAD(QF, EN, UU) do { const int t_ = ((EN) & 0x7fffffff) >> 2; _Pragma("unroll") for (int ks = 0; ks < 4; ++ks) QF[ks] = *(const bf16x8*)(Q + (size_t)t_ * 1024 + 128 * ((UU) >> 6) + 32 * ks + 8 * g); } while (0)
    int u1 = u, u2 = u, en0, en1, en2 = 0; bf16x8 qf[4], qn[4];
    P4_ENTRY(lo, u, en0); u1 = u; P4_ENTRY(lo + 1, u1, en1); u2 = u1;
    P4_QLOAD(qf, en0, u);
    for (int it = lo; it < hi; ++it) {
        P4_QLOAD(qn, en1, u1);
        P4_ENTRY(it + 2, u2, en2);
        const int h = u >> 6, j = u & 63, tl = it - PFX(u), nsel = PFX(u + 1) - PFX(u) - 2;
        if (u != loaded) {
            __syncthreads();
#pragma unroll
            for (int i = 0; i < 8; ++i) { const int pz = F.tid + 512 * i, row = pz >> 4, cc = pz & 15;
                const v4u kv = *(const GAS v4u*)(KM + (size_t)(256 * j + row) * 1024 + 128 * h + 8 * cc); const v4u vv = *(const GAS v4u*)(VM + (size_t)(256 * j + row) * 1024 + 128 * h + 8 * cc);
                *(LAS v4u*)(F.lds + KLDS_OFF + row * KV_STRIDE + 16 * cc) = kv; *(LAS v4u*)(F.lds + VLDS_OFF + row * KV_STRIDE + 16 * cc) = vv; }
            __syncthreads();
            loaded = u;
        }
        const bool own = tl >= nsel; const int hf = tl - nsel;
        const int t = (en0 & 0x7fffffff) >> 2, slot = en0 & 3; const bool valid = en0 >= 0;
        const int nkt = own ? (8 * hf + wv + 1) : 16;
        f32x4 acc[16];
#pragma unroll
        for (int kt = 0; kt < 16; ++kt) { acc[kt] = (f32x4){0.f, 0.f, 0.f, 0.f};
            if (kt < nkt) {
#pragma unroll
                for (int ks = 0; ks < 4; ++ks) { const bf16x8 a = *(const LAS bf16x8*)(F.lds + KLDS_OFF + (16 * kt + qi) * KV_STRIDE + 64 * ks + 16 * g); acc[kt] = mfma16(a, qf[ks], acc[kt]); } } }
        const int tq = t - 256 * j;
        float m = -INFINITY;
#pragma unroll
        for (int kt = 0; kt < 16; ++kt)
#pragma unroll
            for (int r = 0; r < 4; ++r) { float s = acc[kt][r] * scale; const int key = 16 * kt + 4 * g + r; if (kt >= nkt || (own && key > tq)) s = -INFINITY; acc[kt][r] = s; m = fmaxf(m, s); }
        m = fmaxf(m, __shfl_xor(m, 16)); m = fmaxf(m, __shfl_xor(m, 32));
        float l = 0.f;
#pragma unroll
        for (int kt = 0; kt < 16; ++kt)
#pragma unroll
            for (int r = 0; r < 4; ++r) { const float p = __expf(acc[kt][r] - m); acc[kt][r] = p; l += p; }
        l += __shfl_xor(l, 16); l += __shfl_xor(l, 32);
        f32x4 o[8];
#pragma unroll
        for (int dt = 0; dt < 8; ++dt) o[dt] = (f32x4){0.f, 0.f, 0.f, 0.f};
        const unsigned vb0 = (unsigned)(VLDS_OFF + (4 * g + (qi >> 2)) * KV_STRIDE + 8 * (qi & 3)), vb1 = vb0 + 128u * KV_STRIDE;
        if (0 < nkt) pv_step<0>(acc[0], acc[1], o, vb0);
        if (2 < nkt) pv_step<1>(acc[2], acc[3], o, vb0);
        if (4 < nkt) pv_step<2>(acc[4], acc[5], o, vb0);
        if (6 < nkt) pv_step<3>(acc[6], acc[7], o, vb0);
        if (8 < nkt) pv_step<0>(acc[8], acc[9], o, vb1);
        if (10 < nkt) pv_step<1>(acc[10], acc[11], o, vb1);
        if (12 < nkt) pv_step<2>(acc[12], acc[13], o, vb1);
        if (14 < nkt) pv_step<3>(acc[14], acc[15], o, vb1);
        if (valid) { const float il = 1.f / l; const size_t pb = ((size_t)t * 8 + h) * 4 + slot;
#pragma unroll
            for (int dt = 0; dt < 8; ++dt) { v2u w; w.x = pk2(o[dt][0] * il, o[dt][1] * il); w.y = pk2(o[dt][2] * il, o[dt][3] * il); *(GAS v2u*)(parto + pb * 128 + 16 * dt + 4 * g) = w; }
            if (g == 0) { f32x2 ml; ml.x = m; ml.y = l; *(GAS f32x2*)(partml + pb * 2) = ml; } }
        en0 = en1; en1 = en2; u = u1; u1 = u2;
#pragma unroll
        for (int ks = 0; ks < 4; ++ks) qf[ks] = qn[ks];
    }
#undef P4_ENTRY
#undef P4_QLOAD
#undef PFX
}

__device__ __forceinline__ void p5_combine(Frame& F) {
    const bf16* parto = (const bf16*)(F.ws + WS_PARTO); const float* partml = (const float*)(F.ws + WS_PARTML); const bf16* GM = (const bf16*)(F.ws + WS_GM);
    bf16* mixed = (bf16*)(F.ws + WS_MIXED);
    const int gw = F.bid * NWAVES + F.wave, NGW = F.G * NWAVES, sub = F.lane >> 4, d0 = 8 * (F.lane & 15);
    for (int pq = gw; pq < T * MB_H / 4; pq += NGW) { const int pr = pq * 4 + sub, t = pr >> 3, h = pr & 7, cur = t >> 8, vc = cur < 3 ? cur : 3;
        float mm[4], ll[4]; float M = -INFINITY;
#pragma unroll
        for (int s = 0; s < 4; ++s) { const bool on = (s == 3) || (s < vc); f32x2 ml = (f32x2){-INFINITY, 0.f}; if (on) ml = *(const GAS f32x2*)(partml + ((size_t)pr * 4 + s) * 2); mm[s] = ml.x; ll[s] = ml.y; M = fmaxf(M, ml.x); }
        float acc[8]; float W = 0.f;
#pragma unroll
        for (int e = 0; e < 8; ++e) acc[e] = 0.f;
#pragma unroll
        for (int s = 0; s < 4; ++s) { const bool on = (s == 3) || (s < vc); if (on) { const float w = __expf(mm[s] - M) * ll[s]; W += w;
            const v4u ov = *(const GAS v4u*)(parto + ((size_t)pr * 4 + s) * 128 + d0);
            acc[0] += w * bflo(ov.x); acc[1] += w * bfhi(ov.x); acc[2] += w * bflo(ov.y); acc[3] += w * bfhi(ov.y); acc[4] += w * bflo(ov.z); acc[5] += w * bfhi(ov.z); acc[6] += w * bflo(ov.w); acc[7] += w * bfhi(ov.w); } }
        const float iw = 1.f / W;
        const v4u gv = *(const GAS v4u*)(GM + (size_t)t * 1024 + 128 * h + d0);
        const float gg[8] = {bflo(gv.x), bfhi(gv.x), bflo(gv.y), bfhi(gv.y), bflo(gv.z), bfhi(gv.z), bflo(gv.w), bfhi(gv.w)};
        float r[8];
#pragma unroll
        for (int e = 0; e < 8; ++e) r[e] = acc[e] * iw * gg[e] * sigmoidf_(gg[e]);
        v4u w; w.x = pk2(r[0], r[1]); w.y = pk2(r[2], r[3]); w.z = pk2(r[4], r[5]); w.w = pk2(r[6], r[7]);
        *(GAS v4u*)(mixed + (size_t)t * 2048 + 1024 + 128 * h + d0) = w;
    }
}

constexpr size_t WS_SR = 52 * MiB;
constexpr size_t WS_SA = 16 * MiB;
constexpr size_t WS_SK = 376 * MiB;
constexpr size_t WS_SV = 440 * MiB;
constexpr size_t WS_SB = WS_GM;
constexpr size_t WS_SW = WS_VM;
constexpr size_t WS_YS = WS_R;

__device__ __forceinline__ void p6_rwkv_prep(Frame& F) {
    const bf16* R = (const bf16*)(F.ws + WS_R); const bf16* K = (const bf16*)(F.ws + WS_K); const bf16* V = (const bf16*)(F.ws + WS_V); const bf16* WDAD = (const bf16*)(F.ws + WS_WDAD);
    float* SR = (float*)(F.ws + WS_SR); float* SK = (float*)(F.ws + WS_SK); float* SV = (float*)(F.ws + WS_SV);
    bf16* SA = (bf16*)(F.ws + WS_SA); bf16* SB = (bf16*)(F.ws + WS_SB); bf16* SW = (bf16*)(F.ws + WS_SW); float* BSC = (float*)(F.ws + WS_BSC);
    LAS float* WD = (LAS float*)(F.lds);
    LAS float* WI = (LAS float*)(F.lds + 16384);
    LAS float* Rs = (LAS float*)(F.lds + 32768);
    LAS float* Ks = (LAS float*)(F.lds + 49152);
    LAS float* TW = (LAS float*)(F.lds + 65536);
    LAS float* AD = (LAS float*)(F.lds + 81920);
    constexpr int NU = RW_H * (T / 64);
    const int upw = (NU + F.G - 1) / F.G;
    const int c = F.tid & 63, tg = F.tid >> 6;
    int hl_ = -1; float kkc = 0.f, kac = 0.f, rkc = 0.f, wb = 0.f, ib = 0.f;
    for (int ui = 0; ui < upw; ++ui) { const int u = F.bid * upw + ui; if (u >= NU) break; const int h = u / (T / 64), chunk = u % (T / 64), t0 = chunk * 64, ch = 64 * h + c;
        __syncthreads();
        if (h != hl_) { hl_ = h;
            for (int e = F.tid; e < 64 * 64; e += 512) { const int l = e >> 6, cc = e & 63; WD[e] = F.w_decay_up[(size_t)l * 1024 + 64 * h + cc]; WI[e] = F.w_iclr_up[(size_t)l * 1024 + 64 * h + cc]; }
            kkc = F.k_k[ch]; kac = F.k_a[ch]; rkc = F.r_k[ch]; wb = F.w_decay_bias[ch]; ib = F.w_iclr_bias[ch]; }
        { const int row = F.tid >> 3, cv = F.tid & 7, t = t0 + row; const size_t o = (size_t)t * 1024 + 64 * h + 8 * cv;
          const v4u z = (v4u){0u, 0u, 0u, 0u};
          const v4u rc = *(const GAS v4u*)(R + o), kc = *(const GAS v4u*)(K + o), vc = *(const GAS v4u*)(V + o);
          const v4u rp = t > 0 ? *(const GAS v4u*)(R + o - 1024) : z, kp = t > 0 ? *(const GAS v4u*)(K + o - 1024) : z, vp = t > 0 ? *(const GAS v4u*)(V + o - 1024) : z;
          const unsigned rcw[4] = {rc.x, rc.y, rc.z, rc.w}, rpw[4] = {rp.x, rp.y, rp.z, rp.w}, kcw[4] = {kc.x, kc.y, kc.z, kc.w}, kpw[4] = {kp.x, kp.y, kp.z, kp.w}, vcw[4] = {vc.x, vc.y, vc.z, vc.w}, vpw[4] = {vp.x, vp.y, vp.z, vp.w};
          float vs[8];
#pragma unroll
          for (int q = 0; q < 4; ++q) {
#pragma unroll
              for (int hl = 0; hl < 2; ++hl) { const int cc = 8 * cv + 2 * q + hl, chn = 64 * h + cc;
                  const float r0 = hl ? bfhi(rcw[q]) : bflo(rcw[q]), r1 = hl ? bfhi(rpw[q]) : bflo(rpw[q]);
                  const float k0 = hl ? bfhi(kcw[q]) : bflo(kcw[q]), k1 = hl ? bfhi(kpw[q]) : bflo(kpw[q]);
                  const float v0 = hl ? bfhi(vcw[q]) : bflo(vcw[q]), v1 = hl ? bfhi(vpw[q]) : bflo(vpw[q]);
                  Rs[row * 64 + cc] = r0 + F.mu_rkv[chn] * (r1 - r0); Ks[row * 64 + cc] = k0 + F.mu_rkv[1024 + chn] * (k1 - k0); vs[2 * q + hl] = v0 + F.mu_rkv[2048 + chn] * (v1 - v0); } }
          *(GAS f32x4*)(SV + o) = (f32x4){vs[0], vs[1], vs[2], vs[3]}; *(GAS f32x4*)(SV + o + 4) = (f32x4){vs[4], vs[5], vs[6], vs[7]};
#pragma unroll
          for (int part = 0; part < 2; ++part) { const int lv = 8 * cv + 64 * part;
              const v4u wc4 = *(const GAS v4u*)(WDAD + (size_t)t * 128 + lv); const v4u wp4 = t > 0 ? *(const GAS v4u*)(WDAD + (size_t)(t - 1) * 128 + lv) : z;
              const unsigned cw[4] = {wc4.x, wc4.y, wc4.z, wc4.w}, pw[4] = {wp4.x, wp4.y, wp4.z, wp4.w};
#pragma unroll
              for (int q = 0; q < 4; ++q)
#pragma unroll
                  for (int hl = 0; hl < 2; ++hl) { const int l = 8 * cv + 2 * q + hl; const float x0 = hl ? bfhi(cw[q]) : bflo(cw[q]), x1 = hl ? bfhi(pw[q]) : bflo(pw[q]);
                      const float xs = x0 + F.mu_lora[64 * part + l] * (x1 - x0);
                      if (part == 0) TW[row * 64 + l] = tanhf(xs); else AD[row * 64 + l] = xs; } } }
        __syncthreads();
        float aw[8], ai[8];
#pragma unroll
        for (int r = 0; r < 8; ++r) { aw[r] = 0.f; ai[r] = 0.f; }
        for (int l4 = 0; l4 < 16; ++l4) {
            const float wd0 = WD[(4 * l4 + 0) * 64 + c], wd1 = WD[(4 * l4 + 1) * 64 + c], wd2 = WD[(4 * l4 + 2) * 64 + c], wd3 = WD[(4 * l4 + 3) * 64 + c];
            const float wi0 = WI[(4 * l4 + 0) * 64 + c], wi1 = WI[(4 * l4 + 1) * 64 + c], wi2 = WI[(4 * l4 + 2) * 64 + c], wi3 = WI[(4 * l4 + 3) * 64 + c];
#pragma unroll
            for (int r = 0; r < 8; ++r) { const f32x4 tw = *(const LAS f32x4*)(TW + (8 * tg + r) * 64 + 4 * l4); const f32x4 ad = *(const LAS f32x4*)(AD + (8 * tg + r) * 64 + 4 * l4);
                aw[r] += tw.x * wd0 + tw.y * wd1 + tw.z * wd2 + tw.w * wd3; ai[r] += ad.x * wi0 + ad.y * wi1 + ad.z * wi2 + ad.w * wi3; }
        }
#pragma unroll
        for (int r = 0; r < 8; ++r) { const int row = 8 * tg + r, t = t0 + row; const size_t o = (size_t)t * 1024 + ch;
            const float lw = -0.6065306597126334f * sigmoidf_(wb + aw[r]);
            const float ic = sigmoidf_(ib + ai[r]);
            const float kr = Ks[row * 64 + c], rr = Rs[row * 64 + c];
            const float kk = kr * kkc; const float nrm = sqrtf(wave_sum(kk * kk)); const float kkn = kk / fmaxf(nrm, 1e-12f);
            const float kp = kr * (1.f + (ic - 1.f) * kac);
            const float bs = wave_sum(rr * kp * rkc);
            SR[o] = rr; SK[o] = kp; SA[o] = (bf16)f2bf(-kkn); SB[o] = (bf16)f2bf(kkn * ic); SW[o] = (bf16)f2bf(lw);
            if (c == 0) BSC[(size_t)t * 16 + h] = bs; }
    }
}

__device__ __forceinline__ float dpp_add16(float x) {
    x += __builtin_bit_cast(float, __builtin_amdgcn_update_dpp(0, __builtin_bit_cast(int, x), 0xB1, 0xf, 0xf, false));
    x += __builtin_bit_cast(float, __builtin_amdgcn_update_dpp(0, __builtin_bit_cast(int, x), 0x4E, 0xf, 0xf, false));
    x += __builtin_bit_cast(float, __builtin_amdgcn_update_dpp(0, __builtin_bit_cast(int, x), 0x141, 0xf, 0xf, false));
    x += __builtin_bit_cast(float, __builtin_amdgcn_update_dpp(0, __builtin_bit_cast(int, x), 0x140, 0xf, 0xf, false));
    return x;
}
constexpr int SC_CH = 64;
__device__ __forceinline__ void p7_rwkv_scan(Frame& F) {
    if (F.bid >= 32) return;
    const float* SR = (const float*)(F.ws + WS_SR); const float* SK = (const float*)(F.ws + WS_SK); const float* SV = (const float*)(F.ws + WS_SV);
    const bf16* SA = (const bf16*)(F.ws + WS_SA); const bf16* SB = (const bf16*)(F.ws + WS_SB); const bf16* SW = (const bf16*)(F.ws + WS_SW); float* Y = (float*)(F.ws + WS_YS);
    const int h = F.bid >> 1, i0 = 32 * (F.bid & 1);
    LAS float* Lr = (LAS float*)(F.lds);
    LAS float* Lk = (LAS float*)(F.lds + 16384);
    LAS float* La = (LAS float*)(F.lds + 32768);
    LAS float* Lb = (LAS float*)(F.lds + 49152);
    LAS float* Lw = (LAS float*)(F.lds + 65536);
    LAS float* Lv = (LAS float*)(F.lds + 81920);
    const int jg = F.lane & 15, rl = 4 * F.wave + (F.lane >> 4);
    f32x4 st = (f32x4){0.f, 0.f, 0.f, 0.f};
    const int srow = F.tid >> 3, scv = F.tid & 7;
    for (int t0 = 0; t0 < T; t0 += SC_CH) {
        __syncthreads();
        { const size_t o = (size_t)(t0 + srow) * 1024 + 64 * h + 8 * scv;
          const f32x4 r0 = *(const GAS f32x4*)(SR + o), r1 = *(const GAS f32x4*)(SR + o + 4), k0 = *(const GAS f32x4*)(SK + o), k1 = *(const GAS f32x4*)(SK + o + 4);
          const v4u a4 = *(const GAS v4u*)(SA + o), b4 = *(const GAS v4u*)(SB + o), w4 = *(const GAS v4u*)(SW + o);
          const f32x4 vv = *(const GAS f32x4*)(SV + (size_t)(t0 + srow) * 1024 + 64 * h + i0 + 4 * scv);
          LAS float* d = Lr + srow * 64 + 8 * scv; *(LAS f32x4*)d = r0; *(LAS f32x4*)(d + 4) = r1;
          d = Lk + srow * 64 + 8 * scv; *(LAS f32x4*)d = k0; *(LAS f32x4*)(d + 4) = k1;
          d = La + srow * 64 + 8 * scv; *(LAS f32x4*)d = (f32x4){bflo(a4.x), bfhi(a4.x), bflo(a4.y), bfhi(a4.y)}; *(LAS f32x4*)(d + 4) = (f32x4){bflo(a4.z), bfhi(a4.z), bflo(a4.w), bfhi(a4.w)};
          d = Lb + srow * 64 + 8 * scv; *(LAS f32x4*)d = (f32x4){bflo(b4.x), bfhi(b4.x), bflo(b4.y), bfhi(b4.y)}; *(LAS f32x4*)(d + 4) = (f32x4){bflo(b4.z), bfhi(b4.z), bflo(b4.w), bfhi(b4.w)};
          d = Lw + srow * 64 + 8 * scv; *(LAS f32x4*)d = (f32x4){__expf(bflo(w4.x)), __expf(bfhi(w4.x)), __expf(bflo(w4.y)), __expf(bfhi(w4.y))}; *(LAS f32x4*)(d + 4) = (f32x4){__expf(bflo(w4.z)), __expf(bfhi(w4.z)), __expf(bflo(w4.w)), __expf(bfhi(w4.w))};
          *(LAS f32x4*)(Lv + srow * 32 + 4 * scv) = vv; }
        __syncthreads();
#pragma unroll 2
        for (int s = 0; s < SC_CH; ++s) {
            const f32x4 a = *(const LAS f32x4*)(La + s * 64 + 4 * jg), b = *(const LAS f32x4*)(Lb + s * 64 + 4 * jg), w = *(const LAS f32x4*)(Lw + s * 64 + 4 * jg);
            const f32x4 k = *(const LAS f32x4*)(Lk + s * 64 + 4 * jg), r = *(const LAS f32x4*)(Lr + s * 64 + 4 * jg); const float vi = Lv[s * 32 + rl];
            const float sa = dpp_add16((st.x * a.x + st.y * a.y) + (st.z * a.z + st.w * a.w));
            st = st * w + (b * sa + k * vi);
            const float y = dpp_add16((st.x * r.x + st.y * r.y) + (st.z * r.z + st.w * r.w));
            if (jg == 0) Y[(size_t)(t0 + s) * 1024 + 64 * h + i0 + rl] = y;
        }
    }
}

__device__ __forceinline__ void p8_rwkv_final(Frame& F) {
    const float* Y = (const float*)(F.ws + WS_YS); const float* SV = (const float*)(F.ws + WS_SV); const float* BSC = (const float*)(F.ws + WS_BSC); const bf16* GR = (const bf16*)(F.ws + WS_GR);
    bf16* mixed = (bf16*)(F.ws + WS_MIXED);
    const int gw = F.bid * NWAVES + F.wave, NGW = F.G * NWAVES, c0 = 16 * F.lane, hd = F.lane >> 2;
    for (int t = gw; t < T; t += NGW) {
        float y[16]; float s = 0.f;
#pragma unroll
        for (int q = 0; q < 4; ++q) { const f32x4 v = *(const GAS f32x4*)(Y + (size_t)t * 1024 + c0 + 4 * q); y[4 * q] = v.x; y[4 * q + 1] = v.y; y[4 * q + 2] = v.z; y[4 * q + 3] = v.w; s += (v.x + v.y) + (v.z + v.w); }
        s += __shfl_xor(s, 1); s += __shfl_xor(s, 2);
        const float mean = s * (1.f / 64.f); float q2 = 0.f;
#pragma unroll
        for (int e = 0; e < 16; ++e) { y[e] -= mean; q2 += y[e] * y[e]; }
        q2 += __shfl_xor(q2, 1); q2 += __shfl_xor(q2, 2);
        const float rstd = 1.f / sqrtf(q2 * (1.f / 64.f) + LNX_EPS);
        const float bs = BSC[(size_t)t * 16 + hd];
        const v4u g0 = *(const GAS v4u*)(GR + (size_t)t * 1024 + c0), g1 = *(const GAS v4u*)(GR + (size_t)t * 1024 + c0 + 8);
        const float gg[16] = {bflo(g0.x), bfhi(g0.x), bflo(g0.y), bfhi(g0.y), bflo(g0.z), bfhi(g0.z), bflo(g0.w), bfhi(g0.w), bflo(g1.x), bfhi(g1.x), bflo(g1.y), bfhi(g1.y), bflo(g1.z), bfhi(g1.z), bflo(g1.w), bfhi(g1.w)};
        float r[16];
#pragma unroll
        for (int q = 0; q < 4; ++q) { const f32x4 v = *(const GAS f32x4*)(SV + (size_t)t * 1024 + c0 + 4 * q); const f32x4 lw = *(const GAS f32x4*)(F.lnx_w + c0 + 4 * q), lb = *(const GAS f32x4*)(F.lnx_b + c0 + 4 * q);
            const float vv[4] = {v.x, v.y, v.z, v.w}, lww[4] = {lw.x, lw.y, lw.z, lw.w}, lbb[4] = {lb.x, lb.y, lb.z, lb.w};
#pragma unroll
            for (int e = 0; e < 4; ++e) { const int i = 4 * q + e; const float o = y[i] * rstd * lww[e] + lbb[e] + bs * vv[e]; r[i] = o * gg[i] * sigmoidf_(gg[i]); } }
        v4u w0, w1; w0.x = pk2(r[0], r[1]); w0.y = pk2(r[2], r[3]); w0.z = pk2(r[4], r[5]); w0.w = pk2(r[6], r[7]); w1.x = pk2(r[8], r[9]); w1.y = pk2(r[10], r[11]); w1.z = pk2(r[12], r[13]); w1.w = pk2(r[14], r[15]);
        *(GAS v4u*)(mixed + (size_t)t * 2048 + c0) = w0; *(GAS v4u*)(mixed + (size_t)t * 2048 + c0 + 8) = w1;
    }
}

constexpr size_t WS_WDT = 1 * MiB + 512 * 1024;
constexpr size_t WS_WIT = 1 * MiB + 640 * 1024;
constexpr size_t WS_PB = 16 * MiB;
constexpr size_t WS_QC = 52 * MiB;
constexpr size_t WS_HT = 84 * MiB;
constexpr size_t WS_GT = 376 * MiB;
constexpr size_t WS_Y0T = 440 * MiB;
constexpr int IMS = 144;
constexpr int L_AT = 0, L_RT = 9216, L_BT = 18432, L_KT = 27648, L_BHT = 36864, L_KHT = 46080, L_VT = 55296, L_XT = 64512;
constexpr int L_RA = 82944;
constexpr int L_TW = L_RA, L_AD = L_RA + 9216, L_WP = L_RA + 18432, L_AP = L_WP + 16640;
constexpr int L_LAB = L_RA, L_LAK = L_RA + 17408, L_MRB = L_LAK + 9216, L_MRK = L_MRB + 9216, L_TII = L_MRK + 9216;
constexpr int L_CUMP = 134656, L_GC = L_CUMP + 2048;
constexpr int L_NRM = 136960;
constexpr int L_PAR = 137216;

__device__ __forceinline__ f32x4 mfma4f(float a, float b, f32x4 c) { return __builtin_amdgcn_mfma_f32_16x16x4f32(a, b, c, 0, 0, 0); }
__device__ __forceinline__ bf16x8 lds_frag(LAS unsigned char* img, int row, int ks, int g) { return *(const LAS bf16x8*)(img + row * IMS + 64 * ks + 16 * g); }

__device__ __forceinline__ float wave_sum_dpp(float x) {
    x = dpp_add16(x);
    x += __builtin_bit_cast(float, __builtin_amdgcn_update_dpp(0, __builtin_bit_cast(int, x), 0x142, 0xa, 0xf, false));
    x += __builtin_bit_cast(float, __builtin_amdgcn_update_dpp(0, __builtin_bit_cast(int, x), 0x143, 0xc, 0xf, false));
    return __builtin_bit_cast(float, __builtin_amdgcn_readlane(__builtin_bit_cast(int, x), 63));
}
struct R1In { v4u wd0, wd1, wp0, wp1, rc, rp, kc, kp, vc, vp; };
__device__ __forceinline__ void r1_load(Frame& F, int h, int chunk, R1In& in) {
    const bf16* R = (const bf16*)(F.ws + WS_R); const bf16* K = (const bf16*)(F.ws + WS_K); const bf16* V = (const bf16*)(F.ws + WS_V); const bf16* WDAD = (const bf16*)(F.ws + WS_WDAD);
    const int row = F.tid >> 3, cv = F.tid & 7, t = chunk * 64 + row; const size_t o = (size_t)t * 1024 + 64 * h + 8 * cv; const v4u z4 = (v4u){0u, 0u, 0u, 0u};
    in.wd0 = *(const GAS v4u*)(WDAD + (size_t)t * 128 + 8 * cv); in.wd1 = *(const GAS v4u*)(WDAD + (size_t)t * 128 + 64 + 8 * cv);
    in.rc = *(const GAS v4u*)(R + o); in.kc = *(const GAS v4u*)(K + o); in.vc = *(const GAS v4u*)(V + o);
    if (t > 0) { in.wp0 = *(const GAS v4u*)(WDAD + (size_t)(t - 1) * 128 + 8 * cv); in.wp1 = *(const GAS v4u*)(WDAD + (size_t)(t - 1) * 128 + 64 + 8 * cv);
        in.rp = *(const GAS v4u*)(R + o - 1024); in.kp = *(const GAS v4u*)(K + o - 1024); in.vp = *(const GAS v4u*)(V + o - 1024); }
    else { in.wp0 = z4; in.wp1 = z4; in.rp = z4; in.kp = z4; in.vp = z4; }
}
constexpr int L_RS = L_AT, L_KS = L_BT, L_VS = L_BHT;

__device__ __forceinline__ void r1_unit(Frame& F, int h, int chunk, R1In& in, const bf16x8 (&wfr)[2][2][2], int un) {
    float* BSC = (float*)(F.ws + WS_BSC);
    LAS unsigned char* L = F.lds; const LAS float* PAR = (const LAS float*)(L + L_PAR);
    int tid = F.tid; asm volatile("" : "+v"(tid));
    const int t0 = chunk * 64, u = h * 256 + chunk, lane = tid & 63, wv = __builtin_amdgcn_readfirstlane(tid >> 6), fr = lane & 15, g = lane >> 4;
    __syncthreads();
    { const int row = tid >> 3, cv = tid & 7;
#pragma unroll
      for (int part = 0; part < 2; ++part) { const v4u wc4 = part ? in.wd1 : in.wd0, wp4 = part ? in.wp1 : in.wp0;
          const unsigned cw[4] = {wc4.x, wc4.y, wc4.z, wc4.w}, pw[4] = {wp4.x, wp4.y, wp4.z, wp4.w}; unsigned ow[4];
#pragma unroll
          for (int q = 0; q < 4; ++q) { float xs[2];
#pragma unroll
              for (int hl = 0; hl < 2; ++hl) { const int l = 8 * cv + 2 * q + hl; const float x0 = hl ? bfhi(cw[q]) : bflo(cw[q]), x1 = hl ? bfhi(pw[q]) : bflo(pw[q]);
                  xs[hl] = x0 + PAR[192 + 64 * part + l] * (x1 - x0); if (part == 0) { const float e2 = __expf(2.f * xs[hl]); xs[hl] = 1.f - 2.f / (e2 + 1.f); } }
              ow[q] = pk2(xs[0], xs[1]); }
          *(LAS v4u*)(L + (part == 0 ? L_TW : L_AD) + row * IMS + 16 * cv) = (v4u){ow[0], ow[1], ow[2], ow[3]}; }
      const unsigned rcw[4] = {in.rc.x, in.rc.y, in.rc.z, in.rc.w}, rpw[4] = {in.rp.x, in.rp.y, in.rp.z, in.rp.w}, kcw[4] = {in.kc.x, in.kc.y, in.kc.z, in.kc.w}, kpw[4] = {in.kp.x, in.kp.y, in.kp.z, in.kp.w},
                     vcw[4] = {in.vc.x, in.vc.y, in.vc.z, in.vc.w}, vpw[4] = {in.vp.x, in.vp.y, in.vp.z, in.vp.w};
      float nrm2 = 0.f;
#pragma unroll
      for (int q = 0; q < 4; ++q)
#pragma unroll
          for (int hl = 0; hl < 2; ++hl) { const int cc = 8 * cv + 2 * q + hl;
              const float r0 = hl ? bfhi(rcw[q]) : bflo(rcw[q]), r1 = hl ? bfhi(rpw[q]) : bflo(rpw[q]), k0 = hl ? bfhi(kcw[q]) : bflo(kcw[q]), k1 = hl ? bfhi(kpw[q]) : bflo(kpw[q]);
              const float v0 = hl ? bfhi(vcw[q]) : bflo(vcw[q]), v1 = hl ? bfhi(vpw[q]) : bflo(vpw[q]);
              const float ksh = k0 + PAR[64 + cc] * (k1 - k0), kkv = ksh * PAR[320 + cc]; nrm2 += kkv * kkv;
              ((LAS float*)(L + L_RS))[row * 65 + cc] = r0 + PAR[cc] * (r1 - r0); ((LAS float*)(L + L_KS))[row * 65 + cc] = ksh;
              ((LAS float*)(L + L_VS))[row * 65 + cc] = v0 + PAR[128 + cc] * (v1 - v0); }
      nrm2 += __builtin_bit_cast(float, __builtin_amdgcn_update_dpp(0, __builtin_bit_cast(int, nrm2), 0xB1, 0xf, 0xf, false));
      nrm2 += __builtin_bit_cast(float, __builtin_amdgcn_update_dpp(0, __builtin_bit_cast(int, nrm2), 0x4E, 0xf, 0xf, false));
      nrm2 += __builtin_bit_cast(float, __builtin_amdgcn_update_dpp(0, __builtin_bit_cast(int, nrm2), 0x141, 0xf, 0xf, false));
      if (cv == 0) ((LAS float*)(L + L_NRM))[row] = __builtin_amdgcn_rsqf(fmaxf(nrm2, 1e-24f)); }
    if (un >= 0) r1_load(F, un >> 8, un & 255, in);
    __syncthreads();
    { const int tr = wv >> 1;
#pragma unroll
      for (int prod = 0; prod < 2; ++prod) { LAS unsigned char* aimg = L + (prod == 0 ? L_TW : L_AD); LAS float* o = (LAS float*)(L + (prod == 0 ? L_WP : L_AP));
#pragma unroll
          for (int cc = 0; cc < 2; ++cc) { const int ct = (wv & 1) * 2 + cc; f32x4 acc = (f32x4){0.f, 0.f, 0.f, 0.f};
#pragma unroll
              for (int ks = 0; ks < 2; ++ks) acc = mfma16(lds_frag(aimg, 16 * tr + fr, ks, g), wfr[prod][cc][ks], acc);
#pragma unroll
              for (int r = 0; r < 4; ++r) o[(16 * tr + 4 * g + r) * 65 + 16 * ct + fr] = acc[r]; } } }
    __syncthreads();
    { const int c = tid & 63, tg = tid >> 6, ch = 64 * h + c;
      const float kkc = PAR[320 + c], kac = PAR[384 + c], rkc = PAR[448 + c], wb = PAR[512 + c], ib = PAR[576 + c];
      const LAS float* WP = (const LAS float*)(L + L_WP); const LAS float* AP = (const LAS float*)(L + L_AP); LAS float* CUMP = (LAS float*)(L + L_CUMP);
      float rr[8], kr[8], vv[8], lw[8], ic[8];
      float ps = 0.f;
#pragma unroll
      for (int r = 0; r < 8; ++r) { const int row = 8 * tg + r; rr[r] = ((const LAS float*)(L + L_RS))[row * 65 + c]; kr[r] = ((const LAS float*)(L + L_KS))[row * 65 + c]; vv[r] = ((const LAS float*)(L + L_VS))[row * 65 + c];
          lw[r] = -0.6065306597126334f * sigmoidf_(wb + WP[row * 65 + c]); ic[r] = sigmoidf_(ib + AP[row * 65 + c]); ps += lw[r]; }
      CUMP[tg * 64 + c] = ps;
      __syncthreads();
      float off = 0.f, tot = 0.f;
#pragma unroll
      for (int q = 0; q < 8; ++q) { const float p = CUMP[q * 64 + c]; tot += p; if (q < tg) off += p; }
      float av[8], rv[8], bv[8], kv[8], bhv[8], khv[8]; float cum = off, gcar = __expf(off); const float gtot = __expf(tot);
      if (tg == 0) ((LAS float*)(L + L_GC))[c] = gtot;
#pragma unroll
      for (int r = 0; r < 8; ++r) { const int t = t0 + 8 * tg + r;
          const float gprev = gcar; cum += lw[r]; const float gam = __expf(cum), ig = __builtin_amdgcn_rcpf(gam), gh = gtot * ig; gcar = gam;
          const float kkn = kr[r] * kkc * ((const LAS float*)(L + L_NRM))[8 * tg + r];
          const float kpm = kr[r] * (1.f + (ic[r] - 1.f) * kac); const float bs = wave_sum_dpp(rr[r] * kpm * rkc);
          if (c == 0) BSC[(size_t)t * 16 + h] = bs;
          const float bq = kkn * ic[r];
          av[r] = -kkn * gprev; rv[r] = rr[r] * gam; bv[r] = bq * ig; kv[r] = kpm * ig; bhv[r] = bq * gh; khv[r] = kpm * gh; }
#define R1_PUT(OFF, A) *(LAS v4u*)(L + (OFF) + c * IMS + 16 * tg) = (v4u){pk2(A[0], A[1]), pk2(A[2], A[3]), pk2(A[4], A[5]), pk2(A[6], A[7])}
      R1_PUT(L_AT, av); R1_PUT(L_RT, rv); R1_PUT(L_BT, bv); R1_PUT(L_KT, kv); R1_PUT(L_BHT, bhv); R1_PUT(L_KHT, khv); R1_PUT(L_VT, vv);
#undef R1_PUT
    }
    __syncthreads();
    { const int prod = wv >> 1; const unsigned ximg = (unsigned)((prod < 2) ? L_AT : L_RT), yimg = (unsigned)((prod & 1) ? L_KT : L_BT);
      const unsigned trb = (unsigned)((8 * g + (fr >> 2)) * IMS + 8 * (fr & 3));
#pragma unroll
      for (int q = 0; q < 8; ++q) { const int tl = 8 * (wv & 1) + q, ti = tl >> 2, si = tl & 3; f32x4 acc = (f32x4){0.f, 0.f, 0.f, 0.f};
          if (si <= ti) {
#pragma unroll
              for (int ks = 0; ks < 2; ++ks) { s16x4 y0, y1, x0, x1;
                  tr_read2(y0, y1, yimg + trb + (unsigned)(32 * ks * IMS + 32 * si), yimg + trb + (unsigned)((32 * ks + 4) * IMS + 32 * si));
                  tr_read2(x0, x1, ximg + trb + (unsigned)(32 * ks * IMS + 32 * ti), ximg + trb + (unsigned)((32 * ks + 4) * IMS + 32 * ti));
                  acc = mfma16((bf16x8){y0[0], y0[1], y0[2], y0[3], y1[0], y1[1], y1[2], y1[3]}, (bf16x8){x0[0], x0[1], x0[2], x0[3], x1[0], x1[1], x1[2], x1[3]}, acc); } }
          const int t = 16 * ti + fr, s0 = 16 * si + 4 * g;
#pragma unroll
          for (int r = 0; r < 4; ++r) { const bool keep = (prod < 2) ? (s0 + r < t) : (s0 + r <= t); acc[r] = keep ? acc[r] : 0.f; }
          if (prod == 0) *(LAS f32x4*)(L + L_LAB + (t * 68 + s0) * 4) = acc;
          else *(LAS v2u*)(L + (prod == 1 ? L_LAK : prod == 2 ? L_MRB : L_MRK) + t * IMS + 2 * s0) = (v2u){pk2(acc[0], acc[1]), pk2(acc[2], acc[3])}; } }
    __syncthreads();
    f32x4 x[4];
    if (wv < 4) {
#pragma unroll
        for (int bi = 0; bi < 4; ++bi) { const v2u w = *(const LAS v2u*)(L + L_AT + (16 * wv + fr) * IMS + 2 * (16 * bi + 4 * g)); x[bi] = (f32x4){bflo(w.x), bfhi(w.x), bflo(w.y), bfhi(w.y)}; }
    } else {
#pragma unroll
        for (int bi = 0; bi < 4; ++bi) { x[bi] = (f32x4){0.f, 0.f, 0.f, 0.f};
#pragma unroll
            for (int ks = 0; ks < 2; ++ks) x[bi] = mfma16(lds_frag(L + L_LAK, 16 * bi + fr, ks, g), lds_frag(L + L_VT, 16 * (wv - 4) + fr, ks, g), x[bi]); }
    }
    if (wv == 0) { const int bi = g, c = fr; const LAS float* Lb = (const LAS float*)(L + L_LAB) + (16 * bi) * 68 + 16 * bi; LAS float* Tb = (LAS float*)(L + L_TII) + bi * 320;
        float xc[16];
#pragma unroll
        for (int r = 0; r < 16; ++r) { float s0 = (r == c) ? 1.f : 0.f, s1 = 0.f, s2 = 0.f, s3 = 0.f;
#pragma unroll
            for (int q = 0; q < r; ++q) { const float p = Lb[r * 68 + q] * xc[q]; if ((q & 3) == 0) s0 += p; else if ((q & 3) == 1) s1 += p; else if ((q & 3) == 2) s2 += p; else s3 += p; }
            const float s = (s0 + s1) + (s2 + s3); xc[r] = s; Tb[r * 20 + c] = s; } }
    __syncthreads();
    { const LAS float* Lab = (const LAS float*)(L + L_LAB); const LAS float* Tii = (const LAS float*)(L + L_TII);
#pragma unroll
      for (int bi = 0; bi < 4; ++bi) { f32x4 acc = x[bi];
#pragma unroll
          for (int bj = 0; bj < 4; ++bj) { if (bj < bi) { const f32x4 a = *(const LAS f32x4*)(Lab + (16 * bi + fr) * 68 + 16 * bj + 4 * g);
#pragma unroll
              for (int kk = 0; kk < 4; ++kk) acc = mfma4f(a[kk], x[bj][kk], acc); } }
          const f32x4 tq = *(const LAS f32x4*)(Tii + bi * 320 + fr * 20 + 4 * g); f32x4 xo = (f32x4){0.f, 0.f, 0.f, 0.f};
#pragma unroll
          for (int kk = 0; kk < 4; ++kk) xo = mfma4f(tq[kk], acc[kk], xo);
          x[bi] = xo;
          *(LAS v2u*)(L + L_XT + (16 * wv + fr) * IMS + 2 * (16 * bi + 4 * g)) = (v2u){pk2(xo[0], xo[1]), pk2(xo[2], xo[3])}; } }
    __syncthreads();
    { bf16* PB = (bf16*)(F.ws + WS_PB) + (size_t)u * 4096; bf16* QC = (bf16*)(F.ws + WS_QC) + (size_t)u * 4096; float* GT = (float*)(F.ws + WS_GT) + (size_t)u * 4096; bf16* Y0 = (bf16*)(F.ws + WS_Y0T) + (size_t)u * 4096;
      const LAS float* GC = (const LAS float*)(L + L_GC);
#pragma unroll
      for (int q = 0; q < 2; ++q) { const int tl = 2 * wv + q, ra = tl >> 2, cb = tl & 3;
          { f32x4 acc = (f32x4){0.f, 0.f, 0.f, 0.f};
#pragma unroll
            for (int ks = 0; ks < 2; ++ks) acc = mfma16(lds_frag(L + L_XT, 16 * ra + fr, ks, g), lds_frag(L + L_MRB, 16 * cb + fr, ks, g), acc);
            const int t = 16 * cb + fr, j0 = 16 * ra + 4 * g;
#pragma unroll
            for (int r = 0; r < 4; ++r) acc[r] += bf2f(*(const LAS bf16*)(L + L_RT + (j0 + r) * IMS + 2 * t));
            *(GAS v2u*)(QC + (size_t)t * 64 + j0) = (v2u){pk2(acc[0], acc[1]), pk2(acc[2], acc[3])}; }
          { f32x4 acc = (f32x4){0.f, 0.f, 0.f, 0.f};
#pragma unroll
            for (int ks = 0; ks < 2; ++ks) { acc = mfma16(lds_frag(L + L_XT, 64 + 16 * ra + fr, ks, g), lds_frag(L + L_MRB, 16 * cb + fr, ks, g), acc); acc = mfma16(lds_frag(L + L_VT, 16 * ra + fr, ks, g), lds_frag(L + L_MRK, 16 * cb + fr, ks, g), acc); }
            *(GAS v2u*)(Y0 + (size_t)(16 * cb + fr) * 64 + 16 * ra + 4 * g) = (v2u){pk2(acc[0], acc[1]), pk2(acc[2], acc[3])}; }
          { f32x4 acc = (f32x4){0.f, 0.f, 0.f, 0.f};
#pragma unroll
            for (int ks = 0; ks < 2; ++ks) acc = mfma16(lds_frag(L + L_XT, 16 * ra + fr, ks, g), lds_frag(L + L_BHT, 16 * cb + fr, ks, g), acc);
            const int jp = 16 * cb + fr;
#pragma unroll
            for (int r = 0; r < 4; ++r) if (16 * ra + 4 * g + r == jp) acc[r] += GC[jp];
            *(GAS v2u*)(PB + (size_t)jp * 64 + 32 * (ra >> 1) + 8 * g + 4 * (ra & 1)) = (v2u){pk2(acc[0], acc[1]), pk2(acc[2], acc[3])}; }
          { f32x4 acc = (f32x4){0.f, 0.f, 0.f, 0.f};
#pragma unroll
            for (int ks = 0; ks < 2; ++ks) { acc = mfma16(lds_frag(L + L_BHT, 16 * ra + fr, ks, g), lds_frag(L + L_XT, 64 + 16 * cb + fr, ks, g), acc); acc = mfma16(lds_frag(L + L_KHT, 16 * ra + fr, ks, g), lds_frag(L + L_VT, 16 * cb + fr, ks, g), acc); }
            *(GAS f32x4*)(GT + (size_t)(16 * cb + fr) * 64 + 16 * ra + 4 * g) = acc; } } }
}

__device__ __forceinline__ void r1_chunk_local(Frame& F) {
    constexpr int NU = RW_H * (T / 64);
    const int upw = (NU + F.G - 1) / F.G;
    const int u0 = F.bid * upw; if (u0 >= NU) return;
    const bf16* WDT = (const bf16*)(F.ws + WS_WDT); const bf16* WIT = (const bf16*)(F.ws + WS_WIT);
    const int fr = F.lane & 15, g = F.lane >> 4;
    R1In in; r1_load(F, u0 >> 8, u0 & 255, in);
    bf16x8 wfr[2][2][2]; int hw = -1;
    for (int ui = 0; ui < upw; ++ui) { const int u = u0 + ui; if (u >= NU) break; const int h = u >> 8;
        if (h != hw) { hw = h;
            __syncthreads();
            { LAS float* PARW = (LAS float*)(F.lds + L_PAR); const int e = F.tid, c = e & 63, ch = 64 * h + c; float v = 0.f;
              if (e < 64) v = F.mu_rkv[ch]; else if (e < 128) v = F.mu_rkv[1024 + ch]; else if (e < 192) v = F.mu_rkv[2048 + ch]; else if (e < 320) v = F.mu_lora[e - 192];
              else if (e < 384) v = F.k_k[ch]; else if (e < 448) v = F.k_a[ch]; else v = F.r_k[ch];
              PARW[e] = v;
              if (e < 64) PARW[512 + e] = F.w_decay_bias[ch]; else if (e < 128) PARW[512 + e] = F.w_iclr_bias[ch]; }
#pragma unroll
            for (int prod = 0; prod < 2; ++prod)
#pragma unroll
                for (int cc = 0; cc < 2; ++cc)
#pragma unroll
                    for (int ks = 0; ks < 2; ++ks) wfr[prod][cc][ks] = *(const bf16x8*)((prod ? WIT : WDT) + (size_t)(64 * h + 16 * ((F.wave & 1) * 2 + cc) + fr) * 64 + 32 * ks + 8 * g); }
        r1_unit(F, h, u & 255, in, wfr, (ui + 1 < upw && u + 1 < NU) ? u + 1 : -1); }
}

constexpr int R2_SLOT = 12288, R2_D = 8, R2_NS = 10;
__device__ __forceinline__ void r2_recurrence(Frame& F) {
    if (F.bid >= 64) return;
    const int h = 2 * (F.bid & 7) + (F.bid >> 5), cg = (F.bid >> 3) & 3, lane = F.lane, fr = lane & 15, g = lane >> 4, wv = F.wave;
    const bf16* PB = (const bf16*)(F.ws + WS_PB) + (size_t)h * 256 * 4096; const float* GT = (const float*)(F.ws + WS_GT) + (size_t)h * 256 * 4096 + (size_t)(16 * cg) * 64;
    bf16* HT = (bf16*)(F.ws + WS_HT) + (size_t)h * 256 * 4096 + (size_t)(16 * cg) * 64;
    LAS unsigned char* L = F.lds;
#define R2_BAR() do { asm volatile("" ::: "memory"); __builtin_amdgcn_s_barrier(); asm volatile("" ::: "memory"); } while (0)
    __syncthreads();
    if (wv == 0) {
#define R2_FRAGS(step, PF, GF) do { const LAS unsigned char* sl_ = L + ((step) % R2_NS) * R2_SLOT; _Pragma("unroll") for (int rt = 0; rt < 4; ++rt) { GF[rt] = *(const LAS f32x4*)(sl_ + 8192 + (fr * 64 + 16 * rt + 4 * g) * 4); \
        _Pragma("unroll") for (int ks = 0; ks < 2; ++ks) PF[rt][ks] = *(const LAS bf16x8*)(sl_ + ((16 * rt + fr) * 64 + 32 * ks + 8 * g) * 2); } } while (0)
#define R2_STEP(PF, GF) do { \
        _Pragma("unroll") for (int rt = 0; rt < 4; ++rt) *(GAS v2u*)(HT + (size_t)c * 4096 + (size_t)fr * 64 + 16 * rt + 4 * g) = (v2u){pk2(hs[rt][0], hs[rt][1]), pk2(hs[rt][2], hs[rt][3])}; \
        bf16x8 bfr[2]; \
        _Pragma("unroll") for (int ks = 0; ks < 2; ++ks) { const v4u w = (v4u){pk2(hs[2 * ks][0], hs[2 * ks][1]), pk2(hs[2 * ks][2], hs[2 * ks][3]), pk2(hs[2 * ks + 1][0], hs[2 * ks + 1][1]), pk2(hs[2 * ks + 1][2], hs[2 * ks + 1][3])}; bfr[ks] = __builtin_bit_cast(bf16x8, w); } \
        _Pragma("unroll") for (int rt = 0; rt < 4; ++rt) { f32x4 acc = GF[rt]; _Pragma("unroll") for (int ks = 0; ks < 2; ++ks) acc = mfma16(PF[rt][ks], bfr[ks], acc); hs[rt] = acc; } } while (0)
        f32x4 hs[4], gfa[4], gfb[4]; bf16x8 pfa[4][2], pfb[4][2];
#pragma unroll
        for (int rt = 0; rt < 4; ++rt) hs[rt] = (f32x4){0.f, 0.f, 0.f, 0.f};
        R2_BAR();
        R2_FRAGS(0, pfa, gfa);
        for (int c = 0; c < 256; c += 2) {
            { R2_FRAGS(c + 1, pfb, gfb); R2_STEP(pfa, gfa); asm volatile("s_waitcnt lgkmcnt(0)" ::: "memory"); R2_BAR(); }
            { const int c1 = c + 1; const int cn = (c1 + 1 < 256) ? c1 + 1 : 255; R2_FRAGS(cn, pfa, gfa); { const int c = c1; R2_STEP(pfb, gfb); } asm volatile("s_waitcnt lgkmcnt(0)" ::: "memory"); R2_BAR(); }
        }
#undef R2_FRAGS
#undef R2_STEP
    } else if (wv <= 6) {
        const int p0 = 2 * (wv - 1);
#define R2_DMA(step) do { const int st_ = (step) < 256 ? (step) : 255; LAS unsigned char* sl_ = L + ((step) % R2_NS) * R2_SLOT; \
        _Pragma("unroll") for (int q_ = 0; q_ < 2; ++q_) { const int pc_ = p0 + q_; const char* src_ = (pc_ < 8) ? ((const char*)(PB + (size_t)st_ * 4096) + pc_ * 1024) : ((const char*)(GT + (size_t)st_ * 4096) + (pc_ - 8) * 1024); \
            __builtin_amdgcn_global_load_lds((const unsigned*)(src_ + lane * 16), (LAS unsigned*)(sl_ + pc_ * 1024), 16, 0, 0); } } while (0)
#pragma unroll
        for (int s0 = 0; s0 < R2_D; ++s0) R2_DMA(s0);
        asm volatile("s_waitcnt vmcnt(12)" ::: "memory");
        R2_BAR();
        for (int c = 0; c < 256; ++c) {
            R2_DMA(c + R2_D);
            asm volatile("s_waitcnt vmcnt(12)" ::: "memory");
            R2_BAR();
        }
        asm volatile("s_waitcnt vmcnt(0)" ::: "memory");
#undef R2_DMA
    } else {
        R2_BAR();
        for (int c = 0; c < 256; ++c) R2_BAR();
    }
    __syncthreads();
#undef R2_BAR
}

__device__ __forceinline__ void r3_output(Frame& F) {
    const bf16* QC = (const bf16*)(F.ws + WS_QC); const bf16* HT = (const bf16*)(F.ws + WS_HT); const bf16* Y0 = (const bf16*)(F.ws + WS_Y0T); const float* BSC = (const float*)(F.ws + WS_BSC);
    const bf16* V = (const bf16*)(F.ws + WS_V); const bf16* GR = (const bf16*)(F.ws + WS_GR); bf16* mixed = (bf16*)(F.ws + WS_MIXED);
    const int gw = F.bid * NWAVES + F.wave, NGW = F.G * NWAVES, lane = F.lane, fr = lane & 15, g = lane >> 4;
    for (int w = gw; w < 4096 * 4; w += NGW) { const int u = w >> 2, tt = w & 3, h = u >> 8, chunk = u & 255, t = chunk * 64 + 16 * tt + fr;
        bf16x8 qb[2];
#pragma unroll
        for (int ks = 0; ks < 2; ++ks) qb[ks] = *(const bf16x8*)(QC + (size_t)u * 4096 + (size_t)(16 * tt + fr) * 64 + 32 * ks + 8 * g);
        f32x4 y[4]; float s = 0.f;
#pragma unroll
        for (int it = 0; it < 4; ++it) { const v2u y0 = *(const GAS v2u*)(Y0 + (size_t)u * 4096 + (size_t)(16 * tt + fr) * 64 + 16 * it + 4 * g); y[it] = (f32x4){bflo(y0.x), bfhi(y0.x), bflo(y0.y), bfhi(y0.y)};
#pragma unroll
            for (int ks = 0; ks < 2; ++ks) y[it] = mfma16(*(const bf16x8*)(HT + (size_t)u * 4096 + (size_t)(16 * it + fr) * 64 + 32 * ks + 8 * g), qb[ks], y[it]);
            s += (y[it][0] + y[it][1]) + (y[it][2] + y[it][3]); }
        s += __shfl_xor(s, 16); s += __shfl_xor(s, 32);
        const float mean = s * (1.f / 64.f); float q2 = 0.f;
#pragma unroll
        for (int it = 0; it < 4; ++it)
#pragma unroll
            for (int r = 0; r < 4; ++r) { y[it][r] -= mean; q2 += y[it][r] * y[it][r]; }
        q2 += __shfl_xor(q2, 16); q2 += __shfl_xor(q2, 32);
        const float rstd = __builtin_amdgcn_rsqf(q2 * (1.f / 64.f) + LNX_EPS), bs = BSC[(size_t)t * 16 + h];
#pragma unroll
        for (int it = 0; it < 4; ++it) { const int ch = 64 * h + 16 * it + 4 * g; const size_t o = (size_t)t * 1024 + ch;
            const v2u vc = *(const GAS v2u*)(V + o), vp = t > 0 ? *(const GAS v2u*)(V + o - 1024) : (v2u){0u, 0u}, gg = *(const GAS v2u*)(GR + o);
            const f32x4 mu = *(const GAS f32x4*)(F.mu_rkv + 2048 + ch), lw = *(const GAS f32x4*)(F.lnx_w + ch), lb = *(const GAS f32x4*)(F.lnx_b + ch);
            const f32x4 vcf = (f32x4){bflo(vc.x), bfhi(vc.x), bflo(vc.y), bfhi(vc.y)}, vpf = (f32x4){bflo(vp.x), bfhi(vp.x), bflo(vp.y), bfhi(vp.y)}, gf = (f32x4){bflo(gg.x), bfhi(gg.x), bflo(gg.y), bfhi(gg.y)};
            const f32x4 vs = vcf + mu * (vpf - vcf); f32x4 o4 = y[it] * rstd * lw + lb + vs * bs;
#pragma unroll
            for (int r = 0; r < 4; ++r) o4[r] = o4[r] * gf[r] * sigmoidf_(gf[r]);
            *(GAS v2u*)(mixed + (size_t)t * 2048 + ch) = (v2u){pk2(o4[0], o4[1]), pk2(o4[2], o4[3])}; }
    }
}
#define PHASES_MID \
    p3_gate(F); GRID_BAR(); \
    p4_attn_items(F); GRID_BAR(); \
    p5_combine(F); GRID_BAR(); \
    r1_chunk_local(F); GRID_BAR(); \
    r2_recurrence(F); GRID_BAR(); \
    r3_output(F); GRID_BAR();
#define HOST_EXTRA

__device__ __forceinline__ void p7_final_norm(Frame& F) {
    const int gw = F.bid * NWAVES + F.wave, NGW = F.G * NWAVES;
    const float* rowss = (const float*)(F.ws + WS_ROWSS);
    for (int m = gw; m < T; m += NGW) {
        const float p = (F.lane < 32) ? rowss[(size_t)m * 32 + F.lane] : 0.f;
        const float rs = 1.f / sqrtf(wave_sum(p) * (1.f / D) + RMS_EPS);
        GAS f32x4* o = (GAS f32x4*)(F.out + (size_t)m * D) + F.lane; const GAS f32x4* w = (const GAS f32x4*)F.final_norm_w + F.lane;
#pragma unroll
        for (int j = 0; j < 8; ++j) { const f32x4 h = o[64 * j]; o[64 * j] = h * rs * w[64 * j]; }
    }
}

struct Args { const float* in[16]; float* out; unsigned char* ws; };
__global__ void __launch_bounds__(NWAVES * 64, 2) hymba_fwd(Args args) {
    extern __shared__ __attribute__((aligned(16))) unsigned char lds[];
    Frame F;
    F.lds = (LAS unsigned char*)lds;
    F.MISC = (volatile LAS unsigned*)(F.lds + MISC_OFF);
    F.tid = threadIdx.x; F.lane = F.tid & 63; F.wave = __builtin_amdgcn_readfirstlane(F.tid >> 6);
    F.G = gridDim.x; F.bid = blockIdx.x;
    F.ws = args.ws; F.ctl = (gu32*)(args.ws + WS_CTL);
    F.x = args.in[0]; F.norm_w = args.in[1]; F.w_in = args.in[2]; F.mu_rkv = args.in[3]; F.mu_lora = args.in[4]; F.w_decay_up = args.in[5]; F.w_decay_bias = args.in[6];
    F.w_iclr_up = args.in[7]; F.w_iclr_bias = args.in[8]; F.k_k = args.in[9]; F.k_a = args.in[10]; F.r_k = args.in[11]; F.lnx_w = args.in[12]; F.lnx_b = args.in[13];
    F.w_out = args.in[14]; F.final_norm_w = args.in[15]; F.out = args.out;
    for (int u = F.tid; u < (LDS_BYTES - MISC_OFF) / 4; u += NWAVES * 64) ((LAS unsigned*)(F.lds + MISC_OFF))[u] = 0u;
    __syncthreads();
    XcdBarrier bar = xcd_barrier_post((unsigned*)(F.ctl + CW_BAR), F.MISC + 8);
#define GRID_BAR() do { xcd_barrier(bar); int t_ = threadIdx.x; asm volatile("" : "+v"(t_)); F.tid = t_; F.lane = t_ & 63; F.wave = __builtin_amdgcn_readfirstlane(t_ >> 6); } while (0)

    p0_prologue(F);
    GRID_BAR();
    {
        pg8::Gemm g{(const pg8::bf16_t*)(F.ws + WS_XN), (const pg8::bf16_t*)(F.ws + WS_W1T), T, NPROJ, D}; pg8::StaticOrder S; S.init(T, NPROJ, F.G, F.bid);
        pg8::EpiProj E{(pg8::bf16_t*)(F.ws + WS_PROJ), (pg8::bf16_t*)(F.ws + WS_WDAD), (const float*)(F.ws + WS_ROPE), (const float*)(F.ws + WS_ROPE) + (size_t)T * 16, (size_t)T * 1024, (float*)(F.ws + WS_KMSUM)};
        pg8::gemm_phase<pg8::EpiProj, pg8::StaticOrder, true, true>(F.lds, g, S, E);
    }
    GRID_BAR();
    PHASES_MID
    {
        pg8::Gemm g{(const pg8::bf16_t*)(F.ws + WS_MIXED), (const pg8::bf16_t*)(F.ws + WS_W2T), T, D, D}; pg8::StaticOrder S; S.init(T, D, F.G, F.bid);
        pg8::EpiOut E{F.x, F.out, (float*)(F.ws + WS_ROWSS), D};
        pg8::gemm_phase<pg8::EpiOut, pg8::StaticOrder, true, true>(F.lds, g, S, E);
    }
    GRID_BAR();
    p7_final_norm(F);
}

extern "C" void kernel_launch(void* const* d_in, const int* in_sizes, int n_in, void* d_out, int out_size, void* d_ws, size_t ws_size, hipStream_t stream) {
    static int grid = 0;
    if (grid == 0) {
        if (n_in != 16 || in_sizes[0] != T * D || out_size != T * D || ws_size < WS_END) { fprintf(stderr, "kernel_launch: unexpected shapes / workspace (n_in %d, in0 %d, out %d, ws %zu < %zu); nothing launched\n", n_in, n_in > 0 ? in_sizes[0] : -1, out_size, ws_size, (size_t)WS_END); grid = -1; return; }
        int dev = 0, cus = 0, per_cu = 0;
        if (hipGetDevice(&dev) != hipSuccess || hipDeviceGetAttribute(&cus, hipDeviceAttributeMultiprocessorCount, dev) != hipSuccess) { grid = -1; return; }
        if (hipFuncSetAttribute((const void*)hymba_fwd, hipFuncAttributeMaxDynamicSharedMemorySize, LDS_BYTES) != hipSuccess) { fprintf(stderr, "kernel_launch: hipFuncSetAttribute failed\n"); grid = -1; return; }
        if (hipOccupancyMaxActiveBlocksPerMultiprocessor(&per_cu, (const void*)hymba_fwd, NWAVES * 64, LDS_BYTES) != hipSuccess || per_cu < 1) { fprintf(stderr, "kernel_launch: occupancy query reports %d workgroups per CU\n", per_cu); per_cu = 1; }
        (void)hipGetLastError();
        grid = cus;
    }
    if (grid < 0) return;
    (void)hipMemsetAsync((char*)d_ws + WS_CTL, 0, CTL_ZERO_BYTES, stream);
    HOST_EXTRA
    Args a{};
    for (int i = 0; i < 16; ++i) a.in[i] = (const float*)d_in[i];
    a.out = (float*)d_out; a.ws = (unsigned char*)d_ws;
    hipLaunchKernelGGL(hymba_fwd, dim3(grid), dim3(NWAVES * 64), LDS_BYTES, stream, a);
}
```
